# Optimizing an MI355X kernel written in HIP

```python
import math
import jax, jax.numpy as jnp
from jax import lax
import numpy as np

D_MODEL = 4096
BATCH = 4
SEQ = 2048
DEPTH = 1
DEC_BATCH = 128
DEC_SEQ = 1
PAST_LEN = 16384
PAGE_SIZE = 128

RET_HEADS = 8
RET_DIM = 256
ML_HEADS = 8
ML_DIM = 256
RET_W = RET_HEADS * RET_DIM
ML_W = ML_HEADS * ML_DIM
MIX_W = RET_W + ML_W
IN_COLS = 4 * RET_W + 4 * ML_W + 2 * ML_HEADS
CHUNK = 128
CONV_W = 4
ROPE_BASE = 10000.0
PEER_HEADS = 8
N_KEYS = 128
N_EXPERTS = N_KEYS * N_KEYS
PEER_TOPK = 16
PEER_QDIM = 256
PEER_BLOCK = 64
PLE_DIM = 256
LN_EPS = 1e-5
DEEPNORM_ALPHA = (2.0 * DEPTH) ** 0.25
DEEPNORM_BETA = (8.0 * DEPTH) ** -0.25

kernel_name = "hybrid_retention_mlstm_peer_decoder_step"

F32 = jnp.float32


def layer_norm(x, g, b):
    xf = x.astype(F32)
    mu = xf.mean(-1, keepdims=True)
    var = jnp.mean(jnp.square(xf - mu), -1, keepdims=True)
    return ((xf - mu) * lax.rsqrt(var + LN_EPS)).astype(x.dtype) * g + b


def head_norm(h, g):
    mu = h.mean(-1, keepdims=True)
    var = jnp.mean(jnp.square(h - mu), -1, keepdims=True)
    return (h - mu) * lax.rsqrt(var + LN_EPS) * g.astype(F32)


def rope(x, pos):
    half = x.shape[-1] // 2
    inv = ROPE_BASE ** (-jnp.arange(half, dtype=F32) / half)
    ang = pos.astype(F32)[:, None] * inv[None]
    cos = jnp.cos(ang)[None, :, None, :].astype(x.dtype)
    sin = jnp.sin(ang)[None, :, None, :].astype(x.dtype)
    x1, x2 = x[..., :half], x[..., half:]
    return jnp.concatenate([x1 * cos - x2 * sin, x1 * sin + x2 * cos], -1)


def to_chunks(a, chunk):
    B, T = a.shape[:2]
    return jnp.moveaxis(a.reshape(B, T // chunk, chunk, *a.shape[2:]), 1, 0)


def from_chunks(a):
    a = jnp.moveaxis(a, 0, 1)
    return a.reshape(a.shape[0], a.shape[1] * a.shape[2], *a.shape[3:])


def retention(q, k, v, s0, chunk):
    H = q.shape[2]
    log_g = jnp.log1p(-(2.0 ** (-5.0 - jnp.arange(H, dtype=F32))))
    idx = jnp.arange(chunk, dtype=F32)
    diff = idx[:, None] - idx[None, :]
    causal = diff >= 0
    decay_in = jnp.where(causal[None], jnp.exp(log_g[:, None, None] * jnp.where(causal, diff, 0.0)[None]), 0.0)
    decay_q = jnp.exp(log_g[None, :] * (idx + 1.0)[:, None])[None, :, :, None]
    decay_k = jnp.exp(log_g[None, :] * (chunk - 1.0 - idx)[:, None])[None, :, :, None]
    decay_c = jnp.exp(log_g * chunk)[None, :, None, None]

    def step(s, inp):
        qc, kc, vc = inp
        sc = jnp.einsum('bihd,bjhd->bhij', qc, kc) * decay_in
        o = jnp.einsum('bhij,bjhe->bihe', sc, vc) + jnp.einsum('bihd,bhde->bihe', qc, s) * decay_q
        s = s * decay_c + jnp.einsum('bjhd,bjhe->bhde', kc * decay_k, vc)
        return s, o

    s, o = lax.scan(step, s0, (to_chunks(q, chunk), to_chunks(k, chunk), to_chunks(v, chunk)))
    return from_chunks(o), s


def mlstm(q, k, v, ig, lf, c0, n0, m0, chunk):
    idx = jnp.arange(chunk)
    causal = idx[:, None] >= idx[None, :]

    def step(carry, inp):
        c, n, m = carry
        qc, kc, vc, ic, fc = inp
        bt = jnp.cumsum(fc, axis=1).transpose(0, 2, 1)
        it = ic.transpose(0, 2, 1)
        dmat = jnp.where(causal, bt[..., :, None] - bt[..., None, :] + it[..., None, :], -jnp.inf)
        prior = bt + m[..., None]
        mt = jnp.maximum(prior, dmat.max(-1))
        w = jnp.exp(dmat - mt[..., None])
        wp = jnp.exp(prior - mt).transpose(0, 2, 1)
        qk = jnp.einsum('bihd,bjhd->bhij', qc, kc) * w
        num = jnp.einsum('bhij,bjhe->bihe', qk, vc) + jnp.einsum('bihd,bhde->bihe', qc, c) * wp[..., None]
        den = qk.sum(-1).transpose(0, 2, 1) + jnp.einsum('bihd,bhd->bih', qc, n) * wp
        h = num / jnp.maximum(jnp.abs(den), jnp.exp(-mt).transpose(0, 2, 1))[..., None]
        bl = bt[..., -1]
        m_new = mt[..., -1]
        wk = jnp.exp(bl[..., None] - bt + it - m_new[..., None])
        wc = jnp.exp(bl + m - m_new)
        c_new = c * wc[..., None, None] + jnp.einsum('bjhd,bhj,bjhe->bhde', kc, wk, vc)
        n_new = n * wc[..., None] + jnp.einsum('bjhd,bhj->bhd', kc, wk)
        return (c_new, n_new, m_new), h

    xs = tuple(to_chunks(a, chunk) for a in (q, k, v, ig, lf))
    (c, n, m), h = lax.scan(step, (c0, n0, m0), xs)
    return from_chunks(h), c, n, m


def causal_conv(x, buf, w, b):
    T = x.shape[1]
    xx = jnp.concatenate([buf.astype(x.dtype), x], 1)
    y = sum(xx[:, j:j + T] * w[j] for j in range(CONV_W)) + b
    return y, xx[:, -(CONV_W - 1):]


def token_mixers(x, pos, chunk, s_ret, conv_buf, c0, n0, m0, w_in, b_gate, conv_w, conv_b, g_ret_norm, g_ml_norm, w_out):
    B, T, _ = x.shape
    z = x @ w_in
    offs = [RET_W, 2 * RET_W, 3 * RET_W, 4 * RET_W, 4 * RET_W + 2 * ML_W, 4 * RET_W + 3 * ML_W, 4 * RET_W + 4 * ML_W]
    rq, rk, rv, rg, mqk, mv, mo, gates = jnp.split(z, offs, axis=-1)
    heads = lambda a, d: a.reshape(B, T, -1, d)
    rq = rope(heads(rq, RET_DIM), pos).astype(F32)
    rk = (rope(heads(rk, RET_DIM), pos) * RET_DIM ** -0.5).astype(F32)
    o_r, s_new = retention(rq, rk, heads(rv, RET_DIM).astype(F32), s_ret.astype(F32), chunk)
    o_r = head_norm(o_r, g_ret_norm).reshape(B, T, RET_W).astype(x.dtype) * jax.nn.silu(rg)
    qk_c, buf_new = causal_conv(mqk, conv_buf, conv_w, conv_b)
    mq, mk = jnp.split(jax.nn.silu(qk_c), 2, axis=-1)
    g = gates.astype(F32) + b_gate.astype(F32)
    ig, lf = g[..., :ML_HEADS], jax.nn.log_sigmoid(g[..., ML_HEADS:])
    h, c, n, m = mlstm(heads(mq, ML_DIM).astype(F32), (heads(mk, ML_DIM) * ML_DIM ** -0.5).astype(F32),
                       heads(mv, ML_DIM).astype(F32), ig, lf, c0.astype(F32), n0.astype(F32), m0.astype(F32), chunk)
    o_m = head_norm(h, g_ml_norm).reshape(B, T, ML_W).astype(x.dtype) * jax.nn.sigmoid(mo)
    y = jnp.concatenate([o_r, o_m], -1) @ w_out
    return y, s_new, buf_new, c, n, m


def peer(x, w_q, sub_keys, u_tab, v_tab):
    lead = x.shape[:-1]
    xt = x.reshape(-1, D_MODEL)
    nt = xt.shape[0]
    q = (xt @ w_q).reshape(nt, PEER_HEADS, 2, PEER_QDIM // 2).astype(F32)
    s = jnp.einsum('nhpd,hpkd->nhpk', q, sub_keys.astype(F32))
    sv, si = lax.top_k(s, PEER_TOPK)
    cand = (sv[:, :, 0, :, None] + sv[:, :, 1, None, :]).reshape(nt, PEER_HEADS, -1)
    cidx = (si[:, :, 0, :, None] * N_KEYS + si[:, :, 1, None, :]).reshape(nt, PEER_HEADS, -1)
    tv, ti = lax.top_k(cand, PEER_TOPK)
    eidx = jnp.take_along_axis(cidx, ti, -1).reshape(nt, -1)
    gw = jax.nn.softmax(tv, -1).reshape(nt, -1)
    nblk = -(-nt // PEER_BLOCK)
    pad = nblk * PEER_BLOCK - nt
    xb = jnp.pad(xt, ((0, pad), (0, 0))).reshape(nblk, PEER_BLOCK, D_MODEL)
    eb = jnp.pad(eidx, ((0, pad), (0, 0))).reshape(nblk, PEER_BLOCK, -1)
    gb = jnp.pad(gw, ((0, pad), (0, 0))).reshape(nblk, PEER_BLOCK, -1)

    def block(args):
        xs, es, gs = args
        a = jax.nn.gelu(jnp.einsum('nd,nkd->nk', xs, u_tab[es]))
        return jnp.einsum('nk,nkd->nd', a * gs.astype(a.dtype), v_tab[es])

    y = lax.map(block, (xb, eb, gb)).reshape(-1, D_MODEL)[:nt]
    return y.reshape(*lead, D_MODEL)


def trunk(x, p, pos, chunk, s_ret, s_conv, s_c, s_n, s_m, ln_emb_g, ln_emb_b, w_in, b_gate, conv_w, conv_b,
          g_ret_norm, g_ml_norm, w_out, ln1_g, ln1_b, w_peer_q, peer_sub_keys, peer_u, peer_v,
          w_ple_gate, w_ple_proj, ln2_g, ln2_b):
    x = layer_norm(x, ln_emb_g, ln_emb_b)
    rets, convs, cs, ns, ms = [], [], [], [], []
    for i in range(DEPTH):
        mix, sr, cb, c, n, m = token_mixers(x, pos, chunk, s_ret[i], s_conv[i], s_c[i], s_n[i], s_m[i], w_in[i], b_gate[i],
                                            conv_w[i], conv_b[i], g_ret_norm[i], g_ml_norm[i], w_out[i])
        x = layer_norm(DEEPNORM_ALPHA * x + mix, ln1_g[i], ln1_b[i])
        ch = peer(x, w_peer_q[i], peer_sub_keys[i], peer_u[i], peer_v[i])
        ple = jax.nn.sigmoid(x @ w_ple_gate[i]) * (p[i].astype(x.dtype) @ w_ple_proj[i])
        x = layer_norm(DEEPNORM_ALPHA * x + ch + ple, ln2_g[i], ln2_b[i])
        rets.append(sr); convs.append(cb); cs.append(c); ns.append(n); ms.append(m)
    return x, jnp.stack(rets), jnp.stack(convs), jnp.stack(cs), jnp.stack(ns), jnp.stack(ms)


def setup_inputs(seed: int = 0) -> dict:
    key = jax.random.key(seed)
    ks = jax.random.split(key, 32)
    nrm = lambda k, shape, scale: jax.random.normal(k, shape, F32) * scale
    H = ML_HEADS
    b_gate = jnp.concatenate([nrm(ks[10], (DEPTH, H), 0.1),
                              jnp.broadcast_to(jnp.linspace(3.0, 6.0, H, dtype=F32), (DEPTH, H)) + nrm(ks[11], (DEPTH, H), 0.1)], -1)
    return {
        "x_prompt": nrm(ks[0], (BATCH, SEQ, D_MODEL), 1.0),
        "x_sample": nrm(ks[1], (DEC_BATCH, DEC_SEQ, D_MODEL), 1.0),
        "state_ret": nrm(ks[2], (DEPTH, DEC_BATCH, RET_HEADS, RET_DIM, RET_DIM), 0.1),
        "state_conv": nrm(ks[3], (DEPTH, DEC_BATCH, CONV_W - 1, 2 * ML_W), 1.0),
        "state_mlstm_c": nrm(ks[4], (DEPTH, DEC_BATCH, ML_HEADS, ML_DIM, ML_DIM), 0.1),
        "state_mlstm_n": nrm(ks[5], (DEPTH, DEC_BATCH, ML_HEADS, ML_DIM), 0.5),
        "state_mlstm_m": nrm(ks[6], (DEPTH, DEC_BATCH, ML_HEADS), 1.0),
        "p_prompt": nrm(ks[7], (DEPTH, BATCH, SEQ, PLE_DIM), 1.0),
        "p_sample": nrm(ks[8], (DEPTH, DEC_BATCH, DEC_SEQ, PLE_DIM), 1.0),
        "ln_emb_g": 1.0 + nrm(ks[9], (D_MODEL,), 0.02),
        "ln_emb_b": nrm(ks[12], (D_MODEL,), 0.02),
        "w_in": nrm(ks[13], (DEPTH, D_MODEL, IN_COLS), D_MODEL ** -0.5),
        "b_gate": b_gate,
        "conv_w": nrm(ks[14], (DEPTH, CONV_W, 2 * ML_W), CONV_W ** -0.5),
        "conv_b": nrm(ks[15], (DEPTH, 2 * ML_W), 0.02),
        "g_ret_norm": 1.0 + nrm(ks[16], (DEPTH, RET_HEADS, RET_DIM), 0.02),
        "g_ml_norm": 1.0 + nrm(ks[17], (DEPTH, ML_HEADS, ML_DIM), 0.02),
        "w_out": nrm(ks[18], (DEPTH, MIX_W, D_MODEL), MIX_W ** -0.5 * DEEPNORM_BETA),
        "ln1_g": 1.0 + nrm(ks[19], (DEPTH, D_MODEL), 0.02),
        "ln1_b": nrm(ks[20], (DEPTH, D_MODEL), 0.02),
        "w_peer_q": nrm(ks[21], (DEPTH, D_MODEL, PEER_HEADS * PEER_QDIM), D_MODEL ** -0.5),
        "peer_sub_keys": nrm(ks[22], (DEPTH, PEER_HEADS, 2, N_KEYS, PEER_QDIM // 2), (PEER_QDIM // 2) ** -0.5),
        "peer_u": nrm(ks[23], (DEPTH, N_EXPERTS, D_MODEL), D_MODEL ** -0.5),
        "peer_v": nrm(ks[24], (DEPTH, N_EXPERTS, D_MODEL), DEEPNORM_BETA * PEER_HEADS ** -0.5),
        "w_ple_gate": nrm(ks[25], (DEPTH, D_MODEL, D_MODEL), D_MODEL ** -0.5),
        "w_ple_proj": nrm(ks[26], (DEPTH, PLE_DIM, D_MODEL), PLE_DIM ** -0.5 * DEEPNORM_BETA),
        "ln2_g": 1.0 + nrm(ks[27], (DEPTH, D_MODEL), 0.02),
        "ln2_b": nrm(ks[28], (DEPTH, D_MODEL), 0.02),
    }


def reference(x_prompt, x_sample, state_ret, state_conv, state_mlstm_c, state_mlstm_n, state_mlstm_m, p_prompt, p_sample,
              ln_emb_g, ln_emb_b, w_in, b_gate, conv_w, conv_b, g_ret_norm, g_ml_norm, w_out, ln1_g, ln1_b,
              w_peer_q, peer_sub_keys, peer_u, peer_v, w_ple_gate, w_ple_proj, ln2_g, ln2_b):
    weights = (ln_emb_g, ln_emb_b, w_in, b_gate, conv_w, conv_b, g_ret_norm, g_ml_norm, w_out, ln1_g, ln1_b,
               w_peer_q, peer_sub_keys, peer_u, peer_v, w_ple_gate, w_ple_proj, ln2_g, ln2_b)
    Bp, Tp = x_prompt.shape[:2]
    y_prompt, ret_p, conv_p, c_p, n_p, m_p = trunk(
        x_prompt, p_prompt, jnp.arange(Tp), CHUNK,
        jnp.zeros((DEPTH, Bp, RET_HEADS, RET_DIM, RET_DIM), F32),
        jnp.zeros((DEPTH, Bp, CONV_W - 1, 2 * ML_W), x_prompt.dtype),
        jnp.zeros((DEPTH, Bp, ML_HEADS, ML_DIM, ML_DIM), F32),
        jnp.zeros((DEPTH, Bp, ML_HEADS, ML_DIM), F32),
        jnp.zeros((DEPTH, Bp, ML_HEADS), F32),
        *weights)
    Ts = x_sample.shape[1]
    y_sample, ret_s, conv_s, c_s, n_s, m_s = trunk(
        x_sample, p_sample, PAST_LEN + jnp.arange(Ts), Ts,
        state_ret, state_conv, state_mlstm_c, state_mlstm_n, state_mlstm_m,
        *weights)
    return (y_prompt, y_sample, ret_p, conv_p, c_p, n_p, m_p, ret_s, conv_s, c_s, n_s, m_s)
```

```cpp
#include <hip/hip_runtime.h>
#include <cstdio>
#include <cstdint>
#include <cmath>
#include <cstring>

#ifndef USE_MFMA
#define USE_MFMA 1
#endif
#ifndef USE_PEER_FAST
#define USE_PEER_FAST 1
#endif
#ifndef USE_MIX_FAST
#define USE_MIX_FAST 1
#endif
#ifndef USE_ROUTE_FAST
#define USE_ROUTE_FAST 1
#endif
#ifndef FUSE_CONV
#define FUSE_CONV 1
#endif
static_assert(FUSE_CONV == 0 || (USE_MFMA != 0 && USE_MIX_FAST != 0), "FUSE_CONV needs the MFMA GEMM (fused rope) and the fast mixers");
constexpr bool kFuseConv = FUSE_CONV != 0;
static_assert((USE_ROUTE_FAST != 0) == (USE_PEER_FAST != 0), "the fast routing writes u16 expert ids that only the fast expert phases read");
#ifndef USE_MX
#define USE_MX 1
#endif
#ifndef MK_PER_PHASE
#define MK_PER_PHASE 0
#endif

#define GAS __attribute__((address_space(1)))
#define LAS __attribute__((address_space(3)))
typedef unsigned short bf16;
typedef unsigned v4u __attribute__((ext_vector_type(4)));
typedef float f32x4 __attribute__((ext_vector_type(4)));
typedef GAS unsigned gu32;
typedef short bf16x8 __attribute__((ext_vector_type(8)));
typedef float f32x16 __attribute__((ext_vector_type(16)));
#define MFMA32(a, b, c) __builtin_amdgcn_mfma_f32_32x32x16_bf16((a), (b), (c), 0, 0, 0)

constexpr int D = 4096, SEQ = 2048, NPB = 4, NP = NPB * SEQ  , NS = 128, M = NP + NS  , MP = 8448  ;
constexpr int H = 8, HD = 256, RW = 2048, INC = 16400, NZ = 16384;
constexpr int ZQ = 0, ZK = 2048, ZV = 4096, ZG = 6144, ZMQK = 8192, ZMV = 12288, ZMO = 14336;
constexpr int PLE_D = 256, NQ = 2048, NEXP = 16384, TOPK = 16, NSLOT = 128;
constexpr float LN_EPS = 1e-5f;
constexpr float ALPHA = 1.189207115002721f;
constexpr int PAST_LEN = 16384;
constexpr size_t O_YP = 0, O_YS = O_YP + (size_t)NP * D, O_RETP = O_YS + (size_t)NS * D, O_CONVP = O_RETP + (size_t)NPB * H * HD * HD,
                 O_CP = O_CONVP + (size_t)NPB * 3 * 4096, O_NP = O_CP + (size_t)NPB * H * HD * HD, O_MP = O_NP + (size_t)NPB * H * HD,
                 O_RETS = O_MP + (size_t)NPB * H, O_CONVS = O_RETS + (size_t)NS * H * HD * HD, O_CS = O_CONVS + (size_t)NS * 3 * 4096,
                 O_NS = O_CS + (size_t)NS * H * HD * HD, O_MS = O_NS + (size_t)NS * H * HD, O_END = O_MS + (size_t)NS * H;
static_assert(O_END == 174384160, "output size");

constexpr size_t MiB = 1u << 20;
constexpr size_t WS_CTL = 0, CTL_ZERO_BYTES = 32768;
constexpr size_t WS_ROPE = 1 * MiB;
constexpr size_t WS_G = 764 * MiB;
constexpr size_t WS_WG = 4 * MiB + 614400;
constexpr size_t WS_EIDX = 5 * MiB;
constexpr size_t WS_GW = 10 * MiB;
constexpr size_t WS_KH = 15 * MiB;
constexpr size_t WS_WOUT = 16 * MiB;
constexpr size_t WS_W3 = 48 * MiB;
constexpr size_t WS_WP = 96 * MiB;
constexpr size_t WS_P16 = 98 * MiB;
constexpr size_t WS_XN = 104 * MiB;
constexpr size_t WS_MIX = 170 * MiB;
constexpr size_t WS_X1 = 236 * MiB;
constexpr size_t WS_WIN = 302 * MiB;
constexpr size_t WS_Z = 430 * MiB;
constexpr size_t WS_MQK = 694 * MiB;
constexpr size_t WS_X18 = 694 * MiB;
constexpr size_t WS_Y1 = 302 * MiB;
constexpr size_t WS_PLE = 434 * MiB;
constexpr size_t WS_QP = 566 * MiB;
constexpr size_t WS_CH = 632 * MiB;
constexpr size_t WS_X1S = 170 * MiB;
constexpr size_t WS_PA = 764 * MiB;
constexpr size_t WS_UB = 800 * MiB;
constexpr size_t WS_VB = 928 * MiB;
constexpr size_t WS_ST = 302 * MiB;
constexpr size_t WS_NLOC = 760 * MiB;
constexpr size_t WS_NST = 761 * MiB;
constexpr size_t WS_SCAL = 762 * MiB;
constexpr size_t WS_UT = 1056 * MiB;
constexpr size_t WS_PLE2 = 1184 * MiB;
constexpr size_t WS_END = 1316 * MiB;
constexpr int CW_BAR = 4096;
constexpr int CW_QS = 7936;

constexpr int NWAVES = 8, NTHR = 512;
constexpr int LDS_BYTES = 163840, LDSCTL_OFF = 162816, MISC_OFF = LDSCTL_OFF + 320;

#define LDS_WAIT() asm volatile("s_waitcnt lgkmcnt(0)" ::: "memory")
#define VM_WAIT() asm volatile("s_waitcnt vmcnt(0)" ::: "memory")
__device__ __forceinline__ float bf2f(unsigned v) { return __uint_as_float(v << 16); }
__device__ __forceinline__ unsigned f2bf(float f) { unsigned u = __float_as_uint(f); return (u + 0x7fffu + ((u >> 16) & 1u)) >> 16; }
__device__ __forceinline__ unsigned pk2(float lo, float hi) { return f2bf(lo) | (f2bf(hi) << 16); }
__device__ __forceinline__ float wave_sum(float v) {
#pragma unroll
    for (int o = 1; o < 64; o <<= 1) v += __shfl_xor(v, o);
    return v;
}
__device__ __forceinline__ float sigmoidf_(float x) { return __builtin_amdgcn_rcpf(1.f + __expf(-x)); }
__device__ __forceinline__ float siluf_(float x) { return x * sigmoidf_(x); }
__device__ __forceinline__ float log_sigmoidf_(float x) { return fminf(x, 0.f) - log1pf(__expf(-fabsf(x))); }
__device__ __forceinline__ float gate_ld(const float* G, int row, int col) { const size_t o = (size_t)row * 16 + col; return (G[o] + G[o + (size_t)MP * 16]) + (G[o + (size_t)2 * MP * 16] + G[o + (size_t)3 * MP * 16]); }
__device__ __forceinline__ float gelu_tanh(float x) { const float u = 0.7978845608028654f * (x + 0.044715f * x * x * x); return 0.5f * x * (1.f + tanhf(u)); }

#define XB_TMO      128
#define XB_XCNT(j)  (256  + 64 * (j))
#define XB_XSUB(j)  (1280 + 64 * (j))
#define XB_XGEN(j)  (2304 + 64 * (j))
#define XB_TOP      3328
#define XB_TOPGEN   3392
#define XCD_BAR_WORDS 3456
#define XB_SPIN_CAP (1u << 23)
__device__ __forceinline__ unsigned xb_ld(unsigned* p)              { return __hip_atomic_load(p, __ATOMIC_RELAXED, __HIP_MEMORY_SCOPE_AGENT); }
__device__ __forceinline__ unsigned xb_add(unsigned* p, unsigned v) { return __hip_atomic_fetch_add(p, v, __ATOMIC_RELAXED, __HIP_MEMORY_SCOPE_AGENT); }
__device__ __forceinline__ unsigned xb_xcc_id() { return (unsigned)__builtin_amdgcn_s_getreg((3 << 11) | 20) & 0xFu; }
#define XB_SPIN(cond, bar) do { unsigned _sp = 0; while (cond) { __builtin_amdgcn_s_sleep(1); \
    if ((++_sp & 255u) == 0u) { if (xb_ld(&(bar)[XB_TMO])) break; if (_sp > XB_SPIN_CAP) { atomicAdd(&(bar)[XB_TMO], 1u); break; } } } } while (0)
struct XcdBarrier { unsigned* bar; unsigned x; volatile LAS unsigned* st; };
__device__ __forceinline__ XcdBarrier xcd_barrier_post(unsigned* bar, volatile LAS unsigned* st) {
    XcdBarrier b; b.bar = bar; b.x = xb_xcc_id(); b.st = st;
    if (threadIdx.x == 0) (void)xb_add(&bar[XB_XCNT(b.x)], 1u);
    return b;
}
__device__ __forceinline__ void xcd_barrier_complete(unsigned* bar, unsigned x, unsigned& nloc, unsigned& nx) {
    const unsigned G = gridDim.x * gridDim.y * gridDim.z;
    unsigned sum, cnt, mine, sp = 0u;
    for (;;) {
        sum = 0u; cnt = 0u; mine = 0u;
#pragma unroll
        for (unsigned j = 0; j < 16; ++j) { const unsigned c = xb_ld(&bar[XB_XCNT(j)]); sum += c; cnt += (c > 0u) ? 1u : 0u; mine = (j == x) ? c : mine; }
        if (sum == G) break;
        __builtin_amdgcn_s_sleep(1);
        if ((++sp & 255u) == 0u) { if (xb_ld(&bar[XB_TMO])) break; if (sp > XB_SPIN_CAP) { atomicAdd(&bar[XB_TMO], 1u); break; } }
    }
    nloc = mine > 0u ? mine : 1u; nx = cnt > 0u ? cnt : 1u;
}
__device__ __forceinline__ void xcd_barrier(const XcdBarrier& b) {
    asm volatile("s_waitcnt vmcnt(0)" ::: "memory");
    __syncthreads();
    if (threadIdx.x == 0) {
        unsigned* bar = b.bar;
        __builtin_amdgcn_s_waitcnt(0);
        unsigned nloc = b.st[0], nx = b.st[1];
        if (nloc == 0u) { xcd_barrier_complete(bar, b.x, nloc, nx); b.st[0] = nloc; b.st[1] = nx; }
        const unsigned old = xb_add(&bar[XB_XSUB(b.x)], 1u);
        const unsigned gen = old / nloc;
        if (old + 1u == (gen + 1u) * nloc) {
            __builtin_amdgcn_fence(__ATOMIC_RELEASE, "agent");
            asm volatile("s_waitcnt vmcnt(0)" ::: "memory");
            const unsigned og = xb_add(&bar[XB_TOP], 1u);
            const unsigned tg = og / nx;
            if (og + 1u == (tg + 1u) * nx) xb_add(&bar[XB_TOPGEN], 1u);
            else XB_SPIN(xb_ld(&bar[XB_TOPGEN]) == tg, bar);
            __builtin_amdgcn_fence(__ATOMIC_ACQUIRE, "agent");
            xb_add(&bar[XB_XGEN(b.x)], 1u);
            asm volatile("s_waitcnt vmcnt(0)" ::: "memory");
        } else {
            XB_SPIN(xb_ld(&bar[XB_XGEN(b.x)]) == gen, bar);
            __builtin_amdgcn_fence(__ATOMIC_ACQUIRE, "agent");
            asm volatile("s_waitcnt vmcnt(0)" ::: "memory");
        }
    }
    __syncthreads();
}

namespace pg8 {
#define PG8_LAS __attribute__((address_space(3)))
typedef unsigned short bf16_t;
typedef short bf16x8 __attribute__((ext_vector_type(8)));
typedef float f32x4 __attribute__((ext_vector_type(4)));
typedef unsigned u32x4 __attribute__((ext_vector_type(4)));
constexpr int BM = 256, BK = 64, HALF = 128, HTB = HALF * BK * 2  , STAGE_BYTES = 8 * HTB, NXCD = 8, WGM = 8;

__host__ __device__ __forceinline__ int lds_byte(int r, int c) { const int st = (r >> 4) * 2 + (c >> 5), rr = r & 15, cc = c & 31, ob = rr * 64 + cc * 2; return st * 1024 + (ob ^ (((ob >> 9) & 1) << 5)); }
__host__ __device__ __forceinline__ void stage_rc(int b, int& R, int& C) { const int st = b / 1024, sb = b % 1024, swz = sb ^ (((sb >> 9) & 1) << 5); R = (st >> 1) * 16 + swz / 64; C = (st & 1) * 32 + (swz % 64) / 2; }
__host__ __device__ __forceinline__ int perm32(int rho) { const int n = rho >> 4, i = rho & 15; return 8 * (i >> 2) + 4 * n + (i & 3); }

struct Unit { int pm, pn; };
constexpr int M_VALID = 8320;
struct Gemm { const bf16_t* A; const bf16_t* Bt; int M, N, K; int wscale = 0x7f7f7f7f; };
typedef int v8i_t __attribute__((ext_vector_type(8)));
typedef int v4i_t __attribute__((ext_vector_type(4)));
__device__ __forceinline__ f32x4 mx_mma(bf16x8 b0, bf16x8 b1, bf16x8 a0, bf16x8 a1, f32x4 c, int wscale) {
    const v4i_t B0 = __builtin_bit_cast(v4i_t, b0), B1 = __builtin_bit_cast(v4i_t, b1), A0 = __builtin_bit_cast(v4i_t, a0), A1 = __builtin_bit_cast(v4i_t, a1);
    const v8i_t Bv = {B0.x, B0.y, B0.z, B0.w, B1.x, B1.y, B1.z, B1.w}, Av = {A0.x, A0.y, A0.z, A0.w, A1.x, A1.y, A1.z, A1.w};
    return __builtin_amdgcn_mfma_scale_f32_16x16x128_f8f6f4(Bv, Av, c, 0, 0, 0, wscale, 0, 0x7f7f7f7f);
}

struct StaticOrder {
    int nM, nN, nwg, G, c;
    __host__ __device__ void init(int M, int N, int G_, int c_) { nM = M / BM; nN = N / BM; nwg = nM * nN; G = G_; c = c_; }
    __host__ __device__ bool next(int i, Unit& u) const {
        const long L = (long)i * G + c; if (L >= nwg) return false;
        int wgid = (int)L; { const int q = nwg / NXCD, r = nwg % NXCD, xcd = wgid % NXCD, off = wgid / NXCD; wgid = (xcd < r ? xcd * (q + 1) : r * (q + 1) + (xcd - r) * q) + off; }
        const int nig = WGM * nN, gid = wgid / nig, fm = gid * WGM, gsz = (nM - fm) < WGM ? (nM - fm) : WGM;
        u.pm = fm + ((wgid % nig) % gsz); u.pn = (wgid % nig) / gsz; return true;
    }
    __device__ __forceinline__ void a_ready(const Unit&) const {}
    __device__ __forceinline__ void done(const Unit&) const {}
};
struct TailOrder {
    StaticOrder so; int nmain, nN, nMmain, G, c;
    __host__ __device__ void init(int Mmain, int N, int G_, int c_) { so.init(Mmain, N, G_, c_); nMmain = Mmain / BM; nN = N / BM; nmain = nMmain * nN; G = G_; c = c_; }
    __host__ __device__ bool next(int i, Unit& u) const { const long L = (long)i * G + c; if (L < nmain) return so.next(i, u); if (L >= nmain + nN) return false; u.pm = nMmain; u.pn = (int)(L - nmain); return true; }
    __device__ __forceinline__ void a_ready(const Unit&) const {}
    __device__ __forceinline__ void done(const Unit&) const {}
};
struct SpanOrder {
    TailOrder t; int start, stride, cnt;
    __host__ __device__ void init(int Mmain, int N, int s, int st, int n) { t.init(Mmain, N, 1, 0); start = s; stride = st; cnt = n; }
    __host__ __device__ bool next(int i, Unit& u) const { if (i >= cnt) return false; return t.next(start + i * stride, u); }
    __device__ __forceinline__ void a_ready(const Unit&) const {}
    __device__ __forceinline__ void done(const Unit&) const {}
};
__device__ __forceinline__ unsigned cvt_pk_bf16(float lo, float hi) { unsigned r; asm volatile("v_cvt_pk_bf16_f32 %0, %1, %2" : "=v"(r) : "v"(lo), "v"(hi)); return r; }
struct EpiZRope {
    static constexpr bool PERM = true, AFTER_DRAIN = false;
    bf16_t* Z; const float* cs; const float* sn;
    __device__ __forceinline__ void operator()(const f32x4 (&acc)[2][2][4][2], const Unit& u, int wr, int wc, int fr, int fq) const {
        const int row0 = u.pm * BM + wr * 64 + fr, col0 = u.pn * BM + wc * 32 + 8 * fq, i0 = wc * 32 + 8 * fq;
        const bool rope = u.pn < 16; const float sc = (u.pn >= 8 && u.pn < 16) ? 0.0625f : 1.f;
#pragma unroll
        for (int ai = 0; ai < 2; ++ai)
#pragma unroll
            for (int m = 0; m < 4; ++m) { if (ai == 1 && u.pm * BM + HALF >= M_VALID) continue; const int row = row0 + ai * HALF + m * 16; bf16_t* rowp = Z + (size_t)row * NZ + col0;
                f32x4 v00 = acc[ai][0][m][0], v01 = acc[ai][0][m][1], v10 = acc[ai][1][m][0], v11 = acc[ai][1][m][1];
                if (rope) { const int pi = row < NP ? (row & (SEQ - 1)) : 2048; const float* cp = cs + pi * 128 + i0; const float* sp = sn + pi * 128 + i0;
                    const f32x4 c0 = *(const f32x4*)cp, c1 = *(const f32x4*)(cp + 4), s0 = *(const f32x4*)sp, s1 = *(const f32x4*)(sp + 4);
                    const f32x4 a0 = (v00 * c0 - v10 * s0) * sc, b0 = (v00 * s0 + v10 * c0) * sc, a1 = (v01 * c1 - v11 * s1) * sc, b1 = (v01 * s1 + v11 * c1) * sc;
                    v00 = a0; v10 = b0; v01 = a1; v11 = b1; }
                u32x4 w; w.x = cvt_pk_bf16(v00[0], v00[1]); w.y = cvt_pk_bf16(v00[2], v00[3]); w.z = cvt_pk_bf16(v01[0], v01[1]); w.w = cvt_pk_bf16(v01[2], v01[3]);
                *(u32x4*)rowp = w;
                w.x = cvt_pk_bf16(v10[0], v10[1]); w.y = cvt_pk_bf16(v10[2], v10[3]); w.z = cvt_pk_bf16(v11[0], v11[1]); w.w = cvt_pk_bf16(v11[2], v11[3]);
                *(u32x4*)(rowp + HALF) = w; }
    }
};
struct EpiY1m {
    static constexpr bool PERM = true, AFTER_DRAIN = false;
    bf16_t* Y1; const bf16_t* XN;
    __device__ __forceinline__ void operator()(const f32x4 (&acc)[2][2][4][2], const Unit& u, int wr, int wc, int fr, int fq) const {
        const int row0 = u.pm * BM + wr * 64 + fr, col0 = u.pn * BM + wc * 32 + 8 * fq;
#pragma unroll
        for (int ai = 0; ai < 2; ++ai)
#pragma unroll
            for (int m = 0; m < 4; ++m) { if (ai == 1 && u.pm * BM + HALF >= M_VALID) continue; const size_t ro = (size_t)(row0 + ai * HALF + m * 16) * D + col0;
#pragma unroll
                for (int bj = 0; bj < 2; ++bj) { const size_t o = ro + bj * HALF; const u32x4 xb = *(const u32x4*)(XN + o); const f32x4 v0 = acc[ai][bj][m][0], v1 = acc[ai][bj][m][1];
                    u32x4 w;
                    w.x = cvt_pk_bf16(__uint_as_float(xb.x << 16) * ALPHA + v0[0], __uint_as_float(xb.x & 0xffff0000u) * ALPHA + v0[1]);
                    w.y = cvt_pk_bf16(__uint_as_float(xb.y << 16) * ALPHA + v0[2], __uint_as_float(xb.y & 0xffff0000u) * ALPHA + v0[3]);
                    w.z = cvt_pk_bf16(__uint_as_float(xb.z << 16) * ALPHA + v1[0], __uint_as_float(xb.z & 0xffff0000u) * ALPHA + v1[1]);
                    w.w = cvt_pk_bf16(__uint_as_float(xb.w << 16) * ALPHA + v1[2], __uint_as_float(xb.w & 0xffff0000u) * ALPHA + v1[3]);
                    *(u32x4*)(Y1 + o) = w; } }
    }
};
struct EpiB16m {
    static constexpr bool PERM = true, AFTER_DRAIN = false;
    bf16_t* C; int ldc;
    __device__ __forceinline__ void operator()(const f32x4 (&acc)[2][2][4][2], const Unit& u, int wr, int wc, int fr, int fq) const {
        const int row0 = u.pm * BM + wr * 64 + fr, col0 = u.pn * BM + wc * 32 + 8 * fq;
#pragma unroll
        for (int ai = 0; ai < 2; ++ai)
#pragma unroll
            for (int m = 0; m < 4; ++m) { if (ai == 1 && u.pm * BM + HALF >= M_VALID) continue; bf16_t* rowp = C + (size_t)(row0 + ai * HALF + m * 16) * ldc + col0;
#pragma unroll
                for (int bj = 0; bj < 2; ++bj) { const f32x4 v0 = acc[ai][bj][m][0], v1 = acc[ai][bj][m][1]; u32x4 w;
                    w.x = cvt_pk_bf16(v0[0], v0[1]); w.y = cvt_pk_bf16(v0[2], v0[3]); w.z = cvt_pk_bf16(v1[0], v1[1]); w.w = cvt_pk_bf16(v1[2], v1[3]);
                    *(u32x4*)(rowp + bj * HALF) = w; } }
    }
};
struct EpiB16n {
    static constexpr bool PERM = false, AFTER_DRAIN = false;
    bf16_t* C; int ldc;
    __device__ __forceinline__ void operator()(const f32x4 (&acc)[2][2][4][2], const Unit& u, int wr, int wc, int fr, int fq) const {
        const int row0 = u.pm * BM + wr * 64 + fr, col0 = u.pn * BM + wc * 32 + 4 * fq;
#pragma unroll
        for (int ai = 0; ai < 2; ++ai)
#pragma unroll
            for (int m = 0; m < 4; ++m) { if (ai == 1 && u.pm * BM + HALF >= M_VALID) continue; bf16_t* rowp = C + (size_t)(row0 + ai * HALF + m * 16) * ldc + col0;
#pragma unroll
                for (int bj = 0; bj < 2; ++bj)
#pragma unroll
                    for (int n = 0; n < 2; ++n) { const f32x4 v = acc[ai][bj][m][n]; *(unsigned long long*)(rowp + bj * HALF + n * 16) = (unsigned long long)cvt_pk_bf16(v[0], v[1]) | ((unsigned long long)cvt_pk_bf16(v[2], v[3]) << 32); } }
    }
};
struct EpiF32m {
    static constexpr bool PERM = false, AFTER_DRAIN = false;
    float* C; int ldc;
    __device__ __forceinline__ void operator()(const f32x4 (&acc)[2][2][4][2], const Unit& u, int wr, int wc, int fr, int fq) const {
        const int row0 = u.pm * BM + wr * 64 + fr, col0 = u.pn * BM + wc * 32 + 4 * fq;
#pragma unroll
        for (int ai = 0; ai < 2; ++ai)
#pragma unroll
            for (int m = 0; m < 4; ++m) { if (ai == 1 && u.pm * BM + HALF >= M_VALID) continue; float* rowp = C + (size_t)(row0 + ai * HALF + m * 16) * ldc + col0;
#pragma unroll
                for (int bj = 0; bj < 2; ++bj)
#pragma unroll
                    for (int n = 0; n < 2; ++n) *(f32x4*)(rowp + bj * HALF + n * 16) = acc[ai][bj][m][n]; }
    }
};
struct EpiQGate {
    static constexpr bool PERM = false, AFTER_DRAIN = false;
    float* QP; float* PLE; float* PLEO; int nq;
    __device__ __forceinline__ void operator()(const f32x4 (&acc)[2][2][4][2], const Unit& u, int wr, int wc, int fr, int fq) const {
        const int row0 = u.pm * BM + wr * 64 + fr; const bool isq = u.pn < nq; const size_t odelta = PLEO - PLE; const int col0 = (isq ? u.pn : u.pn - nq) * BM + wc * 32 + 4 * fq; const int ldc = isq ? NQ : D; float* base = isq ? QP : PLE;
#pragma unroll
        for (int ai = 0; ai < 2; ++ai)
#pragma unroll
            for (int m = 0; m < 4; ++m) { if (ai == 1 && u.pm * BM + HALF >= M_VALID) continue; float* rowp = base + (size_t)(row0 + ai * HALF + m * 16) * ldc + col0;
#pragma unroll
                for (int bj = 0; bj < 2; ++bj)
#pragma unroll
                    for (int n = 0; n < 2; ++n) { f32x4 v = acc[ai][bj][m][n]; float* p = rowp + bj * HALF + n * 16;
#if USE_ROUTE_FAST
                        if (isq) { bf16_t* qh = (bf16_t*)QP + (size_t)(row0 + ai * HALF + m * 16) * NQ + col0 + bj * HALF + n * 16; bf16_t* ql = qh + (size_t)MP * NQ;
                            const unsigned h0 = cvt_pk_bf16(v[0], v[1]), h1 = cvt_pk_bf16(v[2], v[3]);
                            const unsigned l0 = cvt_pk_bf16(v[0] - __uint_as_float(h0 << 16), v[1] - __uint_as_float(h0 & 0xffff0000u)), l1 = cvt_pk_bf16(v[2] - __uint_as_float(h1 << 16), v[3] - __uint_as_float(h1 & 0xffff0000u));
                            *(unsigned long long*)qh = (unsigned long long)h0 | ((unsigned long long)h1 << 32); *(unsigned long long*)ql = (unsigned long long)l0 | ((unsigned long long)l1 << 32); continue; }
#endif
                        { const unsigned long long ppv = *(const unsigned long long*)((const bf16_t*)PLE + (size_t)(row0 + ai * HALF + m * 16) * D + col0 + bj * HALF + n * 16); const unsigned pl = (unsigned)ppv, ph = (unsigned)(ppv >> 32);
                          const float p0 = __uint_as_float(pl << 16), p1 = __uint_as_float(pl & 0xffff0000u), p2 = __uint_as_float(ph << 16), p3 = __uint_as_float(ph & 0xffff0000u);
                          v[0] = p0 * __builtin_amdgcn_rcpf(1.f + __expf(-v[0])); v[1] = p1 * __builtin_amdgcn_rcpf(1.f + __expf(-v[1])); v[2] = p2 * __builtin_amdgcn_rcpf(1.f + __expf(-v[2])); v[3] = p3 * __builtin_amdgcn_rcpf(1.f + __expf(-v[3]));
                          *(unsigned long long*)((bf16_t*)PLEO + (size_t)(row0 + ai * HALF + m * 16) * D + col0 + bj * HALF + n * 16) = (unsigned long long)cvt_pk_bf16(v[0], v[1]) | ((unsigned long long)cvt_pk_bf16(v[2], v[3]) << 32); } } }
    }
};
template <class Epi, class Sched, bool ALIGN_EPI = false, bool SP2 = false, bool MX = false>
__device__ __forceinline__ void gemm_phase(PG8_LAS unsigned char* lds, const Gemm g, const Sched& S, const Epi& E) {
    const int tid = threadIdx.x, wid = __builtin_amdgcn_readfirstlane(tid >> 6), lane = tid & 63, wr = wid >> 2, wc = wid & 3, fr = lane & 15, fq = lane >> 4;
    const int K = g.K, nt = K / BK;
    unsigned voffA[2], voffB[2];
#pragma unroll
    for (int i = 0; i < 2; ++i) { int R, C; stage_rc(tid * 16 + i * 8192, R, C); const int Rb = Epi::PERM ? ((R & ~31) + perm32(R & 31)) : R;
        voffA[i] = (unsigned)(R * K + C) * 2u; voffB[i] = (unsigned)(Rb * K + C) * 2u; }
    const size_t kstep = (size_t)(BK * 2);
    const size_t hstep = (size_t)HALF * K * 2;
    const size_t tstep = 2 * hstep;
    const unsigned ldsw = (unsigned)wid * 1024u;
    const int aoff = lds_byte(wr * 64 + fr, fq * 8), boff = lds_byte(wc * 32 + fr, fq * 8);
#define PG8_SA(b, h) (((b) * 2 + (h)) * HTB)
#define PG8_SB(b, h) ((4 + (b) * 2 + (h)) * HTB)
#define PG8_STAGE(bufoff, gbase, voff) do { _Pragma("unroll") for (int _i = 0; _i < 2; ++_i) \
        __builtin_amdgcn_global_load_lds((const unsigned*)((const char*)(gbase) + (voff)[_i]), (PG8_LAS unsigned*)(lds + (bufoff) + ldsw + _i * 8192), 16, 0, 0); } while (0)
#define PG8_LDA(dst, b, h) do { _Pragma("unroll") for (int m = 0; m < 4; ++m) { \
        if constexpr (MX) { const v4i_t _lo = *(const PG8_LAS v4i_t*)(lds + PG8_SA(b, h) + aoff + m * 2048), _hi = *(const PG8_LAS v4i_t*)(lds + PG8_SA(b, h) + aoff + m * 2048 + 1024); dst##8[m] = __builtin_shufflevector(_lo, _hi, 0, 1, 2, 3, 4, 5, 6, 7); } \
        else { _Pragma("unroll") for (int k = 0; k < 2; ++k) dst[m][k] = *(const PG8_LAS bf16x8*)(lds + PG8_SA(b, h) + aoff + m * 2048 + k * 1024); } } } while (0)
#define PG8_LDB(dst, b, h) do { _Pragma("unroll") for (int n = 0; n < 2; ++n) { \
        if constexpr (MX) { const v4i_t _lo = *(const PG8_LAS v4i_t*)(lds + PG8_SB(b, h) + boff + n * 2048), _hi = *(const PG8_LAS v4i_t*)(lds + PG8_SB(b, h) + boff + n * 2048 + 1024); dst##8[n] = __builtin_shufflevector(_lo, _hi, 0, 1, 2, 3, 4, 5, 6, 7); } \
        else { _Pragma("unroll") for (int k = 0; k < 2; ++k) dst[n][k] = *(const PG8_LAS bf16x8*)(lds + PG8_SB(b, h) + boff + n * 2048 + k * 1024); } } } while (0)
#define PG8_MMA(ai, bj, At, Bt) do { __builtin_amdgcn_s_setprio(1); _Pragma("unroll") for (int m = 0; m < 4; ++m) _Pragma("unroll") for (int n = 0; n < 2; ++n) { \
        if constexpr (MX) asm volatile("v_mfma_scale_f32_16x16x128_f8f6f4 %0, %1, %2, %0, %3, %4 op_sel_hi:[0,0,0]" : "+v"(acc[ai][bj][m][n]) : "v"(Bt##8[n]), "v"(At##8[m]), "v"(mx_ws), "v"(mx_one));   \
        else { _Pragma("unroll") for (int k = 0; k < 2; ++k) acc[ai][bj][m][n] = __builtin_amdgcn_mfma_f32_16x16x32_bf16(Bt[n][k], At[m][k], acc[ai][bj][m][n], 0, 0, 0); } } __builtin_amdgcn_s_setprio(0); } while (0)
#define PG8_WAIT_V(n) asm volatile("s_waitcnt vmcnt(" #n ")" ::: "memory")
#define PG8_WAIT_L(n) asm volatile("s_waitcnt lgkmcnt(" #n ")" ::: "memory")
#define PG8_BAR __builtin_amdgcn_s_barrier()
#define PG8_SCHED __builtin_amdgcn_sched_barrier(0)
    Unit cur, nxt; int ui = 0;
    if (!S.next(0, cur)) return;
    f32x4 acc[2][2][4][2];
#pragma unroll
    for (int a = 0; a < 2; ++a)
#pragma unroll
        for (int b = 0; b < 2; ++b)
#pragma unroll
            for (int m = 0; m < 4; ++m)
#pragma unroll
                for (int n = 0; n < 2; ++n) acc[a][b][m][n] = (f32x4){0.f, 0.f, 0.f, 0.f};
    bf16x8 At[4][2], B0[2][2], B1[2][2];
    v8i_t At8[4], B08[2], B18[2];
    const int mx_ws = g.wscale, mx_one = 0x7f7f7f7f;
    const char* cA = (const char*)g.A + (size_t)cur.pm * tstep; const char* cB = (const char*)g.Bt + (size_t)cur.pn * tstep;
    S.a_ready(cur);
    if constexpr (SP2) {
        PG8_STAGE(PG8_SB(0, 0), cB, voffB); PG8_STAGE(PG8_SB(0, 1), cB + hstep, voffB); PG8_STAGE(PG8_SA(0, 0), cA, voffA); PG8_STAGE(PG8_SA(0, 1), cA + hstep, voffA);
        if (wr == 1) PG8_BAR;
        PG8_WAIT_V(2); PG8_BAR;
        PG8_STAGE(PG8_SB(1, 0), cB + kstep, voffB); PG8_STAGE(PG8_SA(1, 0), cA + kstep, voffA); PG8_STAGE(PG8_SB(1, 1), cB + hstep + kstep, voffB);
        PG8_WAIT_V(6); PG8_BAR;
    } else {
        PG8_STAGE(PG8_SB(0, 0), cB, voffB); PG8_STAGE(PG8_SA(0, 0), cA, voffA); PG8_STAGE(PG8_SB(0, 1), cB + hstep, voffB); PG8_STAGE(PG8_SA(0, 1), cA + hstep, voffA);
        if (wr == 1) PG8_BAR;
        PG8_WAIT_V(4); PG8_BAR;
        PG8_STAGE(PG8_SB(1, 0), cB + kstep, voffB); PG8_STAGE(PG8_SA(1, 0), cA + kstep, voffA); PG8_STAGE(PG8_SB(1, 1), cB + hstep + kstep, voffB);
        PG8_WAIT_V(6); PG8_BAR;
    }
    for (;;) {
        const bool has_next = S.next(ui + 1, nxt);
        const bool half = (cur.pm * BM + HALF >= M_VALID);
        const char* nA = has_next ? (const char*)g.A + (size_t)nxt.pm * tstep : cA; const char* nB = has_next ? (const char*)g.Bt + (size_t)nxt.pn * tstep : cB;
        for (int t = 0; t < nt; t += 2) {
            const bool last = (t == nt - 2);
            const char* a1 = cA + (size_t)(t + 1) * kstep;
            const char* a2 = last ? nA : cA + (size_t)(t + 2) * kstep; const char* b2 = last ? nB : cB + (size_t)(t + 2) * kstep;
            const char* a3 = a2 + kstep; const char* b3 = b2 + kstep;
            if (last && has_next) S.a_ready(nxt);
            if constexpr (SP2) {
            PG8_LDB(B0, 0, 0); PG8_LDB(B1, 0, 1); PG8_SCHED; PG8_LDA(At, 0, 0); PG8_STAGE(PG8_SA(1, 1), a1 + hstep, voffA);
            PG8_WAIT_V(8); PG8_WAIT_L(0); PG8_BAR; PG8_MMA(0, 0, At, B0); PG8_MMA(0, 1, At, B1); PG8_BAR; PG8_SCHED;
            PG8_LDA(At, 0, 1); PG8_STAGE(PG8_SB(0, 0), b2, voffB); PG8_STAGE(PG8_SB(0, 1), b2 + hstep, voffB); PG8_STAGE(PG8_SA(0, 0), a2, voffA);
            PG8_WAIT_V(8); PG8_WAIT_L(0); PG8_BAR; if (!half) { PG8_MMA(1, 0, At, B0); PG8_MMA(1, 1, At, B1); } PG8_BAR; PG8_SCHED;
            PG8_LDB(B0, 1, 0); PG8_LDB(B1, 1, 1); PG8_SCHED; PG8_LDA(At, 1, 0); PG8_STAGE(PG8_SA(0, 1), a2 + hstep, voffA);
            PG8_WAIT_V(8); PG8_WAIT_L(0); PG8_BAR; PG8_MMA(0, 0, At, B0); PG8_MMA(0, 1, At, B1); PG8_BAR; PG8_SCHED;
            PG8_LDA(At, 1, 1); PG8_STAGE(PG8_SB(1, 0), b3, voffB); PG8_STAGE(PG8_SB(1, 1), b3 + hstep, voffB); PG8_STAGE(PG8_SA(1, 0), a3, voffA);
            PG8_WAIT_V(8); PG8_WAIT_L(0); PG8_BAR; if (!half) { PG8_MMA(1, 0, At, B0); PG8_MMA(1, 1, At, B1); } PG8_BAR; PG8_SCHED;
            } else {
            PG8_LDB(B0, 0, 0); PG8_SCHED; PG8_LDA(At, 0, 0); PG8_STAGE(PG8_SA(1, 1), a1 + hstep, voffA);
            PG8_WAIT_L(8); PG8_BAR; PG8_WAIT_L(0); PG8_MMA(0, 0, At, B0); PG8_BAR; PG8_SCHED;
            PG8_LDB(B1, 0, 1); PG8_STAGE(PG8_SB(0, 0), b2, voffB);
            PG8_BAR; PG8_WAIT_L(0); PG8_MMA(0, 1, At, B1); PG8_BAR;
            PG8_LDA(At, 0, 1); PG8_STAGE(PG8_SA(0, 0), a2, voffA);
            PG8_BAR; PG8_WAIT_L(0); PG8_MMA(1, 0, At, B0); PG8_BAR; PG8_SCHED;
            PG8_STAGE(PG8_SB(0, 1), b2 + hstep, voffB);
            PG8_WAIT_V(6); PG8_BAR; PG8_MMA(1, 1, At, B1); PG8_BAR;
            PG8_LDB(B0, 1, 0); PG8_SCHED; PG8_LDA(At, 1, 0); PG8_STAGE(PG8_SA(0, 1), a2 + hstep, voffA);
            PG8_WAIT_L(8); PG8_BAR; PG8_WAIT_L(0); PG8_MMA(0, 0, At, B0); PG8_BAR; PG8_SCHED;
            PG8_LDB(B1, 1, 1); PG8_STAGE(PG8_SB(1, 0), b3, voffB);
            PG8_BAR; PG8_WAIT_L(0); PG8_MMA(0, 1, At, B1); PG8_BAR;
            PG8_LDA(At, 1, 1); PG8_STAGE(PG8_SA(1, 0), a3, voffA);
            PG8_BAR; PG8_WAIT_L(0); PG8_MMA(1, 0, At, B0); PG8_BAR; PG8_SCHED;
            PG8_STAGE(PG8_SB(1, 1), b3 + hstep, voffB);
            PG8_WAIT_V(6); PG8_BAR; PG8_MMA(1, 1, At, B1); PG8_BAR;
            }
        }
        if constexpr (MX) asm volatile("s_nop 15\n\ts_nop 15" ::: "memory");
        if constexpr (ALIGN_EPI) { if (wr == 0) PG8_BAR; }
        if constexpr (!Epi::AFTER_DRAIN) { E(acc, cur, wr, wc, fr, fq); S.done(cur); }
        if (!has_next) break;
#pragma unroll
        for (int a = 0; a < 2; ++a)
#pragma unroll
            for (int b = 0; b < 2; ++b)
#pragma unroll
                for (int m = 0; m < 4; ++m)
#pragma unroll
                    for (int n = 0; n < 2; ++n) acc[a][b][m][n] = (f32x4){0.f, 0.f, 0.f, 0.f};
        cur = nxt; cA = nA; cB = nB; ++ui;
        if constexpr (ALIGN_EPI) { if (wr == 1) PG8_BAR; }
    }
    PG8_WAIT_V(0);
    if constexpr (!ALIGN_EPI) { if (wr == 0) PG8_BAR; }
    PG8_BAR;
    if constexpr (Epi::AFTER_DRAIN) { E.fused(acc, cur, wr, wc, fr, fq, lds, wid, lane); S.done(cur); }
#undef PG8_SA
#undef PG8_SB
#undef PG8_STAGE
#undef PG8_LDA
#undef PG8_LDB
#undef PG8_MMA
#undef PG8_WAIT_V
#undef PG8_WAIT_L
#undef PG8_BAR
#undef PG8_SCHED
}
}

struct Args {
    const float* in[28]; float* out; unsigned char* ws;
    double inv[128];
    int ph_lo, ph_hi;
};
enum { I_XP = 0, I_XS, I_SRET, I_SCONV, I_SC, I_SN, I_SM, I_PP, I_PS, I_LNEG, I_LNEB, I_WIN, I_BG, I_CW, I_CB, I_GRN, I_GMN, I_WOUT, I_LN1G, I_LN1B,
       I_WPQ, I_SUBK, I_PU, I_PV, I_WPG, I_WPP, I_LN2G, I_LN2B };

__device__ __forceinline__ void p0_transpose_item(const float* W, int ldw, int col0, int K, int nblk, bf16* WT, LAS float* scr, int item, int lane) {
    const int kb = item / nblk, nb = item % nblk, k0 = 64 * kb, n0 = 32 * nb;
#pragma unroll 1
    for (int hb = 0; hb < 2; ++hb) { float wv[16];
#pragma unroll
        for (int i = 0; i < 16; ++i) wv[i] = W[(size_t)(k0 + 2 * (16 * hb + i) + (lane >> 5)) * ldw + col0 + n0 + (lane & 31)];
#pragma unroll
        for (int i = 0; i < 16; ++i) scr[(2 * (16 * hb + i) + (lane >> 5)) * 33 + (lane & 31)] = wv[i]; }
    LDS_WAIT(); asm volatile("" ::: "memory");
    const int c = lane & 7;
#pragma unroll
    for (int j = 0; j < 4; ++j) { const int n = (lane >> 3) + 8 * j; const LAS float* s = scr + (8 * c) * 33 + n;
        v4u o; o.x = pk2(s[0 * 33], s[1 * 33]); o.y = pk2(s[2 * 33], s[3 * 33]); o.z = pk2(s[4 * 33], s[5 * 33]); o.w = pk2(s[6 * 33], s[7 * 33]);
        *(v4u*)(WT + (size_t)(n0 + n) * K + k0 + 8 * c) = o; }
    LDS_WAIT(); asm volatile("" ::: "memory");
}
__device__ __forceinline__ unsigned pack4_fp8(float a0, float a1, float a2, float a3) {
    a0 = fminf(fmaxf(a0, -448.f), 448.f); a1 = fminf(fmaxf(a1, -448.f), 448.f); a2 = fminf(fmaxf(a2, -448.f), 448.f); a3 = fminf(fmaxf(a3, -448.f), 448.f);
    int p = __builtin_amdgcn_cvt_pk_fp8_f32(a0, a1, 0, false); p = __builtin_amdgcn_cvt_pk_fp8_f32(a2, a3, p, true); return (unsigned)p;
}
__device__ __forceinline__ void p0_transpose_item_fp8(const float* W, int ldw, int col0, int K, int nblk, unsigned char* WT, float scl, LAS float* scr, int item, int lane) {
    const int kb = item / nblk, nb = item % nblk, k0 = 64 * kb, n0 = 32 * nb;
#pragma unroll 1
    for (int hb = 0; hb < 2; ++hb) { float wv[16];
#pragma unroll
        for (int i = 0; i < 16; ++i) wv[i] = W[(size_t)(k0 + 2 * (16 * hb + i) + (lane >> 5)) * ldw + col0 + n0 + (lane & 31)];
#pragma unroll
        for (int i = 0; i < 16; ++i) scr[(2 * (16 * hb + i) + (lane >> 5)) * 33 + (lane & 31)] = wv[i]; }
    LDS_WAIT(); asm volatile("" ::: "memory");
    const int c = lane & 7;
#pragma unroll
    for (int j = 0; j < 4; ++j) { const int n = (lane >> 3) + 8 * j; const LAS float* s = scr + (8 * c) * 33 + n;
        const unsigned lo = pack4_fp8(s[0 * 33] * scl, s[1 * 33] * scl, s[2 * 33] * scl, s[3 * 33] * scl), hi = pack4_fp8(s[4 * 33] * scl, s[5 * 33] * scl, s[6 * 33] * scl, s[7 * 33] * scl);
        *(unsigned long long*)(WT + (size_t)(n0 + n) * K + k0 + 8 * c) = (unsigned long long)lo | ((unsigned long long)hi << 32); }
    LDS_WAIT(); asm volatile("" ::: "memory");
}
template <bool IN_BF16 = false>
__device__ __forceinline__ void ln_row_bf16(const void* xrow, const float* g, const float* b, bf16* orow, int lane, bf16* sl = nullptr, int m = 0, unsigned char* x8row = nullptr) {
    f32x4 v[16]; float s = 0.f;
#pragma unroll
    for (int j = 0; j < 16; ++j) {
        if (IN_BF16) { const unsigned long long xb = ((const unsigned long long*)xrow)[lane + 64 * j];
            v[j] = (f32x4){bf2f((unsigned)xb & 0xffffu), bf2f(((unsigned)xb) >> 16), bf2f((unsigned)(xb >> 32) & 0xffffu), bf2f((unsigned)(xb >> 48))}; }
        else v[j] = ((const f32x4*)xrow)[lane + 64 * j];
        s += (v[j].x + v[j].y) + (v[j].z + v[j].w); }
    const float mean = wave_sum(s) * (1.f / D); float s2 = 0.f;
#pragma unroll
    for (int j = 0; j < 16; ++j) { v[j] = v[j] - mean; s2 += (v[j].x * v[j].x + v[j].y * v[j].y) + (v[j].z * v[j].z + v[j].w * v[j].w); }
    const float rstd = 1.f / sqrtf(wave_sum(s2) * (1.f / D) + LN_EPS);
    unsigned long long* o8 = (unsigned long long*)orow + lane;
#pragma unroll
    for (int j = 0; j < 16; ++j) { const f32x4 gg = ((const f32x4*)g)[lane + 64 * j], bb = ((const f32x4*)b)[lane + 64 * j]; const f32x4 y = v[j] * rstd * gg + bb;
        const unsigned long long pk = (unsigned long long)pk2(y.x, y.y) | ((unsigned long long)pk2(y.z, y.w) << 32);
        o8[64 * j] = pk;
        if (sl) *(unsigned long long*)(sl + ((size_t)(2 * j + (lane >> 5)) * MP + m) * 128 + (lane & 31) * 4) = pk;
        if (x8row) ((unsigned*)x8row)[lane + 64 * j] = pack4_fp8(y.x, y.y, y.z, y.w); }
}
__device__ __forceinline__ void phase_prologue(const Args& a, LAS unsigned char* lds) {
    const int tid = threadIdx.x, lane = tid & 63, wave = tid >> 6;
    const int gw = blockIdx.x * NWAVES + wave, NGW = gridDim.x * NWAVES;
    const int gt = blockIdx.x * NTHR + tid, NGT = gridDim.x * NTHR;
    unsigned char* ws = a.ws;
    LAS float* scr = (LAS float*)(lds + wave * 16384);
    for (int it = gw; it < 64 * 512; it += NGW) p0_transpose_item(a.in[I_WIN], INC, 0, D, 512, (bf16*)(ws + WS_WIN), scr, it, lane);
    { bf16* WGH = (bf16*)(ws + WS_WG); bf16* WGL = WGH + 16 * D;
      for (int j = gt; j < 16 * D; j += NGT) { const int g = j >> 12, k = j & (D - 1); const float x = a.in[I_WIN][(size_t)k * INC + NZ + g]; const unsigned hi = f2bf(x); WGH[j] = (bf16)hi; WGL[j] = (bf16)f2bf(x - bf2f(hi)); } }
    bf16* XN = (bf16*)(ws + WS_XN);
    for (int m = gw; m < MP; m += NGW) {
        if (m < M) { const float* xr = (m < NP) ? a.in[I_XP] + (size_t)m * D : a.in[I_XS] + (size_t)(m - NP) * D; ln_row_bf16(xr, a.in[I_LNEG], a.in[I_LNEB], XN + (size_t)m * D, lane); }
        else { v4u z = {0u, 0u, 0u, 0u}; for (int j = lane; j < D / 8; j += 64) ((v4u*)(XN + (size_t)m * D))[j] = z; }
    }
    if (USE_MX) { unsigned char* MIXp = ws + WS_MIX + (size_t)M * D; v4u z = {0u, 0u, 0u, 0u}; for (int j = gt; j < (MP - M) * D / 16; j += NGT) ((v4u*)MIXp)[j] = z; }
    else { bf16* MIXp = (bf16*)(ws + WS_MIX) + (size_t)M * D; v4u z = {0u, 0u, 0u, 0u}; for (int j = gt; j < (MP - M) * D / 8; j += NGT) ((v4u*)MIXp)[j] = z; }
    { bf16* P16 = (bf16*)(ws + WS_P16);
      for (int j = gt; j < MP * PLE_D / 2; j += NGT) { const int m = j / (PLE_D / 2), c = (j % (PLE_D / 2)) * 2; unsigned o = 0u;
          if (m < M) { const float* pr = (m < NP) ? a.in[I_PP] + (size_t)m * PLE_D : a.in[I_PS] + (size_t)(m - NP) * PLE_D; o = pk2(pr[c], pr[c + 1]); }
          ((unsigned*)P16)[j] = o; } }
    { bf16* KH = (bf16*)(ws + WS_KH); bf16* KL = KH + 16 * 128 * 128; const float* SK = a.in[I_SUBK];
      for (int j = gt; j < 16 * 128 * 128; j += NGT) { const float x = SK[j]; const unsigned hi = f2bf(x); KH[j] = (bf16)hi; KL[j] = (bf16)f2bf(x - bf2f(hi)); } }
    { float* cs = (float*)(ws + WS_ROPE); float* sn = cs + 2049 * 128;
      for (int j = gt; j < 2049 * 128; j += NGT) { const int pi = j >> 7, i = j & 127; const double pos = (pi < 2048) ? (double)pi : (double)PAST_LEN;
          const double rev = pos * a.inv[i] * 0.15915494309189535;
          const double fr = rev - floor(rev);
          const float ang = (float)(fr * 6.283185307179586);
          cs[j] = cosf(ang); sn[j] = sinf(ang); } }
}

template <class Epi>
__device__ __forceinline__ void slow_gemm(LAS unsigned char* ldsb, const bf16* A, const bf16* Bt, int Mrows, int N, int K, const Epi& epi) {
    LAS float* As = (LAS float*)ldsb; LAS float* Bs = As + 32 * 132;
    const int tid = threadIdx.x, ty = tid >> 4, tx = tid & 15;
    const int ntm = Mrows / 128, ntn = N / 128;
    for (int tile = blockIdx.x; tile < ntm * ntn; tile += gridDim.x) {
        const int tm = tile / ntn, tn = tile % ntn, m0 = tm * 128, n0 = tn * 128;
        float acc[4][8];
#pragma unroll
        for (int i = 0; i < 4; ++i)
#pragma unroll
            for (int j = 0; j < 8; ++j) acc[i][j] = 0.f;
        const int r = tid >> 2, c = tid & 3;
        for (int k0 = 0; k0 < K; k0 += 32) {
            const v4u av = *(const v4u*)(A + (size_t)(m0 + r) * K + k0 + 8 * c);
            const v4u bv = *(const v4u*)(Bt + (size_t)(n0 + r) * K + k0 + 8 * c);
            __syncthreads();
#pragma unroll
            for (int i = 0; i < 4; ++i) {
                As[(8 * c + 2 * i) * 132 + r] = bf2f(av[i] & 0xffffu); As[(8 * c + 2 * i + 1) * 132 + r] = bf2f(av[i] >> 16);
                Bs[(8 * c + 2 * i) * 132 + r] = bf2f(bv[i] & 0xffffu); Bs[(8 * c + 2 * i + 1) * 132 + r] = bf2f(bv[i] >> 16);
            }
            __syncthreads();
#pragma unroll 8
            for (int kk = 0; kk < 32; ++kk) {
                const f32x4 av4 = *(const LAS f32x4*)(As + kk * 132 + ty * 4);
                const f32x4 b0 = *(const LAS f32x4*)(Bs + kk * 132 + tx * 8), b1 = *(const LAS f32x4*)(Bs + kk * 132 + tx * 8 + 4);
#pragma unroll
                for (int i = 0; i < 4; ++i) {
#pragma unroll
                    for (int j = 0; j < 4; ++j) { acc[i][j] += av4[i] * b0[j]; acc[i][4 + j] += av4[i] * b1[j]; }
                }
            }
        }
#pragma unroll
        for (int i = 0; i < 4; ++i)
#pragma unroll
            for (int j = 0; j < 8; ++j) epi(m0 + ty * 4 + i, n0 + tx * 8 + j, acc[i][j]);
        __syncthreads();
    }
}

constexpr float WO8_SCALE = 256.f; constexpr int WO8_E8M0 = 0x77777777;
constexpr float WG8_SCALE = 128.f; constexpr int WG8_E8M0 = 0x78787878;
constexpr float U8_SCALE = 256.f;
constexpr float V8_SCALE = 16.f;
constexpr int BG_T1Q = 64 * 128 + 64 * 64;
constexpr int BG_TS = BG_T1Q + 64 * 64;
constexpr int BG_T1 = 64 * 128  , BG_T2 = BG_T1 + 64 * 64 + 64 * 128  , BG_TN = BG_T2 + 4 * 128  ;
__device__ __forceinline__ void bg_transposes(const Args& a, LAS unsigned char* lds, int it_lo, int it_hi, int widx, int nw) {
    unsigned char* ws = a.ws; const int lane = threadIdx.x & 63, wave = threadIdx.x >> 6; LAS float* scr = (LAS float*)(lds + wave * 16384);
    constexpr int I_OUT = 64 * 128, I_Q = 64 * 64, I_GT = 64 * 128, I_PR = 4 * 128;
    for (int it = it_lo + widx; it < it_hi; it += nw) { int r = it;
#if USE_MX
        if (r < I_OUT) { p0_transpose_item_fp8(a.in[I_WOUT], D, 0, D, 128, ws + WS_WOUT, WO8_SCALE, scr, r, lane); continue; } r -= I_OUT;
#else
        if (r < I_OUT) { p0_transpose_item(a.in[I_WOUT], D, 0, D, 128, (bf16*)(ws + WS_WOUT), scr, r, lane); continue; } r -= I_OUT;
#endif
        if (r < I_Q) { p0_transpose_item(a.in[I_WPQ], NQ, 0, D, 64, (bf16*)(ws + WS_W3), scr, r, lane); continue; } r -= I_Q;
#if USE_MX
        if (r < I_GT) { p0_transpose_item_fp8(a.in[I_WPG], D, 0, D, 128, ws + WS_W3 + (size_t)NQ * D * 2, WG8_SCALE, scr, r, lane); continue; } r -= I_GT;
#else
        if (r < I_GT) { p0_transpose_item(a.in[I_WPG], D, 0, D, 128, (bf16*)(ws + WS_W3) + (size_t)NQ * D, scr, r, lane); continue; } r -= I_GT;
#endif
        p0_transpose_item(a.in[I_WPP], D, 0, PLE_D, 128, (bf16*)(ws + WS_WP), scr, r, lane); }
}
__device__ __forceinline__ void bg_tables(const Args& a, int row_lo, int row_hi, int widx, int nw) {
    unsigned char* ws = a.ws; const int lane = threadIdx.x & 63;
    for (int e2 = row_lo + widx; e2 < row_hi; e2 += nw) { const int e = e2 & (NEXP - 1); const bool isv = e2 >= NEXP; const float* src = (isv ? a.in[I_PV] : a.in[I_PU]) + (size_t)e * D;
        f32x4 rv[16];
#pragma unroll
        for (int j = 0; j < 16; ++j) rv[j] = __builtin_nontemporal_load((const f32x4*)src + j * 64 + lane);
        { unsigned char* dst = ws + (isv ? WS_VB : WS_UB); const float scl = isv ? V8_SCALE : U8_SCALE;
#pragma unroll
            for (int j = 0; j < 16; ++j) { f32x4 v = rv[j] * scl; v = __builtin_elementwise_min(__builtin_elementwise_max(v, (f32x4){-448.f, -448.f, -448.f, -448.f}), (f32x4){448.f, 448.f, 448.f, 448.f});
                int p = __builtin_amdgcn_cvt_pk_fp8_f32(v.x, v.y, 0, false); p = __builtin_amdgcn_cvt_pk_fp8_f32(v.z, v.w, p, true);
                const int s = j * 2 + (lane >> 5);
                __builtin_nontemporal_store((unsigned)p, (unsigned*)(dst + ((size_t)s * NEXP + e) * 128 + (lane & 31) * 4)); } }
    }
}
__device__ __forceinline__ void idle_rank(int nunits, int& rank, int& count) { const int G = (int)gridDim.x, rem = nunits % G; if (rem == 0) { rank = (int)blockIdx.x; count = G; } else { rank = (int)blockIdx.x - rem; count = G - rem; } }
__device__ __forceinline__ void gates_mfma(const Args& a, int widx, int nw) {
    unsigned char* ws = a.ws; const int lane = threadIdx.x & 63, r = lane & 31, hh = lane >> 5;
    const bf16* XN = (const bf16*)(ws + WS_XN); const bf16* WGH = (const bf16*)(ws + WS_WG); const bf16* WGL = WGH + 16 * D; float* G = (float*)(ws + WS_G);
    for (int u = widx; u < (M / 32) * 4; u += nw) { const int t0 = (u >> 2) * 32, kq = u & 3;
        f32x16 acc;
#pragma unroll
        for (int q = 0; q < 16; ++q) acc[q] = 0.f;
        const bf16* ap = XN + (size_t)(t0 + r) * D + kq * (D / 4) + 8 * hh; const bf16* bhp = WGH + (size_t)(r & 15) * D + kq * (D / 4) + 8 * hh; const bf16* blp = WGL + (size_t)(r & 15) * D + kq * (D / 4) + 8 * hh;
#pragma unroll 8
        for (int ks = 0; ks < D / 64; ++ks) { const bf16x8 af = *(const bf16x8*)(ap + ks * 16); bf16x8 bh = *(const bf16x8*)(bhp + ks * 16), bl = *(const bf16x8*)(blp + ks * 16);
            if (r >= 16) { const v4u z = {0u, 0u, 0u, 0u}; bh = __builtin_bit_cast(bf16x8, z); bl = bh; }
            acc = MFMA32(af, bh, acc); acc = MFMA32(af, bl, acc); }
        if (r < 16) { float* Gq = G + (size_t)kq * MP * 16;
#pragma unroll
            for (int q = 0; q < 16; ++q) Gq[(size_t)(t0 + (q & 3) + 8 * (q >> 2) + 4 * hh) * 16 + r] = acc[q]; }
    }
}

struct EpiZ { bf16* Z; __device__ __forceinline__ void operator()(int m, int n, float v) const { Z[(size_t)m * NZ + n] = (bf16)f2bf(v); } };
__device__ __forceinline__ void phase_gemm1(const Args& a, LAS unsigned char* lds) {
    unsigned char* ws = a.ws;
#if USE_MFMA
    { pg8::Gemm g{(const bf16*)(ws + WS_XN), (const bf16*)(ws + WS_WIN), MP, NZ, D}; pg8::TailOrder S; S.init(NP, NZ, (int)gridDim.x, (int)blockIdx.x);
      const float* cs = (const float*)(ws + WS_ROPE); pg8::EpiZRope E{(bf16*)(ws + WS_Z), cs, cs + 2049 * 128};
      pg8::gemm_phase<pg8::EpiZRope, pg8::TailOrder, true, true>(lds, g, S, E); }
#else
    EpiZ e{(bf16*)(ws + WS_Z)};
    slow_gemm(lds, (const bf16*)(ws + WS_XN), (const bf16*)(ws + WS_WIN), MP, NZ, D, e);
#endif
#if USE_MFMA
    { int rank, cnt; idle_rank((MP / 256) * (NZ / 256), rank, cnt);
      if (rank >= 0) { const int widx = rank * NWAVES + (int)(threadIdx.x >> 6), nw = cnt * NWAVES; gates_mfma(a, widx, nw); bg_transposes(a, lds, 0, BG_TS, widx, nw); bg_transposes(a, lds, BG_T2, BG_TN, widx, nw); } }
#else
    { const int wv = (int)(threadIdx.x >> 6), widx = (int)blockIdx.x * NWAVES + wv, nw = (int)gridDim.x * NWAVES; gates_mfma(a, widx, nw); bg_transposes(a, lds, 0, BG_TN, widx, nw); bg_tables(a, 0, 2 * NEXP, widx, nw); }
#endif
}

__device__ __forceinline__ void phase_rope_conv(const Args& a) {
    unsigned char* ws = a.ws; const int gt = blockIdx.x * NTHR + threadIdx.x, NGT = gridDim.x * NTHR;
    bf16* Z = (bf16*)(ws + WS_Z); const float* cs = (const float*)(ws + WS_ROPE); const float* sn = cs + 2049 * 128;
    if (!USE_MFMA) for (size_t j = gt; j < (size_t)M * 2048; j += NGT) {
        const int m = (int)(j >> 11), p = (int)(j & 2047), hh = p >> 7, i = p & 127;
        const int col = hh * 256 + i; const int pi = (m < NP) ? (m & (SEQ - 1)) : 2048;
        const float c = cs[pi * 128 + i], s = sn[pi * 128 + i];
        const float x1 = bf2f(Z[(size_t)m * NZ + col]), x2 = bf2f(Z[(size_t)m * NZ + col + 128]);
        float y1 = x1 * c - x2 * s, y2 = x1 * s + x2 * c;
        if (hh >= 8) { y1 *= 0.0625f; y2 *= 0.0625f; }
        Z[(size_t)m * NZ + col] = (bf16)f2bf(y1); Z[(size_t)m * NZ + col + 128] = (bf16)f2bf(y2);
    }
    bf16* MQK = (bf16*)(ws + WS_MQK); const float* cw = a.in[I_CW]; const float* cb = a.in[I_CB]; const float* sconv = a.in[I_SCONV];
    for (int j = gt; j < M * 512; j += NGT) {
        const int m = j >> 9, c = (j & 511) * 8;
        float acc[8];
        { const f32x4 b0 = *(const f32x4*)(cb + c), b1 = *(const f32x4*)(cb + c + 4); acc[0] = b0.x; acc[1] = b0.y; acc[2] = b0.z; acc[3] = b0.w; acc[4] = b1.x; acc[5] = b1.y; acc[6] = b1.z; acc[7] = b1.w; }
#pragma unroll
        for (int q = 0; q < 4; ++q) {
            float xv[8]; bool have = true;
            if (m < NP) { const int t = m & (SEQ - 1); have = (t - 3 + q) >= 0;
                if (have) { const v4u z = *(const v4u*)(Z + (size_t)(m - 3 + q) * NZ + ZMQK + c);
#pragma unroll
                    for (int i = 0; i < 4; ++i) { xv[2 * i] = bf2f(z[i] & 0xffffu); xv[2 * i + 1] = bf2f(z[i] >> 16); } } }
            else if (q < 3) { const float* sp = sconv + ((size_t)(m - NP) * 3 + q) * 4096 + c; const f32x4 s0 = *(const f32x4*)sp, s1 = *(const f32x4*)(sp + 4);
                xv[0] = s0.x; xv[1] = s0.y; xv[2] = s0.z; xv[3] = s0.w; xv[4] = s1.x; xv[5] = s1.y; xv[6] = s1.z; xv[7] = s1.w; }
            else { const v4u z = *(const v4u*)(Z + (size_t)m * NZ + ZMQK + c);
#pragma unroll
                for (int i = 0; i < 4; ++i) { xv[2 * i] = bf2f(z[i] & 0xffffu); xv[2 * i + 1] = bf2f(z[i] >> 16); } }
            if (have) { const f32x4 w0 = *(const f32x4*)(cw + q * 4096 + c), w1 = *(const f32x4*)(cw + q * 4096 + c + 4);
                acc[0] += w0.x * xv[0]; acc[1] += w0.y * xv[1]; acc[2] += w0.z * xv[2]; acc[3] += w0.w * xv[3]; acc[4] += w1.x * xv[4]; acc[5] += w1.y * xv[5]; acc[6] += w1.z * xv[6]; acc[7] += w1.w * xv[7]; }
        }
        const float sc = (c >= 2048) ? 0.0625f : 1.f;
        v4u o;
#pragma unroll
        for (int i = 0; i < 4; ++i) o[i] = pk2(siluf_(acc[2 * i]) * sc, siluf_(acc[2 * i + 1]) * sc);
        *(v4u*)(MQK + (size_t)m * 4096 + c) = o;
    }
    float* convp = a.out + O_CONVP; float* convs = a.out + O_CONVS;
    for (int j = gt; j < NPB * 3 * 1024; j += NGT) { const int b = j / (3 * 1024), q = (j >> 10) % 3, c = (j & 1023) * 4; const unsigned long long z = *(const unsigned long long*)(Z + (size_t)(b * SEQ + SEQ - 3 + q) * NZ + ZMQK + c);
        *(f32x4*)(convp + (size_t)j * 4) = (f32x4){bf2f((unsigned)z & 0xffffu), bf2f(((unsigned)z) >> 16), bf2f((unsigned)(z >> 32) & 0xffffu), bf2f((unsigned)(z >> 48))}; }
    for (int j = gt; j < NS * 3 * 1024; j += NGT) { const int b = j / (3 * 1024), q = (j >> 10) % 3, c = (j & 1023) * 4; f32x4 o;
        if (q < 2) o = *(const f32x4*)(sconv + ((size_t)b * 3 + q + 1) * 4096 + c);
        else { const unsigned long long z = *(const unsigned long long*)(Z + (size_t)(NP + b) * NZ + ZMQK + c); o = (f32x4){bf2f((unsigned)z & 0xffffu), bf2f(((unsigned)z) >> 16), bf2f((unsigned)(z >> 32) & 0xffffu), bf2f((unsigned)(z >> 48))}; }
        *(f32x4*)(convs + (size_t)j * 4) = o; }
}

__device__ __forceinline__ float block_sum256(float v, LAS float* red, int tid) {
    v = wave_sum(v);
    __syncthreads();
    if ((tid & 63) == 0) red[tid >> 6] = v;
    __syncthreads();
    return (red[0] + red[1]) + (red[2] + red[3]) + (red[4] + red[5]) + (red[6] + red[7]);
}
template <bool ML>
__device__ __forceinline__ void seq_mixer_unit(const Args& a, LAS unsigned char* ldsb, int row0, int T, int h, const float* S0, const float* n0p, const float* m0p,
                                               float* Sout, float* nout, float* mout) {
    LAS float* qs = (LAS float*)ldsb; LAS float* ks = qs + 256; LAS float* vs = ks + 256; LAS float* part = vs + 256  ; LAS float* red = part + 512  ;
    unsigned char* ws = a.ws; const bf16* Z = (const bf16*)(ws + WS_Z); const bf16* MQK = (const bf16*)(ws + WS_MQK); const float* G = (const float*)(ws + WS_G); bf16* MIX = (bf16*)(ws + WS_MIX);
    const int tid = threadIdx.x, e = tid & 255, hf = tid >> 8;
    float S[128];
#pragma unroll
    for (int dd = 0; dd < 128; ++dd) S[dd] = S0 ? S0[(size_t)(hf * 128 + dd) * 256 + e] : 0.f;
    float nvec = 0.f, mst = 0.f;
    if (ML) { if (n0p && tid < 256) nvec = n0p[tid]; if (m0p) mst = m0p[0]; }
    const float gamma = 1.f - exp2f(-5.f - (float)h);
    const float gn = ML ? a.in[I_GMN][h * 256 + e] : a.in[I_GRN][h * 256 + e];
    const float big = a.in[I_BG][h], bfg = a.in[I_BG][8 + h];
    for (int t = 0; t < T; ++t) {
        const int row = row0 + t;
        __syncthreads();
        if (tid < 256) {
            if (ML) { qs[tid] = bf2f(MQK[(size_t)row * 4096 + h * 256 + tid]); ks[tid] = bf2f(MQK[(size_t)row * 4096 + 2048 + h * 256 + tid]); vs[tid] = bf2f(Z[(size_t)row * NZ + ZMV + h * 256 + tid]); }
            else { qs[tid] = bf2f(Z[(size_t)row * NZ + ZQ + h * 256 + tid]); ks[tid] = bf2f(Z[(size_t)row * NZ + ZK + h * 256 + tid]); vs[tid] = bf2f(Z[(size_t)row * NZ + ZV + h * 256 + tid]); }
        }
        float dec = gamma, wk = 1.f, mnew = 0.f;
        if (ML) { const float ig = gate_ld(G, row, h) + big, lf = log_sigmoidf_(gate_ld(G, row, 8 + h) + bfg);
            mnew = fmaxf(lf + mst, ig); dec = __expf(lf + mst - mnew); wk = __expf(ig - mnew); mst = mnew; }
        __syncthreads();
        const float ve = vs[e] * wk; float po = 0.f;
#pragma unroll
        for (int dd = 0; dd < 128; ++dd) { const int d = hf * 128 + dd; S[dd] = dec * S[dd] + ks[d] * ve; po += qs[d] * S[dd]; }
        part[tid] = po;
        float den = 0.f;
        if (ML) { float dp = 0.f; if (tid < 256) { nvec = dec * nvec + wk * ks[tid]; dp = qs[tid] * nvec; } den = block_sum256(dp, red, tid); }
        __syncthreads();
        float o = 0.f;
        if (tid < 256) { o = part[tid] + part[tid + 256]; if (ML) o = o / fmaxf(fabsf(den), __expf(-mnew)); }
        const float mu = block_sum256(tid < 256 ? o : 0.f, red, tid) * (1.f / 256.f);
        const float dv = (tid < 256) ? (o - mu) : 0.f;
        const float var = block_sum256(dv * dv, red, tid) * (1.f / 256.f);
        if (tid < 256) {
            const float on = dv * (1.f / sqrtf(var + LN_EPS)) * gn;
            float gate;
            if (ML) gate = sigmoidf_(bf2f(Z[(size_t)row * NZ + ZMO + h * 256 + tid])); else gate = siluf_(bf2f(Z[(size_t)row * NZ + ZG + h * 256 + tid]));
            MIX[(size_t)row * D + (ML ? RW : 0) + h * 256 + tid] = (bf16)f2bf(on * gate);
        }
    }
#pragma unroll
    for (int dd = 0; dd < 128; ++dd) Sout[(size_t)(hf * 128 + dd) * 256 + e] = S[dd];
    if (ML) { if (tid < 256) nout[tid] = nvec; if (tid == 0) mout[0] = mst; }
}
__device__ __forceinline__ void phase_seq_mixers(const Args& a, LAS unsigned char* lds) {
    for (int u = blockIdx.x; u < 64 + 2048; u += gridDim.x) {
        const bool sample = u >= 64; const int uu = sample ? u - 64 : u; const bool ml = sample ? (uu >= 1024) : (uu >= 32); const int v = sample ? (uu & 1023) : (uu & 31);
        const int b = v >> 3, h = v & 7; const int row0 = sample ? NP + b : b * SEQ, T = sample ? 1 : SEQ;
        if (!ml) { seq_mixer_unit<false>(a, lds, row0, T, h, sample ? a.in[I_SRET] + (size_t)v * 65536 : nullptr, nullptr, nullptr, a.out + (sample ? O_RETS : O_RETP) + (size_t)v * 65536, nullptr, nullptr); }
        else { seq_mixer_unit<true>(a, lds, row0, T, h, sample ? a.in[I_SC] + (size_t)v * 65536 : nullptr, sample ? a.in[I_SN] + (size_t)v * 256 : nullptr, sample ? a.in[I_SM] + v : nullptr,
                                    a.out + (sample ? O_CS : O_CP) + (size_t)v * 65536, a.out + (sample ? O_NS : O_NP) + (size_t)v * 256, a.out + (sample ? O_MS : O_MP) + v); }
        __syncthreads();
    }
}

constexpr int KT_P = 136;
constexpr int QL_P = 264;
constexpr int VT_P = 132;
constexpr int ST_P = 136;
constexpr int M3_SMALL = 67584 + 256 * ST_P * 2;
__device__ __forceinline__ float wave_incl_scan(float v, int lane) {
#pragma unroll
    for (int o = 1; o < 64; o <<= 1) { const float t = __shfl_up(v, o); if (lane >= o) v += t; }
    return v;
}
__device__ __forceinline__ float wave_incl_scanmax(float v, int lane) {
#pragma unroll
    for (int o = 1; o < 64; o <<= 1) { const float t = __shfl_up(v, o); if (lane >= o) v = fmaxf(v, t); }
    return v;
}
__device__ __forceinline__ float wave_max(float v) {
#pragma unroll
    for (int o = 1; o < 64; o <<= 1) v = fmaxf(v, __shfl_xor(v, o));
    return v;
}
__device__ __forceinline__ void gate_scan(const float* G, const float* bgate, int row0, int h, int lane, LAS float* aj, LAS float* btv, LAS float* cmx, float& amax, float& bl) {
    const float big = bgate[h], bfg = bgate[8 + h];
    const float ig0 = gate_ld(G, row0 + lane, h) + big, ig1 = gate_ld(G, row0 + 64 + lane, h) + big;
    const float lf0 = log_sigmoidf_(gate_ld(G, row0 + lane, 8 + h) + bfg), lf1 = log_sigmoidf_(gate_ld(G, row0 + 64 + lane, 8 + h) + bfg);
    const float b0 = wave_incl_scan(lf0, lane); const float tot0 = __shfl(b0, 63); const float b1 = wave_incl_scan(lf1, lane) + tot0;
    const float a0 = ig0 - b0, a1 = ig1 - b1;
    const float c0 = wave_incl_scanmax(a0, lane); const float mx0 = __shfl(c0, 63); const float c1 = fmaxf(wave_incl_scanmax(a1, lane), mx0);
    aj[lane] = a0; aj[lane + 64] = a1; btv[lane] = b0; btv[lane + 64] = b1; cmx[lane] = c0; cmx[lane + 64] = c1;
    amax = __shfl(c1, 63); bl = __shfl(b1, 63);
}
__device__ __forceinline__ void conv8_prompt(const Args& a, const bf16* Z, int row, int t, int col, float (&out)[8]) {
    const float* cw = a.in[I_CW]; const float* cb = a.in[I_CB];
    { const f32x4 b0 = *(const f32x4*)(cb + col), b1 = *(const f32x4*)(cb + col + 4); out[0] = b0.x; out[1] = b0.y; out[2] = b0.z; out[3] = b0.w; out[4] = b1.x; out[5] = b1.y; out[6] = b1.z; out[7] = b1.w; }
#pragma unroll
    for (int q = 0; q < 4; ++q) { if (t - 3 + q >= 0) { const v4u z = *(const v4u*)(Z + (size_t)(row - 3 + q) * NZ + ZMQK + col); const f32x4 w0 = *(const f32x4*)(cw + q * 4096 + col), w1 = *(const f32x4*)(cw + q * 4096 + col + 4);
            out[0] += w0.x * bf2f(z.x & 0xffffu); out[1] += w0.y * bf2f(z.x >> 16); out[2] += w0.z * bf2f(z.y & 0xffffu); out[3] += w0.w * bf2f(z.y >> 16);
            out[4] += w1.x * bf2f(z.z & 0xffffu); out[5] += w1.y * bf2f(z.z >> 16); out[6] += w1.z * bf2f(z.w & 0xffffu); out[7] += w1.w * bf2f(z.w >> 16); } }
    const float sc = (col >= 2048) ? 0.0625f : 1.f;
#pragma unroll
    for (int i = 0; i < 8; ++i) out[i] = siluf_(out[i]) * sc;
}
__device__ __forceinline__ float conv1_sample(const Args& a, const bf16* Z, int b, int col) {
    const float* cw = a.in[I_CW]; const float* sconv = a.in[I_SCONV]; float acc = a.in[I_CB][col];
#pragma unroll
    for (int q = 0; q < 3; ++q) acc += cw[q * 4096 + col] * sconv[((size_t)b * 3 + q) * 4096 + col];
    acc += cw[3 * 4096 + col] * bf2f(Z[(size_t)(NP + b) * NZ + ZMQK + col]);
    return siluf_(acc) * ((col >= 2048) ? 0.0625f : 1.f);
}
__device__ __forceinline__ void m1_unit(const Args& a, LAS unsigned char* ldsb, int kind, int bh, int c) {
    unsigned char* ws = a.ws; const int tid = threadIdx.x, lane = tid & 63, w = tid >> 6, r = lane & 31, hh = lane >> 5;
    const int b = bh >> 3, h = bh & 7, row0 = b * SEQ + c * 128, unit = (kind * 32 + bh) * 16 + c;
    LAS bf16* KT = (LAS bf16*)ldsb; LAS bf16* VT = KT + 256 * KT_P; LAS float* wj = (LAS float*)(ldsb + 2 * 256 * KT_P * 2); LAS float* aj = wj + 128; LAS float* btv = aj + 128; LAS float* cmx = btv + 128;
    const bf16* Z = (const bf16*)(ws + WS_Z); const bf16* MQK = (const bf16*)(ws + WS_MQK);
    const bf16* Ksrc = kind ? MQK + (size_t)row0 * 4096 + 2048 + h * 256 : Z + (size_t)row0 * NZ + ZK + h * 256; const int kst = kind ? 4096 : NZ;
    const bf16* Vsrc = Z + (size_t)row0 * NZ + (kind ? ZMV : ZV) + h * 256;
    __syncthreads();
    if (kind) { if (w == 0) { float amax, bl; gate_scan((const float*)(ws + WS_G), a.in[I_BG], row0, h, lane, aj, btv, cmx, amax, bl);
            wj[lane] = __expf(aj[lane] - amax); wj[lane + 64] = __expf(aj[lane + 64] - amax);
            if (lane == 0) { float* sc = (float*)(ws + WS_SCAL); sc[bh * 16 + c] = amax; sc[512 + bh * 16 + c] = bl; } } }
    else { if (tid < 128) { const float lg = log1pf(-exp2f(-5.f - (float)h)); wj[tid] = __expf(lg * (float)(127 - tid)); } }
    __syncthreads();
#pragma unroll 4
    for (int idx = tid; idx < 128 * 32; idx += NTHR) { const int j = idx & 127, dg = idx >> 7; const float wv = wj[j];
        const v4u vv = *(const v4u*)(Vsrc + (size_t)j * NZ + dg * 8);
        float kf[8];
        if (kFuseConv && kind != 0) conv8_prompt(a, Z, row0 + j, c * 128 + j, 2048 + h * 256 + dg * 8, kf);
        else { const v4u kv = *(const v4u*)(Ksrc + (size_t)j * kst + dg * 8);
#pragma unroll
            for (int i = 0; i < 4; ++i) { kf[2 * i] = bf2f(kv[i] & 0xffffu); kf[2 * i + 1] = bf2f(kv[i] >> 16); } }
#pragma unroll
        for (int i = 0; i < 4; ++i) {
            KT[(dg * 8 + 2 * i) * KT_P + j] = (bf16)f2bf(kf[2 * i] * wv); KT[(dg * 8 + 2 * i + 1) * KT_P + j] = (bf16)f2bf(kf[2 * i + 1] * wv);
            VT[(dg * 8 + 2 * i) * KT_P + j] = (bf16)(vv[i] & 0xffffu); VT[(dg * 8 + 2 * i + 1) * KT_P + j] = (bf16)(vv[i] >> 16); } }
    __syncthreads();
    const int wr = w >> 1, wc = w & 1;
    f32x16 acc[2][4];
#pragma unroll
    for (int mi = 0; mi < 2; ++mi)
#pragma unroll
        for (int ni = 0; ni < 4; ++ni)
#pragma unroll
            for (int q = 0; q < 16; ++q) acc[mi][ni][q] = 0.f;
#pragma unroll 2
    for (int ks = 0; ks < 8; ++ks) { const int k0 = ks * 16 + 8 * hh;
        bf16x8 af[2], bfr[4];
#pragma unroll
        for (int mi = 0; mi < 2; ++mi) af[mi] = *(const LAS bf16x8*)(KT + (64 * wr + 32 * mi + r) * KT_P + k0);
#pragma unroll
        for (int ni = 0; ni < 4; ++ni) bfr[ni] = *(const LAS bf16x8*)(VT + (128 * wc + 32 * ni + r) * KT_P + k0);
#pragma unroll
        for (int mi = 0; mi < 2; ++mi)
#pragma unroll
            for (int ni = 0; ni < 4; ++ni) acc[mi][ni] = MFMA32(af[mi], bfr[ni], acc[mi][ni]); }
    if (kind && tid < 256) { float s = 0.f;
        for (int j = 0; j < 128; j += 8) { const v4u kk = *(const LAS v4u*)(KT + tid * KT_P + j);
            s += (bf2f(kk.x & 0xffffu) + bf2f(kk.x >> 16)) + (bf2f(kk.y & 0xffffu) + bf2f(kk.y >> 16)) + (bf2f(kk.z & 0xffffu) + bf2f(kk.z >> 16)) + (bf2f(kk.w & 0xffffu) + bf2f(kk.w >> 16)); }
        ((float*)(ws + WS_NLOC))[(size_t)(bh * 16 + c) * 256 + tid] = s; }
    __syncthreads();
    LAS bf16* OT = (LAS bf16*)ldsb;
#pragma unroll
    for (int mi = 0; mi < 2; ++mi)
#pragma unroll
        for (int ni = 0; ni < 4; ++ni)
#pragma unroll
            for (int rq = 0; rq < 4; ++rq) { const int d0 = 64 * wr + 32 * mi + 8 * rq + 4 * hh, e = 128 * wc + 32 * ni + r;
                *(LAS unsigned long long*)(OT + e * QL_P + d0) = (unsigned long long)pk2(acc[mi][ni][4 * rq], acc[mi][ni][4 * rq + 1]) | ((unsigned long long)pk2(acc[mi][ni][4 * rq + 2], acc[mi][ni][4 * rq + 3]) << 32); }
    __syncthreads();
    { bf16* UT = (bf16*)(ws + WS_UT) + (size_t)unit * 65536;
#pragma unroll 8
      for (int idx = tid; idx < 256 * 32; idx += NTHR) { const int e = idx >> 5, p = idx & 31; *(v4u*)(UT + e * 256 + p * 8) = *(const LAS v4u*)(OT + e * QL_P + p * 8); } }
}
__device__ __forceinline__ void sample_unit(const Args& a, LAS unsigned char* ldsb, int kind, int v) {
    unsigned char* ws = a.ws; const int tid = threadIdx.x, lane = tid & 63, w = tid >> 6; const int b = v >> 3, h = v & 7, row = NP + b;
    LAS float* qs = (LAS float*)ldsb; LAS float* ks = qs + 256; LAS float* vs = ks + 256; LAS float* red = vs + 256; LAS float* opart = red + 16;
    const bf16* Z = (const bf16*)(ws + WS_Z); const bf16* MQK = (const bf16*)(ws + WS_MQK); const float* G = (const float*)(ws + WS_G); bf16* MIX = (bf16*)(ws + WS_MIX);
    const float* S0 = (kind ? a.in[I_SC] : a.in[I_SRET]) + (size_t)v * 65536; float* Sout = a.out + (kind ? O_CS : O_RETS) + (size_t)v * 65536;
    __syncthreads();
    if (tid < 256) {
        if (kind) { if (FUSE_CONV) { qs[tid] = bf2f(f2bf(conv1_sample(a, Z, b, h * 256 + tid))); ks[tid] = bf2f(f2bf(conv1_sample(a, Z, b, 2048 + h * 256 + tid))); }
                    else { qs[tid] = bf2f(MQK[(size_t)row * 4096 + h * 256 + tid]); ks[tid] = bf2f(MQK[(size_t)row * 4096 + 2048 + h * 256 + tid]); }
                    vs[tid] = bf2f(Z[(size_t)row * NZ + ZMV + h * 256 + tid]); }
        else { qs[tid] = bf2f(Z[(size_t)row * NZ + ZQ + h * 256 + tid]); ks[tid] = bf2f(Z[(size_t)row * NZ + ZK + h * 256 + tid]); vs[tid] = bf2f(Z[(size_t)row * NZ + ZV + h * 256 + tid]); } }
    float dec = 1.f - exp2f(-5.f - (float)h), wk = 1.f, mnew = 0.f;
    if (kind) { const float ig = gate_ld(G, row, h) + a.in[I_BG][h], lf = log_sigmoidf_(gate_ld(G, row, 8 + h) + a.in[I_BG][8 + h]); const float m0 = a.in[I_SM][v];
        mnew = fmaxf(lf + m0, ig); dec = __expf(lf + m0 - mnew); wk = __expf(ig - mnew); }
    __syncthreads();
    const f32x4 v4 = *(const LAS f32x4*)(vs + lane * 4);
    f32x4 o = {0.f, 0.f, 0.f, 0.f};
#pragma unroll 1
    for (int hb = 0; hb < 2; ++hb) {
        f32x4 sv[16];
#pragma unroll
        for (int dd = 0; dd < 16; ++dd) sv[dd] = __builtin_nontemporal_load((const f32x4*)(S0 + (size_t)(32 * w + 16 * hb + dd) * 256 + lane * 4));
#pragma unroll
        for (int dd = 0; dd < 16; ++dd) { const int d = 32 * w + 16 * hb + dd; const float kd = ks[d] * wk;
            const f32x4 sn = dec * sv[dd] + kd * v4; __builtin_nontemporal_store(sn, (f32x4*)(Sout + (size_t)d * 256 + lane * 4)); o += qs[d] * sn; }
    }
    *(LAS f32x4*)(opart + w * 256 + lane * 4) = o;
    float den = 0.f;
    if (kind) { float dp = 0.f; if (tid < 256) { const float nn = dec * a.in[I_SN][(size_t)v * 256 + tid] + wk * ks[tid]; (a.out + O_NS)[(size_t)v * 256 + tid] = nn; dp = qs[tid] * nn; } den = block_sum256(dp, red, tid);
        if (tid == 0) (a.out + O_MS)[v] = mnew; }
    __syncthreads();
    float ov = 0.f;
    if (tid < 256) { ov = ((opart[tid] + opart[256 + tid]) + (opart[512 + tid] + opart[768 + tid])) + ((opart[1024 + tid] + opart[1280 + tid]) + (opart[1536 + tid] + opart[1792 + tid]));
        if (kind) ov = ov / fmaxf(fabsf(den), __expf(-mnew)); }
    const float mu = block_sum256(tid < 256 ? ov : 0.f, red, tid) * (1.f / 256.f);
    const float dv = (tid < 256) ? (ov - mu) : 0.f;
    const float var = block_sum256(dv * dv, red, tid) * (1.f / 256.f);
    if (tid < 256) { const float gn = (kind ? a.in[I_GMN] : a.in[I_GRN])[h * 256 + tid]; const float on = dv * (1.f / sqrtf(var + LN_EPS)) * gn;
        const float gate = kind ? sigmoidf_(bf2f(Z[(size_t)row * NZ + ZMO + h * 256 + tid])) : siluf_(bf2f(Z[(size_t)row * NZ + ZG + h * 256 + tid]));
        if (USE_MX) { const float vq = fminf(fmaxf(on * gate, -448.f), 448.f); (ws + WS_MIX)[(size_t)row * D + (kind ? RW : 0) + h * 256 + tid] = (unsigned char)(__builtin_amdgcn_cvt_pk_fp8_f32(vq, vq, 0, false) & 0xff); }
        else MIX[(size_t)row * D + (kind ? RW : 0) + h * 256 + tid] = (bf16)f2bf(on * gate); }
}
__device__ __forceinline__ void phase_scan(const Args& a, LAS unsigned char* ldsb) {
    unsigned char* ws = a.ws; const int tid = threadIdx.x, gt = blockIdx.x * NTHR + tid, NGT = gridDim.x * NTHR;
    const bf16* UT = (const bf16*)(ws + WS_UT); bf16* ST = (bf16*)(ws + WS_ST); const float* sc = (const float*)(ws + WS_SCAL);
    LAS float* T = (LAS float*)ldsb;
    for (int blk = blockIdx.x; blk < 64 * 16; blk += gridDim.x) { const int kbh = blk >> 4, e0 = ((blk >> 2) & 3) * 64, d0 = (blk & 3) * 64, kind = kbh >> 5, bh = kbh & 31, h = bh & 7;
        const int el = tid >> 3, dch = tid & 7;
        float S[8];
#pragma unroll
        for (int i = 0; i < 8; ++i) S[i] = 0.f;
        float m = 0.f; const float g128 = __expf(128.f * log1pf(-exp2f(-5.f - (float)h)));
        const size_t ub0 = (size_t)kbh * 16 * 65536 + (size_t)(e0 + el) * 256 + d0 + 8 * dch;
        v4u ubv[16];
#pragma unroll
        for (int c = 0; c < 16; ++c) ubv[c] = __builtin_nontemporal_load((const v4u*)(UT + ub0 + (size_t)c * 65536));
#pragma unroll
        for (int c = 0; c < 16; ++c) { const v4u ub = ubv[c];
            v4u so; so.x = pk2(S[0], S[1]); so.y = pk2(S[2], S[3]); so.z = pk2(S[4], S[5]); so.w = pk2(S[6], S[7]);
            *(v4u*)(ST + ub0 + (size_t)c * 65536) = so;
            float dec = g128, scl = 1.f;
            if (kind) { const float amax = sc[bh * 16 + c], bl = sc[512 + bh * 16 + c]; const float mn = bl + fmaxf(m, amax); dec = __expf(bl + m - mn); scl = __expf(bl + amax - mn); m = mn; }
#pragma unroll
            for (int i = 0; i < 4; ++i) { S[2 * i] = dec * S[2 * i] + scl * bf2f(ub[i] & 0xffffu); S[2 * i + 1] = dec * S[2 * i + 1] + scl * bf2f(ub[i] >> 16); } }
        __syncthreads();
#pragma unroll
        for (int i = 0; i < 8; ++i) T[el * 65 + 8 * dch + i] = S[i];
        __syncthreads();
        { const int dl = tid >> 3, ech = tid & 7; float* So = a.out + (kind ? O_CP : O_RETP) + (size_t)bh * 65536 + (size_t)(d0 + dl) * 256 + e0 + 8 * ech;
          f32x4 o0, o1;
#pragma unroll
          for (int i = 0; i < 4; ++i) { o0[i] = T[(8 * ech + i) * 65 + dl]; o1[i] = T[(8 * ech + 4 + i) * 65 + dl]; }
          *(f32x4*)So = o0; *(f32x4*)(So + 4) = o1; }
    }
    const float* NLOC = (const float*)(ws + WS_NLOC); float* NST = (float*)(ws + WS_NST); float* scw = (float*)(ws + WS_SCAL);
    for (int it = gt; it < 32 * 256; it += NGT) { const int bh = it >> 8, d = it & 255; float n = 0.f, m = 0.f;
        for (int c = 0; c < 16; ++c) { NST[(size_t)(bh * 16 + c) * 256 + d] = n; if (d == 0) scw[1024 + bh * 16 + c] = m;
            const float amax = sc[bh * 16 + c], bl = sc[512 + bh * 16 + c]; const float mn = bl + fmaxf(m, amax);
            n = __expf(bl + m - mn) * n + __expf(bl + amax - mn) * NLOC[(size_t)(bh * 16 + c) * 256 + d]; m = mn; }
        (a.out + O_NP)[(size_t)bh * 256 + d] = n; if (d == 0) (a.out + O_MP)[bh] = m; }
}
__device__ __forceinline__ void m3_unit(const Args& a, LAS unsigned char* ldsb, int kind, int bh, int c) {
    unsigned char* ws = a.ws; const int tid = threadIdx.x, lane = tid & 63, w = tid >> 6, r = lane & 31, hh = lane >> 5;
    const int b = bh >> 3, h = bh & 7, row0 = b * SEQ + c * 128, unit = (kind * 32 + bh) * 16 + c;
    LAS bf16* Ql = (LAS bf16*)ldsb; LAS bf16* Kl = Ql + 128 * QL_P; LAS bf16* VT = Kl;
    LAS float* aj = (LAS float*)(ldsb + M3_SMALL); LAS float* btv = aj + 128; LAS float* cmx = btv + 128; LAS float* nv = cmx + 128  ; LAS float* st = nv + 256  ;
    const bf16* Z = (const bf16*)(ws + WS_Z); const bf16* MQK = (const bf16*)(ws + WS_MQK);
    const bf16* Qsrc = kind ? MQK + (size_t)row0 * 4096 + h * 256 : Z + (size_t)row0 * NZ + ZQ + h * 256;
    const bf16* Ksrc = kind ? MQK + (size_t)row0 * 4096 + 2048 + h * 256 : Z + (size_t)row0 * NZ + ZK + h * 256; const int qst = kind ? 4096 : NZ;
    const bf16* Vsrc = Z + (size_t)row0 * NZ + (kind ? ZMV : ZV) + h * 256;
    const float l2g = log2f(1.f - exp2f(-5.f - (float)h));
    __syncthreads();
    float mc = 0.f;
    if (kind) { mc = ((const float*)(ws + WS_SCAL))[1024 + bh * 16 + c];
        if (w == 0) { float amax, bl; gate_scan((const float*)(ws + WS_G), a.in[I_BG], row0, h, lane, aj, btv, cmx, amax, bl); }
        if (tid >= 256) nv[tid - 256] = ((const float*)(ws + WS_NST))[(size_t)(bh * 16 + c) * 256 + tid - 256]; }
#pragma unroll 2
    for (int idx = tid; idx < 128 * 32; idx += NTHR) { const int i = idx >> 5, p = idx & 31;
        if (kFuseConv && kind != 0) { float qf[8], kf[8]; conv8_prompt(a, Z, row0 + i, c * 128 + i, h * 256 + p * 8, qf); conv8_prompt(a, Z, row0 + i, c * 128 + i, 2048 + h * 256 + p * 8, kf);
            v4u qo, ko;
#pragma unroll
            for (int k = 0; k < 4; ++k) { qo[k] = pk2(qf[2 * k], qf[2 * k + 1]); ko[k] = pk2(kf[2 * k], kf[2 * k + 1]); }
            *(LAS v4u*)(Ql + i * QL_P + p * 8) = qo; *(LAS v4u*)(Kl + i * QL_P + p * 8) = ko; }
        else { *(LAS v4u*)(Ql + i * QL_P + p * 8) = *(const v4u*)(Qsrc + (size_t)i * qst + p * 8); *(LAS v4u*)(Kl + i * QL_P + p * 8) = *(const v4u*)(Ksrc + (size_t)i * qst + p * 8); } }
    __syncthreads();
    int hq = 4 * hh; asm volatile("" : "+v"(hq));
    const int it = w & 3, eh = w >> 2, il = 32 * it + r;
    float Mi = 0.f, rs;
    if (kind) { Mi = fmaxf(mc, cmx[il]); rs = __expf(mc - Mi); } else rs = exp2f((float)(il + 1) * l2g);
    bf16x8 xb[4][2]; float rowsum = 0.f;
#pragma unroll
    for (int jt = 0; jt < 4; ++jt) {
        if (jt <= it) {
            f32x16 x;
#pragma unroll
            for (int q = 0; q < 16; ++q) x[q] = 0.f;
#pragma unroll 4
            for (int ks = 0; ks < 16; ++ks) { const bf16x8 af = *(const LAS bf16x8*)(Kl + (32 * jt + r) * QL_P + ks * 16 + 8 * hh); const bf16x8 bq = *(const LAS bf16x8*)(Ql + il * QL_P + ks * 16 + 8 * hh); x = MFMA32(af, bq, x); }
            float xw[16];
#pragma unroll
            for (int q = 0; q < 16; ++q) { const int j = 32 * jt + (q & 3) + 8 * (q >> 2) + hq;
                float wgt; if (kind) wgt = __expf(aj[j] - Mi); else wgt = exp2f((float)(il - j) * l2g);
                xw[q] = (j <= il) ? x[q] * wgt : 0.f; rowsum += xw[q]; }
#pragma unroll
            for (int s = 0; s < 2; ++s) { v4u pk; pk.x = pk2(xw[8 * s + 0], xw[8 * s + 1]); pk.y = pk2(xw[8 * s + 2], xw[8 * s + 3]); pk.z = pk2(xw[8 * s + 4], xw[8 * s + 5]); pk.w = pk2(xw[8 * s + 6], xw[8 * s + 7]);
                xb[jt][s] = __builtin_bit_cast(bf16x8, pk); }
        } else { const v4u z = {0u, 0u, 0u, 0u}; xb[jt][0] = __builtin_bit_cast(bf16x8, z); xb[jt][1] = __builtin_bit_cast(bf16x8, z); }
    }
    float qn = 0.f;
    if (kind) { const LAS bf16* qr = Ql + il * QL_P + hh * 128;
        for (int d = 0; d < 128; d += 8) { const v4u qq = *(const LAS v4u*)(qr + d); const LAS float* np = nv + hh * 128 + d;
            qn += bf2f(qq.x & 0xffffu) * np[0] + bf2f(qq.x >> 16) * np[1] + bf2f(qq.y & 0xffffu) * np[2] + bf2f(qq.y >> 16) * np[3] + bf2f(qq.z & 0xffffu) * np[4] + bf2f(qq.z >> 16) * np[5] + bf2f(qq.w & 0xffffu) * np[6] + bf2f(qq.w >> 16) * np[7]; }
        qn += __shfl_xor(qn, 32); rowsum += __shfl_xor(rowsum, 32); }
    f32x16 acc[4];
#pragma unroll
    for (int et = 0; et < 4; ++et)
#pragma unroll
        for (int q = 0; q < 16; ++q) acc[et][q] = 0.f;
    const bf16* STu = (const bf16*)(ws + WS_ST) + (size_t)unit * 65536;
    LAS bf16* SL = Kl;
#pragma unroll 1
    for (int ch = 0; ch < 2; ++ch) {
        __syncthreads();
        { v4u sv[8];
#pragma unroll
          for (int k = 0; k < 8; ++k) { const int idx = tid + k * NTHR, e = idx >> 4, p = idx & 15; sv[k] = *(const v4u*)(STu + (size_t)e * 256 + ch * 128 + p * 8); }
#pragma unroll
          for (int k = 0; k < 8; ++k) { const int idx = tid + k * NTHR, e = idx >> 4, p = idx & 15; *(LAS v4u*)(SL + e * ST_P + p * 8) = sv[k]; } }
        __syncthreads();
#pragma unroll 2
        for (int ks = 0; ks < 8; ++ks) { const bf16x8 bq = *(const LAS bf16x8*)(Ql + il * QL_P + (ch * 8 + ks) * 16 + 8 * hh);
#pragma unroll
            for (int et = 0; et < 4; ++et) { const bf16x8 af = *(const LAS bf16x8*)(SL + (128 * eh + 32 * et + r) * ST_P + ks * 16 + 8 * hh); acc[et] = MFMA32(af, bq, acc[et]); } }
    }
    __syncthreads();
    { v4u vq[8];
#pragma unroll
      for (int k = 0; k < 8; ++k) { const int idx = tid + k * NTHR, j = idx & 127, dg = idx >> 7; vq[k] = *(const v4u*)(Vsrc + (size_t)j * NZ + dg * 8); }
#pragma unroll
      for (int k = 0; k < 8; ++k) { const int idx = tid + k * NTHR, j = idx & 127, dg = idx >> 7; const v4u vv = vq[k];
#pragma unroll
        for (int i = 0; i < 4; ++i) { VT[(dg * 8 + 2 * i) * VT_P + j] = (bf16)(vv[i] & 0xffffu); VT[(dg * 8 + 2 * i + 1) * VT_P + j] = (bf16)(vv[i] >> 16); } } }
    __syncthreads();
#pragma unroll
    for (int et = 0; et < 4; ++et)
#pragma unroll
        for (int q = 0; q < 16; ++q) acc[et][q] *= rs;
#pragma unroll
    for (int jt = 0; jt < 4; ++jt) {
        if (jt <= it) {
#pragma unroll
            for (int s = 0; s < 2; ++s)
#pragma unroll
                for (int et = 0; et < 4; ++et) { const LAS bf16* vp = VT + (128 * eh + 32 * et + r) * VT_P + 32 * jt + 16 * s + 4 * hh;
                    const unsigned long long lo = *(const LAS unsigned long long*)vp, hi = *(const LAS unsigned long long*)(vp + 8);
                    v4u av; av.x = (unsigned)lo; av.y = (unsigned)(lo >> 32); av.z = (unsigned)hi; av.w = (unsigned)(hi >> 32);
                    acc[et] = MFMA32(__builtin_bit_cast(bf16x8, av), xb[jt][s], acc[et]); }
        }
    }
    float hdiv = 1.f;
    if (kind) { const float den = rowsum + rs * qn; hdiv = 1.f / fmaxf(fabsf(den), __expf(-(btv[il] + Mi))); }
    float s1 = 0.f, s2 = 0.f;
#pragma unroll
    for (int et = 0; et < 4; ++et)
#pragma unroll
        for (int q = 0; q < 16; ++q) { const float v = acc[et][q] * hdiv; acc[et][q] = v; s1 += v; s2 += v * v; }
    s1 += __shfl_xor(s1, 32); s2 += __shfl_xor(s2, 32);
    if (hh == 0) { st[(w * 32 + r) * 2] = s1; st[(w * 32 + r) * 2 + 1] = s2; }
    __syncthreads();
    { const int pw = w ^ 4; s1 += st[(pw * 32 + r) * 2]; s2 += st[(pw * 32 + r) * 2 + 1]; }
    const float mu = s1 * (1.f / 256.f); const float var = fmaxf(s2 * (1.f / 256.f) - mu * mu, 0.f); const float rstd = 1.f / sqrtf(var + LN_EPS);
    LAS bf16* OL = (LAS bf16*)ldsb;
#pragma unroll
    for (int et = 0; et < 4; ++et)
#pragma unroll
        for (int rq = 0; rq < 4; ++rq) { const int e = 128 * eh + 32 * et + 8 * rq + 4 * hh;
            *(LAS unsigned long long*)(OL + il * QL_P + e) = (unsigned long long)pk2((acc[et][4 * rq] - mu) * rstd, (acc[et][4 * rq + 1] - mu) * rstd) | ((unsigned long long)pk2((acc[et][4 * rq + 2] - mu) * rstd, (acc[et][4 * rq + 3] - mu) * rstd) << 32); }
    __syncthreads();
    const float* gn = (kind ? a.in[I_GMN] : a.in[I_GRN]) + h * 256;
#pragma unroll 4
    for (int idx = tid; idx < 128 * 32; idx += NTHR) { const int i = idx >> 5, p = idx & 31; const int row = row0 + i;
        const v4u ov = *(const LAS v4u*)(OL + i * QL_P + p * 8); const v4u gz = *(const v4u*)(Z + (size_t)row * NZ + (kind ? ZMO : ZG) + h * 256 + p * 8);
        const f32x4 g0 = *(const f32x4*)(gn + p * 8), g1 = *(const f32x4*)(gn + p * 8 + 4); const float gg[8] = {g0.x, g0.y, g0.z, g0.w, g1.x, g1.y, g1.z, g1.w};
        float of[8];
#pragma unroll
        for (int k = 0; k < 4; ++k) { const float x0 = bf2f(ov[k] & 0xffffu), x1 = bf2f(ov[k] >> 16), z0 = bf2f(gz[k] & 0xffffu), z1 = bf2f(gz[k] >> 16);
            const float a0 = kind ? sigmoidf_(z0) : siluf_(z0), a1 = kind ? sigmoidf_(z1) : siluf_(z1);
            of[2 * k] = x0 * gg[2 * k] * a0; of[2 * k + 1] = x1 * gg[2 * k + 1] * a1; }
        if (USE_MX) *(unsigned long long*)(ws + WS_MIX + (size_t)row * D + (kind ? RW : 0) + h * 256 + p * 8) = (unsigned long long)pack4_fp8(of[0], of[1], of[2], of[3]) | ((unsigned long long)pack4_fp8(of[4], of[5], of[6], of[7]) << 32);
        else { v4u out; out.x = pk2(of[0], of[1]); out.y = pk2(of[2], of[3]); out.z = pk2(of[4], of[5]); out.w = pk2(of[6], of[7]);
            *(v4u*)((bf16*)(ws + WS_MIX) + (size_t)row * D + (kind ? RW : 0) + h * 256 + p * 8) = out; } }
}
__device__ __forceinline__ void conv_state_outputs(const Args& a) {
    unsigned char* ws = a.ws; const int gt = blockIdx.x * NTHR + threadIdx.x, NGT = gridDim.x * NTHR; const bf16* Z = (const bf16*)(ws + WS_Z); const float* sconv = a.in[I_SCONV];
    float* convp = a.out + O_CONVP; float* convs = a.out + O_CONVS;
    for (int j = gt; j < NPB * 3 * 1024; j += NGT) { const int b = j / (3 * 1024), q = (j >> 10) % 3, c = (j & 1023) * 4; const unsigned long long z = *(const unsigned long long*)(Z + (size_t)(b * SEQ + SEQ - 3 + q) * NZ + ZMQK + c);
        *(f32x4*)(convp + (size_t)j * 4) = (f32x4){bf2f((unsigned)z & 0xffffu), bf2f(((unsigned)z) >> 16), bf2f((unsigned)(z >> 32) & 0xffffu), bf2f((unsigned)(z >> 48))}; }
    for (int j = gt; j < NS * 3 * 1024; j += NGT) { const int b = j / (3 * 1024), q = (j >> 10) % 3, c = (j & 1023) * 4; f32x4 o;
        if (q < 2) o = *(const f32x4*)(sconv + ((size_t)b * 3 + q + 1) * 4096 + c);
        else { const unsigned long long z = *(const unsigned long long*)(Z + (size_t)(NP + b) * NZ + ZMQK + c); o = (f32x4){bf2f((unsigned)z & 0xffffu), bf2f(((unsigned)z) >> 16), bf2f((unsigned)(z >> 32) & 0xffffu), bf2f((unsigned)(z >> 48))}; }
        *(f32x4*)(convs + (size_t)j * 4) = o; }
}
__device__ __forceinline__ void phase_m1_sample(const Args& a, LAS unsigned char* lds) {
    if (FUSE_CONV) conv_state_outputs(a);
    const int nb = gridDim.x, bx = blockIdx.x;
    for (int pass = 0; pass < 2; ++pass) {
        const bool do_m1 = (pass == 0);
        if (do_m1) { for (int u = bx; u < 1024; u += nb) { const int kind = u >> 9, bh = (u >> 4) & 31, c = u & 15; m1_unit(a, lds, kind, bh, c); } }
        else { for (int u = bx; u < 1024; u += nb) { sample_unit(a, lds, 0, u); } }
        __syncthreads();
    }
}
__device__ __forceinline__ void phase_m3(const Args& a, LAS unsigned char* lds) {
    const int nb = gridDim.x, bx = blockIdx.x;
    for (int pass = 0; pass < 2; ++pass) {
        const bool do_m3 = (pass == 0);
        if (do_m3) { for (int u = bx; u < 1024; u += nb) { const int kind = u >> 9, bh = (u >> 4) & 31, c = u & 15; m3_unit(a, lds, kind, bh, c); } }
        else { for (int u = bx; u < 1024; u += nb) { sample_unit(a, lds, 1, u); } }
        __syncthreads();
    }
}

struct EpiY1 { float* Y1; const bf16* XN; __device__ __forceinline__ void operator()(int m, int n, float v) const { Y1[(size_t)m * D + n] = ALPHA * bf2f(XN[(size_t)m * D + n]) + v; } };
struct EpiF32 { float* C; int ldc; __device__ __forceinline__ void operator()(int m, int n, float v) const { C[(size_t)m * ldc + n] = v; } };
__device__ __forceinline__ void phase_gemm2(const Args& a, LAS unsigned char* lds) {
    unsigned char* ws = a.ws;
#if USE_MFMA
#if USE_MX
    { pg8::Gemm g{(const bf16*)(ws + WS_MIX), (const bf16*)(ws + WS_WOUT), MP, D, D / 2, WO8_E8M0}; pg8::TailOrder S; S.init(NP, D, (int)gridDim.x, (int)blockIdx.x);
      pg8::EpiY1m E{(bf16*)(ws + WS_Y1), (const bf16*)(ws + WS_XN)};
      pg8::gemm_phase<pg8::EpiY1m, pg8::TailOrder, true, true, true>(lds, g, S, E); }
#else
    { pg8::Gemm g{(const bf16*)(ws + WS_MIX), (const bf16*)(ws + WS_WOUT), MP, D, D}; pg8::TailOrder S; S.init(NP, D, (int)gridDim.x, (int)blockIdx.x);
      pg8::EpiY1m E{(bf16*)(ws + WS_Y1), (const bf16*)(ws + WS_XN)};
      pg8::gemm_phase<pg8::EpiY1m, pg8::TailOrder, true, true>(lds, g, S, E); }
#endif
    { int rank, cnt; idle_rank((MP / 256) * (D / 256), rank, cnt);
      if (rank >= 0) { bg_transposes(a, lds, BG_TS, BG_T2, rank * NWAVES + (int)(threadIdx.x >> 6), cnt * NWAVES); __syncthreads();
          pg8::Gemm g{(const bf16*)(ws + WS_P16), (const bf16*)(ws + WS_WP), MP, D, PLE_D}; pg8::StaticOrder S; S.init(MP, D, cnt, rank);
          pg8::EpiB16n E{(bf16*)(ws + WS_PLE), D};
          pg8::gemm_phase<pg8::EpiB16n, pg8::StaticOrder, true, true>(lds, g, S, E);
          if (!USE_MX) bg_tables(a, 0, NEXP / 2, rank * NWAVES + (int)(threadIdx.x >> 6), cnt * NWAVES); } }
#else
    EpiY1 e{(float*)(ws + WS_Y1), (const bf16*)(ws + WS_XN)};
    slow_gemm(lds, (const bf16*)(ws + WS_MIX), (const bf16*)(ws + WS_WOUT), MP, D, D, e);
    EpiF32 e2{(float*)(ws + WS_PLE), D};
    slow_gemm(lds, (const bf16*)(ws + WS_P16), (const bf16*)(ws + WS_WP), MP, D, PLE_D, e2);
#endif
}
__device__ __forceinline__ void phase_ln1(const Args& a) {
    unsigned char* ws = a.ws; const int lane = threadIdx.x & 63, wave = threadIdx.x >> 6, gw = blockIdx.x * NWAVES + wave, NGW = gridDim.x * NWAVES;
#if USE_MFMA
    for (int m = gw; m < MP; m += NGW) ln_row_bf16<true>((const bf16*)(ws + WS_Y1) + (size_t)m * D, a.in[I_LN1G], a.in[I_LN1B], (bf16*)(ws + WS_X1) + (size_t)m * D, lane, (bf16*)(ws + WS_X1S), m, USE_MX ? ws + WS_X18 + (size_t)m * D : nullptr);
#else
    for (int m = gw; m < MP; m += NGW) ln_row_bf16<false>((const float*)(ws + WS_Y1) + (size_t)m * D, a.in[I_LN1G], a.in[I_LN1B], (bf16*)(ws + WS_X1) + (size_t)m * D, lane, (bf16*)(ws + WS_X1S), m);
#endif
}
struct EpiGate { float* PLE; __device__ __forceinline__ void operator()(int m, int n, float v) const { const size_t i = (size_t)m * D + n; PLE[i] = sigmoidf_(v) * PLE[i]; } };
__device__ __forceinline__ void phase_route_fast(const Args& a, int mode, int crank);
__device__ __forceinline__ void phase_gemm3(const Args& a, LAS unsigned char* lds) {
    unsigned char* ws = a.ws;
#if USE_MFMA
#if USE_MX
    { const int G = (int)gridDim.x, b = (int)blockIdx.x, nqt = NQ / 256, wv = (int)(threadIdx.x >> 6);
      int qs, qst, qn, gs, gst, gn, c_lo = 0, c_hi = 0, c_w = 0, c_nw = 1; bool conv_first = false;
      constexpr int R1 = 9728;
      if (G == 256) { const int x = b & 7, j = b >> 3;
          if (j < 4)       { qs = 0; qst = 1; qn = 0; gs = 0; gst = 1; gn = 0; c_lo = 0; c_hi = R1; c_w = (x * 4 + j) * NWAVES + wv; c_nw = 32 * NWAVES; conv_first = true; }
          else if (j < 8)  { qs = 8 * (j - 4) + x; qst = 32; qn = 2; gs = 8 * (j - 4) + x; gst = 96; gn = 1; }
          else if (j < 20) { qs = 8 * j + x; qst = 96; qn = 1; gs = 8 * (j - 4) + x; gst = 96; gn = 3; }
          else             { qs = 8 * j + x; qst = 80; qn = (j == 22) ? 2 : 1; gs = 8 * (20 + j) + x; gst = 96; gn = (j < 22) ? 3 : 2;
                             if (j >= 23) { c_lo = R1; c_hi = NEXP; c_w = (x * 9 + (j - 23)) * NWAVES + wv; c_nw = 72 * NWAVES; } } }
      else { const int cq = (b + nqt) % G, nqu = (NP / 256 + 1) * nqt, ngu = (NP / 256 + 1) * (D / 256);
          qs = cq; qst = G; qn = (cq < nqu) ? (nqu - cq + G - 1) / G : 0; gs = b; gst = G; gn = (b < ngu) ? (ngu - b + G - 1) / G : 0;
          c_lo = 0; c_hi = NEXP; c_w = b * NWAVES + wv; c_nw = G * NWAVES; }
      unsigned* qs_done = (unsigned*)(ws + WS_CTL) + CW_QS;
      if (conv_first) { bg_tables(a, c_lo, c_hi, c_w, c_nw);
#if USE_ROUTE_FAST
          if (wv == 0) { unsigned sp = 0; while (xb_ld(qs_done) < 8u) { __builtin_amdgcn_s_sleep(8); if (++sp > (1u << 22)) break; } __builtin_amdgcn_fence(__ATOMIC_ACQUIRE, "agent"); asm volatile("s_waitcnt vmcnt(0)" ::: "memory"); }
          phase_route_fast(a, 1, (b & 7) * 4 + (b >> 3));
#endif
      }
      { pg8::Gemm g{(const bf16*)(ws + WS_X1), (const bf16*)(ws + WS_W3), MP, NQ, D}; pg8::SpanOrder S; S.init(NP, NQ, qs, qst, qn);
        pg8::EpiQGate E{(float*)(ws + WS_QP), (float*)(ws + WS_PLE), (float*)(ws + WS_PLE2), nqt};
        pg8::gemm_phase<pg8::EpiQGate, pg8::SpanOrder, true, true>(lds, g, S, E); }
      if (G == 256 && (b >> 3) == 22) { asm volatile("s_waitcnt vmcnt(0)" ::: "memory"); __syncthreads();
          if (threadIdx.x == 0) { __builtin_amdgcn_fence(__ATOMIC_RELEASE, "agent"); asm volatile("s_waitcnt vmcnt(0)" ::: "memory"); (void)xb_add(qs_done, 1u); } }
      { pg8::Gemm g{(const bf16*)(ws + WS_X18), (const bf16*)(ws + WS_W3 + (size_t)NQ * D * 2), MP, D, D / 2, WG8_E8M0}; pg8::SpanOrder S; S.init(NP, D, gs, gst, gn);
        pg8::EpiQGate E{(float*)(ws + WS_QP), (float*)(ws + WS_PLE), (float*)(ws + WS_PLE2), 0};
        pg8::gemm_phase<pg8::EpiQGate, pg8::SpanOrder, true, true, true>(lds, g, S, E); }
      if (!conv_first && c_hi > c_lo) bg_tables(a, c_lo, c_hi, c_w, c_nw); }
    { int rank = -1, cnt = 1;
#else
    { pg8::Gemm g{(const bf16*)(ws + WS_X1), (const bf16*)(ws + WS_W3), MP, NQ + D, D}; pg8::TailOrder S; S.init(NP, NQ + D, (int)gridDim.x, (int)blockIdx.x);
      pg8::EpiQGate E{(float*)(ws + WS_QP), (float*)(ws + WS_PLE), (float*)(ws + WS_PLE2), NQ / 256};
      pg8::gemm_phase<pg8::EpiQGate, pg8::TailOrder, true, true>(lds, g, S, E); }
    { int rank, cnt; idle_rank((MP / 256) * ((NQ + D) / 256), rank, cnt);
#endif
      if (rank >= 0) bg_tables(a, NEXP / 2, NEXP, rank * NWAVES + (int)(threadIdx.x >> 6), cnt * NWAVES); }
#else
    EpiF32 e{(float*)(ws + WS_QP), NQ};
    slow_gemm(lds, (const bf16*)(ws + WS_X1), (const bf16*)(ws + WS_W3), MP, NQ, D, e);
    EpiGate e2{(float*)(ws + WS_PLE)};
    slow_gemm(lds, (const bf16*)(ws + WS_X1), (const bf16*)(ws + WS_W3) + (size_t)NQ * D, MP, D, D, e2);
#endif
}
__device__ __forceinline__ void wave_argmax(float& v, int& i) {
#pragma unroll
    for (int o = 1; o < 64; o <<= 1) { const float ov = __shfl_xor(v, o); const int oi = __shfl_xor(i, o); if (ov > v || (ov == v && oi < i)) { v = ov; i = oi; } }
}
__device__ __forceinline__ void phase_route(const Args& a) {
    unsigned char* ws = a.ws; const int lane = threadIdx.x & 63, wave = threadIdx.x >> 6, gw = blockIdx.x * NWAVES + wave, NGW = gridDim.x * NWAVES;
    const float* QP = (const float*)(ws + WS_QP); const float* SK = a.in[I_SUBK]; int* EIDX = (int*)(ws + WS_EIDX); float* GW = (float*)(ws + WS_GW);
    const float NEG = -3.0e38f;
    for (int u = gw; u < M * H; u += NGW) {
        const int t = u >> 3, h = u & 7;
        const float* q = QP + (size_t)t * NQ + h * 256;
        float svp[2]; int sip[2];
#pragma unroll
        for (int p = 0; p < 2; ++p) {
            const float* k0 = SK + ((size_t)(h * 2 + p) * 128 + lane) * 128; const float* k1 = k0 + 64 * 128; const float* qp = q + p * 128;
            float s0 = 0.f, s1 = 0.f;
            for (int d = 0; d < 128; d += 4) { const f32x4 qv = *(const f32x4*)(qp + d), a0 = *(const f32x4*)(k0 + d), a1 = *(const f32x4*)(k1 + d);
                s0 += qv.x * a0.x + qv.y * a0.y + qv.z * a0.z + qv.w * a0.w; s1 += qv.x * a1.x + qv.y * a1.y + qv.z * a1.z + qv.w * a1.w; }
            float myv = NEG; int myi = 0;
            for (int r = 0; r < TOPK; ++r) {
                float v = (s0 >= s1) ? s0 : s1; int i = (s0 >= s1) ? lane : lane + 64;
                wave_argmax(v, i);
                if (i == lane) s0 = NEG; if (i == lane + 64) s1 = NEG;
                if (lane == r) { myv = v; myi = i; }
            }
            svp[p] = myv; sip[p] = myi;
        }
        float cand[4];
#pragma unroll
        for (int c = 0; c < 4; ++c) { const int f = 4 * lane + c; cand[c] = __shfl(svp[0], f >> 4) + __shfl(svp[1], f & 15); }
        float tv = NEG; int tf = 0;
        for (int r = 0; r < TOPK; ++r) {
            float v = cand[0]; int i = 4 * lane;
#pragma unroll
            for (int c = 1; c < 4; ++c) if (cand[c] > v) { v = cand[c]; i = 4 * lane + c; }
            wave_argmax(v, i);
#pragma unroll
            for (int c = 0; c < 4; ++c) if (i == 4 * lane + c) cand[c] = NEG;
            if (lane == r) { tv = v; tf = i; }
        }
        const int e0 = __shfl(sip[0], tf >> 4), e1 = __shfl(sip[1], tf & 15);
        const float vmax = __shfl(tv, 0);
        float ex = (lane < TOPK) ? __expf(tv - vmax) : 0.f;
        const float den = wave_sum(ex);
        if (lane < TOPK) { EIDX[(size_t)t * NSLOT + h * TOPK + lane] = e0 * 128 + e1; GW[(size_t)t * NSLOT + h * TOPK + lane] = ex / den; }
    }
}
__device__ __forceinline__ int f2key(float x) { const int b = __float_as_int(x); return b ^ ((b >> 31) & 0x7fffffff); }
__device__ __forceinline__ float key2f(int k) { return __int_as_float(k ^ ((k >> 31) & 0x7fffffff)); }
constexpr int IMIN = -2147483647 - 1;

template <int N> __device__ __forceinline__ void bitonic_sort_desc(int* x) {
#pragma unroll
    for (int k = 2; k <= N; k <<= 1)
#pragma unroll
        for (int j = k >> 1; j > 0; j >>= 1)
#pragma unroll
            for (int i = 0; i < N; ++i) { const int l = i ^ j; if (l > i) { const bool desc = ((i & k) == 0); const int a = x[i], b = x[l]; const int hi = max(a, b), lo = min(a, b); x[i] = desc ? hi : lo; x[l] = desc ? lo : hi; } }
}
__device__ __forceinline__ void bitonic_clean_desc16(int* x) {
#pragma unroll
    for (int j = 8; j > 0; j >>= 1)
#pragma unroll
        for (int i = 0; i < 16; ++i) if ((i & j) == 0) { const int a = x[i], b = x[i + j]; x[i] = max(a, b); x[i + j] = min(a, b); }
}
__device__ __forceinline__ void merge_top16(int* a, const int* b) {
#pragma unroll
    for (int i = 0; i < 16; ++i) a[i] = max(a[i], b[15 - i]);
    bitonic_clean_desc16(a);
}
__device__ __forceinline__ void top16_of64(int* kk, int* out) {
    bitonic_sort_desc<16>(kk); bitonic_sort_desc<16>(kk + 16); bitonic_sort_desc<16>(kk + 32); bitonic_sort_desc<16>(kk + 48);
    merge_top16(kk, kk + 16); merge_top16(kk + 32, kk + 48); merge_top16(kk, kk + 32);
#pragma unroll
    for (int i = 0; i < 16; ++i) out[i] = kk[i];
}

template <int N> __device__ __forceinline__ int tree_max(const int (&v)[N]) {
    int t[N];
#pragma unroll
    for (int i = 0; i < N; ++i) t[i] = v[i];
    int n = N;
#pragma unroll
    for (int lvl = 0; lvl < 8; ++lvl) { if (n > 1) { int o = 0;
#pragma unroll
            for (int i = 0; i < N; i += 3) { if (i < n) { int m = t[i]; if (i + 1 < n) m = max(m, t[i + 1]); if (i + 2 < n) m = max(m, t[i + 2]); t[o] = m; ++o; } }
            n = o; } }
    return t[0];
}
__device__ __forceinline__ void phase_route_fast(const Args& a, int mode, int crank) {
    unsigned char* ws = a.ws; const int lane = threadIdx.x & 63, wave = threadIdx.x >> 6, gw = blockIdx.x * NWAVES + wave, NGW = gridDim.x * NWAVES, r = lane & 31, hh = lane >> 5;
    const bf16* QH = (const bf16*)(ws + WS_QP); const bf16* QL = QH + (size_t)MP * NQ; const bf16* KH = (const bf16*)(ws + WS_KH); const bf16* KL = KH + 16 * 128 * 128;
    int* EIDX = (int*)(ws + WS_EIDX); float* GW = (float*)(ws + WS_GW);
    const int nun = (M / 32) * H, nfull = (nun / NGW) * NGW, nrem = nun - nfull;
    const bool rem_elsewhere = ((int)gridDim.x == 256) && USE_MX;
    for (int k = 0; ; ++k) {
        int u;
        if (mode == 1) { if (k > 0 || wave != 0 || crank >= nrem) break; u = nfull + crank; }
        else if (k * NGW < nfull) u = k * NGW + gw;
        else { if (rem_elsewhere || k * NGW > nfull) break; if (nrem <= (int)gridDim.x) { if (wave != 0 || (int)blockIdx.x >= nrem) break; u = nfull + (int)blockIdx.x; } else { if (gw >= nrem) break; u = nfull + gw; } }
        const int tb = u >> 3, h = u & 7, t0 = tb * 32;
        int sk[2][16];
#pragma unroll
        for (int p = 0; p < 2; ++p) {
            f32x16 acc[4];
#pragma unroll
            for (int tl = 0; tl < 4; ++tl)
#pragma unroll
                for (int q = 0; q < 16; ++q) acc[tl][q] = 0.f;
            const bf16* qh = QH + (size_t)(t0 + r) * NQ + h * 256 + p * 128 + 8 * hh; const bf16* ql = QL + (size_t)(t0 + r) * NQ + h * 256 + p * 128 + 8 * hh;
            const bf16* kh = KH + ((size_t)(h * 2 + p) * 128 + r) * 128 + 8 * hh; const bf16* kl = KL + ((size_t)(h * 2 + p) * 128 + r) * 128 + 8 * hh;
#pragma unroll 2
            for (int ks = 0; ks < 8; ++ks) { const bf16x8 bh = *(const bf16x8*)(qh + ks * 16), bl = *(const bf16x8*)(ql + ks * 16);
#pragma unroll
                for (int tl = 0; tl < 4; ++tl) { const bf16x8 ah = *(const bf16x8*)(kh + (size_t)tl * 32 * 128 + ks * 16), al = *(const bf16x8*)(kl + (size_t)tl * 32 * 128 + ks * 16);
                    acc[tl] = MFMA32(ah, bh, acc[tl]); acc[tl] = MFMA32(ah, bl, acc[tl]); acc[tl] = MFMA32(al, bh, acc[tl]); } }
            int kk[64];
#pragma unroll
            for (int tl = 0; tl < 4; ++tl)
#pragma unroll
                for (int q = 0; q < 16; ++q) { const int kidx = 32 * tl + (q & 3) + 8 * (q >> 2) + 4 * hh; kk[tl * 16 + q] = (f2key(acc[tl][q]) & ~127) | (127 - kidx); }
            int x[16];
            top16_of64(kk, x);
            { int o[16];
#pragma unroll
              for (int i = 0; i < 16; ++i) o[i] = __shfl_xor(x[i], 32);
              merge_top16(x, o); }
#pragma unroll
            for (int i = 0; i < 16; ++i) sk[p][i] = x[i];
        }
        float v0[16], v1[16];
#pragma unroll
        for (int i = 0; i < 16; ++i) { v0[i] = key2f(sk[0][i]); v1[i] = key2f(sk[1][i]); }
        int ck[64]; int nc = 0;
#pragma unroll
        for (int i = 0; i < 16; ++i)
#pragma unroll
            for (int j = 0; j < 16; ++j) if ((i + 1) * (j + 1) <= 16) { ck[nc] = (f2key(v0[i] + v1[j]) & ~255) | (255 - (16 * i + j)); ++nc; }
#pragma unroll
        for (int i = 50; i < 64; ++i) ck[i] = IMIN;
        int win[16];
        top16_of64(ck, win);
        const float vmax = key2f(win[0]); float den = 0.f;
#pragma unroll
        for (int i = 0; i < 16; ++i) den += __expf(key2f(win[i]) - vmax);
        const float rden = 1.f / den;
        int eo[8]; float go[8];
#pragma unroll
        for (int k = 0; k < 8; ++k) { const int m = win[k] ^ ((win[k] ^ win[8 + k]) & (-hh)); const int f = 255 - (m & 255), ci = f >> 4, cj = f & 15; int e0 = 0, e1 = 0;
#pragma unroll
            for (int i = 0; i < 16; ++i) { e0 = (ci == i) ? (127 - (sk[0][i] & 127)) : e0; e1 = (cj == i) ? (127 - (sk[1][i] & 127)) : e1; }
            eo[k] = e0 * 128 + e1; go[k] = __expf(key2f(m) - vmax) * rden; }
        const size_t ob = (size_t)(t0 + r) * NSLOT + h * TOPK + 8 * hh;
        { v4u pe; pe.x = (unsigned)eo[0] | ((unsigned)eo[1] << 16); pe.y = (unsigned)eo[2] | ((unsigned)eo[3] << 16); pe.z = (unsigned)eo[4] | ((unsigned)eo[5] << 16); pe.w = (unsigned)eo[6] | ((unsigned)eo[7] << 16);
          *(v4u*)((unsigned short*)EIDX + ob) = pe; }
        *(f32x4*)(GW + ob) = (f32x4){go[0], go[1], go[2], go[3]}; *(f32x4*)(GW + ob + 4) = (f32x4){go[4], go[5], go[6], go[7]};
    }
}
__device__ __forceinline__ void phase_peer_slow(const Args& a, LAS unsigned char* ldsb) {
    unsigned char* ws = a.ws; const int tid = threadIdx.x, lane = tid & 63, wave = tid >> 6;
    LAS float* xs = (LAS float*)ldsb; LAS float* gk = xs + D; LAS int* ek = (LAS int*)(gk + NSLOT);
    const bf16* X1 = (const bf16*)(ws + WS_X1); const int* EIDX = (const int*)(ws + WS_EIDX); const float* GW = (const float*)(ws + WS_GW);
    const float* U = a.in[I_PU]; const float* V = a.in[I_PV]; float* CH = (float*)(ws + WS_CH);
    for (int t = blockIdx.x; t < M; t += gridDim.x) {
        __syncthreads();
        for (int j = tid; j < D; j += NTHR) xs[j] = bf2f(X1[(size_t)t * D + j]);
        if (tid < NSLOT) ek[tid] = EIDX[(size_t)t * NSLOT + tid];
        __syncthreads();
        for (int kk = 0; kk < 16; ++kk) { const int k = wave * 16 + kk; const float* ur = U + (size_t)ek[k] * D; float s = 0.f;
#pragma unroll 4
            for (int c = 0; c < 16; ++c) { const int idx = c * 256 + lane * 4; const f32x4 uv = *(const f32x4*)(ur + idx); const f32x4 xv = *(const LAS f32x4*)(xs + idx);
                s += uv.x * xv.x + uv.y * xv.y + uv.z * xv.z + uv.w * xv.w; }
            s = wave_sum(s);
            if (lane == 0) gk[k] = gelu_tanh(s) * GW[(size_t)t * NSLOT + k]; }
        __syncthreads();
        f32x4 acc0 = {0.f, 0.f, 0.f, 0.f}, acc1 = {0.f, 0.f, 0.f, 0.f};
        for (int k = 0; k < NSLOT; ++k) { const float g = gk[k]; const float* vr = V + (size_t)ek[k] * D + tid * 8; acc0 += g * *(const f32x4*)vr; acc1 += g * *(const f32x4*)(vr + 4); }
        *(f32x4*)(CH + (size_t)t * D + tid * 8) = acc0; *(f32x4*)(CH + (size_t)t * D + tid * 8 + 4) = acc1;
    }
}
typedef __bf16 bf2_t __attribute__((ext_vector_type(2)));
__device__ __forceinline__ float dot2bf(unsigned x, unsigned y, float c) { return __builtin_amdgcn_fdot2_f32_bf16(__builtin_bit_cast(bf2_t, x), __builtin_bit_cast(bf2_t, y), c, false); }
constexpr int PEER_TL = 260;
__device__ __forceinline__ void phase_peer_u(const Args& a, LAS unsigned char* ldsb) {
    unsigned char* ws = a.ws; const int tid = threadIdx.x, lane = tid & 63, wave = tid >> 6, g = lane >> 3, l8 = lane & 7;
    const int ngrp = (gridDim.x % 8 == 0) ? 8 : 1, xg = blockIdx.x % ngrp, r = blockIdx.x / ngrp, nr = gridDim.x / ngrp;
    LAS float* part = (LAS float*)ldsb;
    const unsigned char* Ub = ws + WS_UB; const bf16* X1s = (const bf16*)(ws + WS_X1S); const int* EIDX = (const int*)(ws + WS_EIDX); float* PA = (float*)(ws + WS_PA);
    const int ntl = (M - r + nr - 1) / nr;
    typedef float f32x2 __attribute__((ext_vector_type(2)));
    for (int n0 = 0; n0 < ntl; n0 += PEER_TL) {
        const int nn = (ntl - n0 < PEER_TL) ? (ntl - n0) : PEER_TL;
        __syncthreads();
        for (int i = tid; i < nn * NSLOT; i += NTHR) part[i] = 0.f;
        __syncthreads();
        for (int s = xg; s < 32; s += ngrp) {
            const int sp = (s - xg) / ngrp, npb = (ngrp == 8) ? 4 : 8, per = (NEXP + npb - 1) / npb; const bool cv = (n0 == 0) && (sp < npb);
            const int cv_lo = NEXP + sp * per, cv_hi = (NEXP + (sp + 1) * per < 2 * NEXP) ? NEXP + (sp + 1) * per : 2 * NEXP;
            const int iters = (nn > wave) ? (nn - wave + NWAVES - 1) / NWAVES : 0, n_cv = wave + NWAVES * ((4 * wave < iters) ? 4 * wave : 0);
            if (cv && iters == 0) bg_tables(a, cv_lo, cv_hi, (int)blockIdx.x * NWAVES + wave, (int)gridDim.x * NWAVES);
            const unsigned char* Us = Ub + (size_t)s * NEXP * 128 + l8 * 16; const bf16* Xs = X1s + (size_t)s * MP * 128 + l8 * 16;
            for (int n = wave; n < nn; n += NWAVES) { const int t = r + nr * (n0 + n);
                if (cv && n == n_cv) bg_tables(a, cv_lo, cv_hi, (int)blockIdx.x * NWAVES + wave, (int)gridDim.x * NWAVES);
                const v4u* ip = (const v4u*)((const unsigned short*)EIDX + (size_t)t * NSLOT + g * 16);
                const v4u ia = ip[0], ib = ip[1];
                const int ej[16] = {(int)(ia.x & 0xffffu), (int)(ia.x >> 16), (int)(ia.y & 0xffffu), (int)(ia.y >> 16), (int)(ia.z & 0xffffu), (int)(ia.z >> 16), (int)(ia.w & 0xffffu), (int)(ia.w >> 16),
                                    (int)(ib.x & 0xffffu), (int)(ib.x >> 16), (int)(ib.y & 0xffffu), (int)(ib.y >> 16), (int)(ib.z & 0xffffu), (int)(ib.z >> 16), (int)(ib.w & 0xffffu), (int)(ib.w >> 16)};
                const v4u xa = *(const v4u*)(Xs + (size_t)t * 128), xb = *(const v4u*)(Xs + (size_t)t * 128 + 8);
                v4u ug[16];
#pragma unroll
                for (int j = 0; j < 16; ++j) ug[j] = *(const v4u*)(Us + (size_t)ej[j] * 128);
                f32x2 x2[8];
#pragma unroll
                for (int i = 0; i < 4; ++i) { x2[i] = (f32x2){__uint_as_float(xa[i] << 16), __uint_as_float(xa[i] & 0xffff0000u)}; x2[4 + i] = (f32x2){__uint_as_float(xb[i] << 16), __uint_as_float(xb[i] & 0xffff0000u)}; }
                float acc[16];
#pragma unroll
                for (int j = 0; j < 16; ++j) { const v4u uv = ug[j]; f32x2 s2 = {0.f, 0.f};
#pragma unroll
                    for (int i = 0; i < 4; ++i) { const f32x2 lo = __builtin_amdgcn_cvt_pk_f32_fp8((int)uv[i], false), hi = __builtin_amdgcn_cvt_pk_f32_fp8((int)uv[i], true);
                        s2 = __builtin_elementwise_fma(lo, x2[2 * i], s2); s2 = __builtin_elementwise_fma(hi, x2[2 * i + 1], s2); }
                    acc[j] = s2.x + s2.y; }
                float b8[8], c4[4], d2[2];
#pragma unroll
                for (int i = 0; i < 8; ++i) { const float snd = (l8 & 4) ? acc[i] : acc[i + 8], kp = (l8 & 4) ? acc[i + 8] : acc[i]; b8[i] = kp + __shfl_xor(snd, 4); }
#pragma unroll
                for (int i = 0; i < 4; ++i) { const float snd = (l8 & 2) ? b8[i] : b8[i + 4], kp = (l8 & 2) ? b8[i + 4] : b8[i]; c4[i] = kp + __shfl_xor(snd, 2); }
#pragma unroll
                for (int i = 0; i < 2; ++i) { const float snd = (l8 & 1) ? c4[i] : c4[i + 2], kp = (l8 & 1) ? c4[i + 2] : c4[i]; d2[i] = kp + __shfl_xor(snd, 1); }
                LAS float* pp = part + n * NSLOT + 2 * lane;
                pp[0] += d2[0]; pp[1] += d2[1];
            }
        }
        __syncthreads();
        for (int i = tid; i < nn * NSLOT; i += NTHR) { const int n = i >> 7, q = i & 127; PA[((size_t)xg * M + (r + nr * (n0 + n))) * NSLOT + q] = part[i] * (1.f / U8_SCALE); }
    }
    if (ngrp == 1) {
        for (size_t i = (size_t)blockIdx.x * NTHR + tid; i < (size_t)7 * M * NSLOT; i += (size_t)gridDim.x * NTHR) PA[(size_t)M * NSLOT + i] = 0.f; }
}
__device__ __forceinline__ void phase_peer_v(const Args& a, LAS unsigned char* ldsb) {
    unsigned char* ws = a.ws; const int tid = threadIdx.x, lane = tid & 63, wave = tid >> 6, g = lane >> 3, l8 = lane & 7;
    const int ngrp = (gridDim.x % 8 == 0) ? 8 : 1, xg = blockIdx.x % ngrp, r = blockIdx.x / ngrp, nr = gridDim.x / ngrp;
    LAS float* gk = (LAS float*)ldsb;
    const unsigned char* Vb = ws + WS_VB; const int* EIDX = (const int*)(ws + WS_EIDX); const float* PA = (const float*)(ws + WS_PA); const float* GW = (const float*)(ws + WS_GW);
    bf16* CH = (bf16*)(ws + WS_CH);
    const int ntl = (M - r + nr - 1) / nr;
    for (int n0 = 0; n0 < ntl; n0 += PEER_TL) {
        const int nn = (ntl - n0 < PEER_TL) ? (ntl - n0) : PEER_TL;
        __syncthreads();
        for (int i = tid; i < nn * NSLOT; i += NTHR) { const int n = i >> 7, q = i & 127; const size_t t = (size_t)(r + nr * (n0 + n)); float s = 0.f;
#pragma unroll
            for (int x = 0; x < 8; ++x) s += PA[((size_t)x * M + t) * NSLOT + q];
            gk[i] = gelu_tanh(s) * GW[t * NSLOT + q] * (1.f / V8_SCALE); }
        __syncthreads();
        for (int s = xg; s < 32; s += ngrp) {
            const unsigned char* Vs = Vb + (size_t)s * NEXP * 128 + l8 * 16;
            for (int n = wave; n < nn; n += NWAVES) { const int t = r + nr * (n0 + n);
                const v4u* ip = (const v4u*)((const unsigned short*)EIDX + (size_t)t * NSLOT + g * 16);
                const v4u ia = ip[0], ib = ip[1];
                const int ej[16] = {(int)(ia.x & 0xffffu), (int)(ia.x >> 16), (int)(ia.y & 0xffffu), (int)(ia.y >> 16), (int)(ia.z & 0xffffu), (int)(ia.z >> 16), (int)(ia.w & 0xffffu), (int)(ia.w >> 16),
                                    (int)(ib.x & 0xffffu), (int)(ib.x >> 16), (int)(ib.y & 0xffffu), (int)(ib.y >> 16), (int)(ib.z & 0xffffu), (int)(ib.z >> 16), (int)(ib.w & 0xffffu), (int)(ib.w >> 16)};
                v4u vg[16];
#pragma unroll
                for (int j = 0; j < 16; ++j) vg[j] = *(const v4u*)(Vs + (size_t)ej[j] * 128);
                const LAS f32x4* gp = (const LAS f32x4*)(gk + n * NSLOT + g * 16);
                const f32x4 g0 = gp[0], g1 = gp[1], g2 = gp[2], g3 = gp[3];
                const float gj[16] = {g0.x, g0.y, g0.z, g0.w, g1.x, g1.y, g1.z, g1.w, g2.x, g2.y, g2.z, g2.w, g3.x, g3.y, g3.z, g3.w};
                typedef float f32x2 __attribute__((ext_vector_type(2)));
                f32x2 ac2[8];
#pragma unroll
                for (int i = 0; i < 8; ++i) ac2[i] = (f32x2){0.f, 0.f};
#pragma unroll
                for (int j = 0; j < 16; ++j) { const v4u vv = vg[j]; const f32x2 gg = {gj[j], gj[j]};
#pragma unroll
                    for (int i = 0; i < 4; ++i) { const f32x2 lo = __builtin_amdgcn_cvt_pk_f32_fp8((int)vv[i], false), hi = __builtin_amdgcn_cvt_pk_f32_fp8((int)vv[i], true);
                        ac2[2 * i] = __builtin_elementwise_fma(gg, lo, ac2[2 * i]); ac2[2 * i + 1] = __builtin_elementwise_fma(gg, hi, ac2[2 * i + 1]); } }
                float acc[16];
#pragma unroll
                for (int i = 0; i < 8; ++i) { acc[2 * i] = ac2[i].x; acc[2 * i + 1] = ac2[i].y; }
                float b8[8], c4[4], d2[2];
#pragma unroll
                for (int i = 0; i < 8; ++i) { const float snd = (g & 4) ? acc[i] : acc[i + 8], kp = (g & 4) ? acc[i + 8] : acc[i]; b8[i] = kp + __shfl_xor(snd, 32); }
#pragma unroll
                for (int i = 0; i < 4; ++i) { const float snd = (g & 2) ? b8[i] : b8[i + 4], kp = (g & 2) ? b8[i + 4] : b8[i]; c4[i] = kp + __shfl_xor(snd, 16); }
#pragma unroll
                for (int i = 0; i < 2; ++i) { const float snd = (g & 1) ? c4[i] : c4[i + 2], kp = (g & 1) ? c4[i + 2] : c4[i]; d2[i] = kp + __shfl_xor(snd, 8); }
                *(unsigned*)(CH + (size_t)t * D + s * 128 + l8 * 16 + 2 * g) = pk2(d2[0], d2[1]);
            }
        }
    }
}

__device__ __forceinline__ void phase_final(const Args& a) {
    unsigned char* ws = a.ws; const int lane = threadIdx.x & 63, wave = threadIdx.x >> 6, gw = blockIdx.x * NWAVES + wave, NGW = gridDim.x * NWAVES;
    const bf16* X1 = (const bf16*)(ws + WS_X1); const float* CH = (const float*)(ws + WS_CH); const float* PLE = (const float*)(ws + (USE_MFMA ? WS_PLE2 : WS_PLE));
    const float* g = a.in[I_LN2G]; const float* b = a.in[I_LN2B];
    for (int m = gw; m < M; m += NGW) {
        float* orow = (m < NP) ? a.out + O_YP + (size_t)m * D : a.out + O_YS + (size_t)(m - NP) * D;
        f32x4 v[16]; float s = 0.f;
#pragma unroll
        for (int j = 0; j < 16; ++j) { const int c = (lane + 64 * j) * 4; const unsigned long long xb = *(const unsigned long long*)(X1 + (size_t)m * D + c);
            const f32x4 x = {bf2f((unsigned)xb & 0xffffu), bf2f(((unsigned)xb) >> 16), bf2f((unsigned)(xb >> 32) & 0xffffu), bf2f((unsigned)(xb >> 48))};
            f32x4 pl;
            if (USE_MFMA) { const unsigned long long pb = *(const unsigned long long*)((const bf16*)PLE + (size_t)m * D + c); pl = (f32x4){bf2f((unsigned)pb & 0xffffu), bf2f(((unsigned)pb) >> 16), bf2f((unsigned)(pb >> 32) & 0xffffu), bf2f((unsigned)(pb >> 48))}; }
            else pl = *(const f32x4*)(PLE + (size_t)m * D + c);
            f32x4 chv;
            if (USE_PEER_FAST) { const unsigned long long cb = *(const unsigned long long*)((const bf16*)CH + (size_t)m * D + c); chv = (f32x4){bf2f((unsigned)cb & 0xffffu), bf2f(((unsigned)cb) >> 16), bf2f((unsigned)(cb >> 32) & 0xffffu), bf2f((unsigned)(cb >> 48))}; }
            else chv = *(const f32x4*)(CH + (size_t)m * D + c);
            v[j] = ALPHA * x + chv + pl; s += (v[j].x + v[j].y) + (v[j].z + v[j].w); }
        const float mean = wave_sum(s) * (1.f / D); float s2 = 0.f;
#pragma unroll
        for (int j = 0; j < 16; ++j) { v[j] = v[j] - mean; s2 += (v[j].x * v[j].x + v[j].y * v[j].y) + (v[j].z * v[j].z + v[j].w * v[j].w); }
        const float rstd = 1.f / sqrtf(wave_sum(s2) * (1.f / D) + LN_EPS);
#pragma unroll
        for (int j = 0; j < 16; ++j) { const int c = (lane + 64 * j) * 4; *(f32x4*)(orow + c) = v[j] * rstd * *(const f32x4*)(g + c) + *(const f32x4*)(b + c); }
    }
}

constexpr int N_PHASES = 8 - (FUSE_CONV ? 1 : 0) + (USE_MIX_FAST ? 3 : 1) + (USE_PEER_FAST ? 2 : 1);
__global__ void __launch_bounds__(NTHR, 2) fwd(Args args) {
    extern __shared__ __attribute__((aligned(16))) unsigned char lds_raw[];
    LAS unsigned char* lds = (LAS unsigned char*)lds_raw;
    volatile LAS unsigned* MISC = (volatile LAS unsigned*)(lds + MISC_OFF);
    for (int u = threadIdx.x; u < (LDS_BYTES - LDSCTL_OFF) / 4; u += NTHR) ((LAS unsigned*)(lds + LDSCTL_OFF))[u] = 0u;
    __syncthreads();
    const int lo = args.ph_lo, hi = args.ph_hi;
    XcdBarrier bar; bar.bar = (unsigned*)(args.ws + WS_CTL) + CW_BAR; bar.x = 0; bar.st = nullptr;
    if (hi - lo > 1) bar = xcd_barrier_post((unsigned*)(args.ws + WS_CTL) + CW_BAR, MISC + 8);
    int pk = 0;
#define PHASE(body) do { if (lo <= pk && pk < hi) { body; if (pk + 1 < hi) xcd_barrier(bar); } ++pk; } while (0)
    PHASE(phase_prologue(args, lds));
    PHASE(phase_gemm1(args, lds));
#if !FUSE_CONV
    PHASE(phase_rope_conv(args));
#endif
#if USE_MIX_FAST
    PHASE(phase_m1_sample(args, lds));
    PHASE(phase_scan(args, lds));
    PHASE(phase_m3(args, lds));
#else
    PHASE(phase_seq_mixers(args, lds));
#endif
    PHASE(phase_gemm2(args, lds));
    PHASE(phase_ln1(args));
    PHASE(phase_gemm3(args, lds));
#if USE_ROUTE_FAST
    PHASE(phase_route_fast(args, 0, 0));
#else
    PHASE(phase_route(args));
#endif
#if USE_PEER_FAST
    PHASE(phase_peer_u(args, lds));
    PHASE(phase_peer_v(args, lds));
#else
    PHASE(phase_peer_slow(args, lds));
#endif
    PHASE(phase_final(args));
#undef PHASE
}

extern "C" void kernel_launch(void* const* d_in, const int* in_sizes, int n_in, void* d_out, int out_size, void* d_ws, size_t ws_size, hipStream_t stream) {
    static int grid = 0;
    if (grid == 0) {
        if (n_in != 28 || (size_t)out_size != O_END || ws_size < WS_END) { fprintf(stderr, "kernel_launch: unexpected shapes: n_in %d out %d ws %zu\n", n_in, out_size, ws_size); grid = -1; return; }
        int dev = 0, cus = 0, per_cu = 0;
        if (hipGetDevice(&dev) != hipSuccess || hipDeviceGetAttribute(&cus, hipDeviceAttributeMultiprocessorCount, dev) != hipSuccess) { grid = -1; return; }
        if (hipFuncSetAttribute((const void*)fwd, hipFuncAttributeMaxDynamicSharedMemorySize, LDS_BYTES) != hipSuccess) { fprintf(stderr, "kernel_launch: hipFuncSetAttribute failed\n"); grid = -1; return; }
        if (hipOccupancyMaxActiveBlocksPerMultiprocessor(&per_cu, (const void*)fwd, NTHR, LDS_BYTES) != hipSuccess || per_cu < 1) { fprintf(stderr, "kernel_launch: occupancy query says %d\n", per_cu); }
        (void)hipGetLastError();
        grid = cus;
    }
    if (grid < 0) return;
    (void)hipMemsetAsync((char*)d_ws + WS_CTL, 0, CTL_ZERO_BYTES, stream);
    Args a; memset(&a, 0, sizeof(a));
    for (int i = 0; i < 28; ++i) a.in[i] = (const float*)d_in[i];
    a.out = (float*)d_out; a.ws = (unsigned char*)d_ws;
    for (int i = 0; i < 128; ++i) a.inv[i] = std::pow(10000.0, -(double)i / 128.0);
#if MK_PER_PHASE
    for (int p = 0; p < N_PHASES; ++p) { a.ph_lo = p; a.ph_hi = p + 1; hipLaunchKernelGGL(fwd, dim3(grid), dim3(NTHR), LDS_BYTES, stream, a); }
#else
    a.ph_lo = 0; a.ph_hi = N_PHASES; hipLaunchKernelGGL(fwd, dim3(grid), dim3(NTHR), LDS_BYTES, stream, a);
#endif
}
```

```cpp
#include <hip/hip_runtime.h>
#include <cstdio>
#include <cstdint>
#include <cmath>
#include <cstring>

#ifndef USE_MFMA
#define USE_MFMA 1
#endif
#ifndef USE_PEER_FAST
#define USE_PEER_FAST 1
#endif
#ifndef USE_MIX_FAST
#define USE_MIX_FAST 1
#endif
#ifndef USE_ROUTE_FAST
#define USE_ROUTE_FAST 1
#endif
#ifndef FUSE_CONV
#define FUSE_CONV 1
#endif
static_assert(FUSE_CONV == 0 || (USE_MFMA != 0 && USE_MIX_FAST != 0), "FUSE_CONV needs the MFMA GEMM (fused rope) and the fast mixers");
constexpr bool kFuseConv = FUSE_CONV != 0;
static_assert((USE_ROUTE_FAST != 0) == (USE_PEER_FAST != 0), "the fast routing writes u16 expert ids that only the fast expert phases read");
#ifndef USE_MX
#define USE_MX 1
#endif
#ifndef MK_PER_PHASE
#define MK_PER_PHASE 0
#endif

#define GAS __attribute__((address_space(1)))
#define LAS __attribute__((address_space(3)))
typedef unsigned short bf16;
typedef unsigned v4u __attribute__((ext_vector_type(4)));
typedef float f32x4 __attribute__((ext_vector_type(4)));
typedef GAS unsigned gu32;
typedef short bf16x8 __attribute__((ext_vector_type(8)));
typedef float f32x16 __attribute__((ext_vector_type(16)));
#define MFMA32(a, b, c) __builtin_amdgcn_mfma_f32_32x32x16_bf16((a), (b), (c), 0, 0, 0)

constexpr int D = 4096, SEQ = 2048, NPB = 4, NP = NPB * SEQ  , NS = 128, M = NP + NS  , MP = 8448  ;
constexpr int H = 8, HD = 256, RW = 2048, INC = 16400, NZ = 16384;
constexpr int ZQ = 0, ZK = 2048, ZV = 4096, ZG = 6144, ZMQK = 8192, ZMV = 12288, ZMO = 14336;
constexpr int PLE_D = 256, NQ = 2048, NEXP = 16384, TOPK = 16, NSLOT = 128;
constexpr float LN_EPS = 1e-5f;
constexpr float ALPHA = 1.189207115002721f;
constexpr int PAST_LEN = 16384;
constexpr size_t O_YP = 0, O_YS = O_YP + (size_t)NP * D, O_RETP = O_YS + (size_t)NS * D, O_CONVP = O_RETP + (size_t)NPB * H * HD * HD,
                 O_CP = O_CONVP + (size_t)NPB * 3 * 4096, O_NP = O_CP + (size_t)NPB * H * HD * HD, O_MP = O_NP + (size_t)NPB * H * HD,
                 O_RETS = O_MP + (size_t)NPB * H, O_CONVS = O_RETS + (size_t)NS * H * HD * HD, O_CS = O_CONVS + (size_t)NS * 3 * 4096,
                 O_NS = O_CS + (size_t)NS * H * HD * HD, O_MS = O_NS + (size_t)NS * H * HD, O_END = O_MS + (size_t)NS * H;
static_assert(O_END == 174384160, "output size");

constexpr size_t MiB = 1u << 20;
constexpr size_t WS_CTL = 0, CTL_ZERO_BYTES = 32768;
constexpr size_t WS_ROPE = 1 * MiB;
constexpr size_t WS_G = 764 * MiB;
constexpr size_t WS_WG = 4 * MiB + 614400;
constexpr size_t WS_EIDX = 5 * MiB;
constexpr size_t WS_GW = 10 * MiB;
constexpr size_t WS_KH = 15 * MiB;
constexpr size_t WS_WOUT = 16 * MiB;
constexpr size_t WS_W3 = 48 * MiB;
constexpr size_t WS_WP = 96 * MiB;
constexpr size_t WS_P16 = 98 * MiB;
constexpr size_t WS_XN = 104 * MiB;
constexpr size_t WS_MIX = 170 * MiB;
constexpr size_t WS_X1 = 236 * MiB;
constexpr size_t WS_WIN = 302 * MiB;
constexpr size_t WS_Z = 430 * MiB;
constexpr size_t WS_MQK = 694 * MiB;
constexpr size_t WS_X18 = 694 * MiB;
constexpr size_t WS_Y1 = 302 * MiB;
constexpr size_t WS_PLE = 434 * MiB;
constexpr size_t WS_QP = 566 * MiB;
constexpr size_t WS_CH = 632 * MiB;
constexpr size_t WS_X1S = 170 * MiB;
constexpr size_t WS_PA = 764 * MiB;
constexpr size_t WS_UB = 800 * MiB;
constexpr size_t WS_VB = 928 * MiB;
constexpr size_t WS_ST = 302 * MiB;
constexpr size_t WS_NLOC = 760 * MiB;
constexpr size_t WS_NST = 761 * MiB;
constexpr size_t WS_SCAL = 762 * MiB;
constexpr size_t WS_UT = 1056 * MiB;
constexpr size_t WS_PLE2 = 1184 * MiB;
constexpr size_t WS_END = 1316 * MiB;
constexpr int CW_BAR = 4096;
constexpr int CW_QS = 7936;

constexpr int NWAVES = 8, NTHR = 512;
constexpr int LDS_BYTES = 163840, LDSCTL_OFF = 162816, MISC_OFF = LDSCTL_OFF + 320;

#define LDS_WAIT() asm volatile("s_waitcnt lgkmcnt(0)" ::: "memory")
#define VM_WAIT() asm volatile("s_waitcnt vmcnt(0)" ::: "memory")
__device__ __forceinline__ float bf2f(unsigned v) { return __uint_as_float(v << 16); }
__device__ __forceinline__ unsigned f2bf(float f) { unsigned u = __float_as_uint(f); return (u + 0x7fffu + ((u >> 16) & 1u)) >> 16; }
__device__ __forceinline__ unsigned pk2(float lo, float hi) { return f2bf(lo) | (f2bf(hi) << 16); }
__device__ __forceinline__ float wave_sum(float v) {
#pragma unroll
    for (int o = 1; o < 64; o <<= 1) v += __shfl_xor(v, o);
    return v;
}
__device__ __forceinline__ float sigmoidf_(float x) { return __builtin_amdgcn_rcpf(1.f + __expf(-x)); }
__device__ __forceinline__ float siluf_(float x) { return x * sigmoidf_(x); }
__device__ __forceinline__ float log_sigmoidf_(float x) { return fminf(x, 0.f) - log1pf(__expf(-fabsf(x))); }
__device__ __forceinline__ float gate_ld(const float* G, int row, int col) { const size_t o = (size_t)row * 16 + col; return (G[o] + G[o + (size_t)MP * 16]) + (G[o + (size_t)2 * MP * 16] + G[o + (size_t)3 * MP * 16]); }
__device__ __forceinline__ float gelu_tanh(float x) { const float u = 0.7978845608028654f * (x + 0.044715f * x * x * x); return 0.5f * x * (1.f + tanhf(u)); }

#define XB_TMO      128
#define XB_XCNT(j)  (256  + 64 * (j))
#define XB_XSUB(j)  (1280 + 64 * (j))
#define XB_XGEN(j)  (2304 + 64 * (j))
#define XB_TOP      3328
#define XB_TOPGEN   3392
#define XCD_BAR_WORDS 3456
#define XB_SPIN_CAP (1u << 23)
__device__ __forceinline__ unsigned xb_ld(unsigned* p)              { return __hip_atomic_load(p, __ATOMIC_RELAXED, __HIP_MEMORY_SCOPE_AGENT); }
__device__ __forceinline__ unsigned xb_add(unsigned* p, unsigned v) { return __hip_atomic_fetch_add(p, v, __ATOMIC_RELAXED, __HIP_MEMORY_SCOPE_AGENT); }
__device__ __forceinline__ unsigned xb_xcc_id() { return (unsigned)__builtin_amdgcn_s_getreg((3 << 11) | 20) & 0xFu; }
#define XB_SPIN(cond, bar) do { unsigned _sp = 0; while (cond) { __builtin_amdgcn_s_sleep(1); \
    if ((++_sp & 255u) == 0u) { if (xb_ld(&(bar)[XB_TMO])) break; if (_sp > XB_SPIN_CAP) { atomicAdd(&(bar)[XB_TMO], 1u); break; } } } } while (0)
struct XcdBarrier { unsigned* bar; unsigned x; volatile LAS unsigned* st; };
__device__ __forceinline__ XcdBarrier xcd_barrier_post(unsigned* bar, volatile LAS unsigned* st) {
    XcdBarrier b; b.bar = bar; b.x = xb_xcc_id(); b.st = st;
    if (threadIdx.x == 0) (void)xb_add(&bar[XB_XCNT(b.x)], 1u);
    return b;
}
__device__ __forceinline__ void xcd_barrier_complete(unsigned* bar, unsigned x, unsigned& nloc, unsigned& nx) {
    const unsigned G = gridDim.x * gridDim.y * gridDim.z;
    unsigned sum, cnt, mine, sp = 0u;
    for (;;) {
        sum = 0u; cnt = 0u; mine = 0u;
#pragma unroll
        for (unsigned j = 0; j < 16; ++j) { const unsigned c = xb_ld(&bar[XB_XCNT(j)]); sum += c; cnt += (c > 0u) ? 1u : 0u; mine = (j == x) ? c : mine; }
        if (sum == G) break;
        __builtin_amdgcn_s_sleep(1);
        if ((++sp & 255u) == 0u) { if (xb_ld(&bar[XB_TMO])) break; if (sp > XB_SPIN_CAP) { atomicAdd(&bar[XB_TMO], 1u); break; } }
    }
    nloc = mine > 0u ? mine : 1u; nx = cnt > 0u ? cnt : 1u;
}
__device__ __forceinline__ void xcd_barrier(const XcdBarrier& b) {
    asm volatile("s_waitcnt vmcnt(0)" ::: "memory");
    __syncthreads();
    if (threadIdx.x == 0) {
        unsigned* bar = b.bar;
        __builtin_amdgcn_s_waitcnt(0);
        unsigned nloc = b.st[0], nx = b.st[1];
        if (nloc == 0u) { xcd_barrier_complete(bar, b.x, nloc, nx); b.st[0] = nloc; b.st[1] = nx; }
        const unsigned old = xb_add(&bar[XB_XSUB(b.x)], 1u);
        const unsigned gen = old / nloc;
        if (old + 1u == (gen + 1u) * nloc) {
            __builtin_amdgcn_fence(__ATOMIC_RELEASE, "agent");
            asm volatile("s_waitcnt vmcnt(0)" ::: "memory");
            const unsigned og = xb_add(&bar[XB_TOP], 1u);
            const unsigned tg = og / nx;
            if (og + 1u == (tg + 1u) * nx) xb_add(&bar[XB_TOPGEN], 1u);
            else XB_SPIN(xb_ld(&bar[XB_TOPGEN]) == tg, bar);
            __builtin_amdgcn_fence(__ATOMIC_ACQUIRE, "agent");
            xb_add(&bar[XB_XGEN(b.x)], 1u);
            asm volatile("s_waitcnt vmcnt(0)" ::: "memory");
        } else {
            XB_SPIN(xb_ld(&bar[XB_XGEN(b.x)]) == gen, bar);
            __builtin_amdgcn_fence(__ATOMIC_ACQUIRE, "agent");
            asm volatile("s_waitcnt vmcnt(0)" ::: "memory");
        }
    }
    __syncthreads();
}

namespace pg8 {
#define PG8_LAS __attribute__((address_space(3)))
typedef unsigned short bf16_t;
typedef short bf16x8 __attribute__((ext_vector_type(8)));
typedef float f32x4 __attribute__((ext_vector_type(4)));
typedef unsigned u32x4 __attribute__((ext_vector_type(4)));
constexpr int BM = 256, BK = 64, HALF = 128, HTB = HALF * BK * 2  , STAGE_BYTES = 8 * HTB, NXCD = 8, WGM = 8;

__host__ __device__ __forceinline__ int lds_byte(int r, int c) { const int st = (r >> 4) * 2 + (c >> 5), rr = r & 15, cc = c & 31, ob = rr * 64 + cc * 2; return st * 1024 + (ob ^ (((ob >> 9) & 1) << 5)); }
__host__ __device__ __forceinline__ void stage_rc(int b, int& R, int& C) { const int st = b / 1024, sb = b % 1024, swz = sb ^ (((sb >> 9) & 1) << 5); R = (st >> 1) * 16 + swz / 64; C = (st & 1) * 32 + (swz % 64) / 2; }
__host__ __device__ __forceinline__ int perm32(int rho) { const int n = rho >> 4, i = rho & 15; return 8 * (i >> 2) + 4 * n + (i & 3); }

struct Unit { int pm, pn; };
constexpr int M_VALID = 8320;
struct Gemm { const bf16_t* A; const bf16_t* Bt; int M, N, K; int wscale = 0x7f7f7f7f; };
typedef int v8i_t __attribute__((ext_vector_type(8)));
typedef int v4i_t __attribute__((ext_vector_type(4)));
__device__ __forceinline__ f32x4 mx_mma(bf16x8 b0, bf16x8 b1, bf16x8 a0, bf16x8 a1, f32x4 c, int wscale) {
    const v4i_t B0 = __builtin_bit_cast(v4i_t, b0), B1 = __builtin_bit_cast(v4i_t, b1), A0 = __builtin_bit_cast(v4i_t, a0), A1 = __builtin_bit_cast(v4i_t, a1);
    const v8i_t Bv = {B0.x, B0.y, B0.z, B0.w, B1.x, B1.y, B1.z, B1.w}, Av = {A0.x, A0.y, A0.z, A0.w, A1.x, A1.y, A1.z, A1.w};
    return __builtin_amdgcn_mfma_scale_f32_16x16x128_f8f6f4(Bv, Av, c, 0, 0, 0, wscale, 0, 0x7f7f7f7f);
}

struct StaticOrder {
    int nM, nN, nwg, G, c;
    __host__ __device__ void init(int M, int N, int G_, int c_) { nM = M / BM; nN = N / BM; nwg = nM * nN; G = G_; c = c_; }
    __host__ __device__ bool next(int i, Unit& u) const {
        const long L = (long)i * G + c; if (L >= nwg) return false;
        int wgid = (int)L; { const int q = nwg / NXCD, r = nwg % NXCD, xcd = wgid % NXCD, off = wgid / NXCD; wgid = (xcd < r ? xcd * (q + 1) : r * (q + 1) + (xcd - r) * q) + off; }
        const int nig = WGM * nN, gid = wgid / nig, fm = gid * WGM, gsz = (nM - fm) < WGM ? (nM - fm) : WGM;
        u.pm = fm + ((wgid % nig) % gsz); u.pn = (wgid % nig) / gsz; return true;
    }
    __device__ __forceinline__ void a_ready(const Unit&) const {}
    __device__ __forceinline__ void done(const Unit&) const {}
};
struct TailOrder {
    StaticOrder so; int nmain, nN, nMmain, G, c;
    __host__ __device__ void init(int Mmain, int N, int G_, int c_) { so.init(Mmain, N, G_, c_); nMmain = Mmain / BM; nN = N / BM; nmain = nMmain * nN; G = G_; c = c_; }
    __host__ __device__ bool next(int i, Unit& u) const { const long L = (long)i * G + c; if (L < nmain) return so.next(i, u); if (L >= nmain + nN) return false; u.pm = nMmain; u.pn = (int)(L - nmain); return true; }
    __device__ __forceinline__ void a_ready(const Unit&) const {}
    __device__ __forceinline__ void done(const Unit&) const {}
};
struct SpanOrder {
    TailOrder t; int start, stride, cnt;
    __host__ __device__ void init(int Mmain, int N, int s, int st, int n) { t.init(Mmain, N, 1, 0); start = s; stride = st; cnt = n; }
    __host__ __device__ bool next(int i, Unit& u) const { if (i >= cnt) return false; return t.next(start + i * stride, u); }
    __device__ __forceinline__ void a_ready(const Unit&) const {}
    __device__ __forceinline__ void done(const Unit&) const {}
};
__device__ __forceinline__ unsigned cvt_pk_bf16(float lo, float hi) { unsigned r; asm volatile("v_cvt_pk_bf16_f32 %0, %1, %2" : "=v"(r) : "v"(lo), "v"(hi)); return r; }
struct EpiZRope {
    static constexpr bool PERM = true, AFTER_DRAIN = false;
    bf16_t* Z; const float* cs; const float* sn;
    __device__ __forceinline__ void operator()(const f32x4 (&acc)[2][2][4][2], const Unit& u, int wr, int wc, int fr, int fq) const {
        const int row0 = u.pm * BM + wr * 64 + fr, col0 = u.pn * BM + wc * 32 + 8 * fq, i0 = wc * 32 + 8 * fq;
        const bool rope = u.pn < 16; const float sc = (u.pn >= 8 && u.pn < 16) ? 0.0625f : 1.f;
#pragma unroll
        for (int ai = 0; ai < 2; ++ai)
#pragma unroll
            for (int m = 0; m < 4; ++m) { if (ai == 1 && u.pm * BM + HALF >= M_VALID) continue; const int row = row0 + ai * HALF + m * 16; bf16_t* rowp = Z + (size_t)row * NZ + col0;
                f32x4 v00 = acc[ai][0][m][0], v01 = acc[ai][0][m][1], v10 = acc[ai][1][m][0], v11 = acc[ai][1][m][1];
                if (rope) { const int pi = row < NP ? (row & (SEQ - 1)) : 2048; const float* cp = cs + pi * 128 + i0; const float* sp = sn + pi * 128 + i0;
                    const f32x4 c0 = *(const f32x4*)cp, c1 = *(const f32x4*)(cp + 4), s0 = *(const f32x4*)sp, s1 = *(const f32x4*)(sp + 4);
                    const f32x4 a0 = (v00 * c0 - v10 * s0) * sc, b0 = (v00 * s0 + v10 * c0) * sc, a1 = (v01 * c1 - v11 * s1) * sc, b1 = (v01 * s1 + v11 * c1) * sc;
                    v00 = a0; v10 = b0; v01 = a1; v11 = b1; }
                u32x4 w; w.x = cvt_pk_bf16(v00[0], v00[1]); w.y = cvt_pk_bf16(v00[2], v00[3]); w.z = cvt_pk_bf16(v01[0], v01[1]); w.w = cvt_pk_bf16(v01[2], v01[3]);
                *(u32x4*)rowp = w;
                w.x = cvt_pk_bf16(v10[0], v10[1]); w.y = cvt_pk_bf16(v10[2], v10[3]); w.z = cvt_pk_bf16(v11[0], v11[1]); w.w = cvt_pk_bf16(v11[2], v11[3]);
                *(u32x4*)(rowp + HALF) = w; }
    }
};
struct EpiY1m {
    static constexpr bool PERM = true, AFTER_DRAIN = false;
    bf16_t* Y1; const bf16_t* XN;
    __device__ __forceinline__ void operator()(const f32x4 (&acc)[2][2][4][2], const Unit& u, int wr, int wc, int fr, int fq) const {
        const int row0 = u.pm * BM + wr * 64 + fr, col0 = u.pn * BM + wc * 32 + 8 * fq;
#pragma unroll
        for (int ai = 0; ai < 2; ++ai)
#pragma unroll
            for (int m = 0; m < 4; ++m) { if (ai == 1 && u.pm * BM + HALF >= M_VALID) continue; const size_t ro = (size_t)(row0 + ai * HALF + m * 16) * D + col0;
#pragma unroll
                for (int bj = 0; bj < 2; ++bj) { const size_t o = ro + bj * HALF; const u32x4 xb = *(const u32x4*)(XN + o); const f32x4 v0 = acc[ai][bj][m][0], v1 = acc[ai][bj][m][1];
                    u32x4 w;
                    w.x = cvt_pk_bf16(__uint_as_float(xb.x << 16) * ALPHA + v0[0], __uint_as_float(xb.x & 0xffff0000u) * ALPHA + v0[1]);
                    w.y = cvt_pk_bf16(__uint_as_float(xb.y << 16) * ALPHA + v0[2], __uint_as_float(xb.y & 0xffff0000u) * ALPHA + v0[3]);
                    w.z = cvt_pk_bf16(__uint_as_float(xb.z << 16) * ALPHA + v1[0], __uint_as_float(xb.z & 0xffff0000u) * ALPHA + v1[1]);
                    w.w = cvt_pk_bf16(__uint_as_float(xb.w << 16) * ALPHA + v1[2], __uint_as_float(xb.w & 0xffff0000u) * ALPHA + v1[3]);
                    *(u32x4*)(Y1 + o) = w; } }
    }
};
struct EpiB16m {
    static constexpr bool PERM = true, AFTER_DRAIN = false;
    bf16_t* C; int ldc;
    __device__ __forceinline__ void operator()(const f32x4 (&acc)[2][2][4][2], const Unit& u, int wr, int wc, int fr, int fq) const {
        const int row0 = u.pm * BM + wr * 64 + fr, col0 = u.pn * BM + wc * 32 + 8 * fq;
#pragma unroll
        for (int ai = 0; ai < 2; ++ai)
#pragma unroll
            for (int m = 0; m < 4; ++m) { if (ai == 1 && u.pm * BM + HALF >= M_VALID) continue; bf16_t* rowp = C + (size_t)(row0 + ai * HALF + m * 16) * ldc + col0;
#pragma unroll
                for (int bj = 0; bj < 2; ++bj) { const f32x4 v0 = acc[ai][bj][m][0], v1 = acc[ai][bj][m][1]; u32x4 w;
                    w.x = cvt_pk_bf16(v0[0], v0[1]); w.y = cvt_pk_bf16(v0[2], v0[3]); w.z = cvt_pk_bf16(v1[0], v1[1]); w.w = cvt_pk_bf16(v1[2], v1[3]);
                    *(u32x4*)(rowp + bj * HALF) = w; } }
    }
};
struct EpiB16n {
    static constexpr bool PERM = false, AFTER_DRAIN = false;
    bf16_t* C; int ldc;
    __device__ __forceinline__ void operator()(const f32x4 (&acc)[2][2][4][2], const Unit& u, int wr, int wc, int fr, int fq) const {
        const int row0 = u.pm * BM + wr * 64 + fr, col0 = u.pn * BM + wc * 32 + 4 * fq;
#pragma unroll
        for (int ai = 0; ai < 2; ++ai)
#pragma unroll
            for (int m = 0; m < 4; ++m) { if (ai == 1 && u.pm * BM + HALF >= M_VALID) continue; bf16_t* rowp = C + (size_t)(row0 + ai * HALF + m * 16) * ldc + col0;
#pragma unroll
                for (int bj = 0; bj < 2; ++bj)
#pragma unroll
                    for (int n = 0; n < 2; ++n) { const f32x4 v = acc[ai][bj][m][n]; *(unsigned long long*)(rowp + bj * HALF + n * 16) = (unsigned long long)cvt_pk_bf16(v[0], v[1]) | ((unsigned long long)cvt_pk_bf16(v[2], v[3]) << 32); } }
    }
};
struct EpiF32m {
    static constexpr bool PERM = false, AFTER_DRAIN = false;
    float* C; int ldc;
    __device__ __forceinline__ void operator()(const f32x4 (&acc)[2][2][4][2], const Unit& u, int wr, int wc, int fr, int fq) const {
        const int row0 = u.pm * BM + wr * 64 + fr, col0 = u.pn * BM + wc * 32 + 4 * fq;
#pragma unroll
        for (int ai = 0; ai < 2; ++ai)
#pragma unroll
            for (int m = 0; m < 4; ++m) { if (ai == 1 && u.pm * BM + HALF >= M_VALID) continue; float* rowp = C + (size_t)(row0 + ai * HALF + m * 16) * ldc + col0;
#pragma unroll
                for (int bj = 0; bj < 2; ++bj)
#pragma unroll
                    for (int n = 0; n < 2; ++n) *(f32x4*)(rowp + bj * HALF + n * 16) = acc[ai][bj][m][n]; }
    }
};
struct EpiQGate {
    static constexpr bool PERM = false, AFTER_DRAIN = false;
    float* QP; float* PLE; float* PLEO; int nq;
    __device__ __forceinline__ void operator()(const f32x4 (&acc)[2][2][4][2], const Unit& u, int wr, int wc, int fr, int fq) const {
        const int row0 = u.pm * BM + wr * 64 + fr; const bool isq = u.pn < nq; const size_t odelta = PLEO - PLE; const int col0 = (isq ? u.pn : u.pn - nq) * BM + wc * 32 + 4 * fq; const int ldc = isq ? NQ : D; float* base = isq ? QP : PLE;
#pragma unroll
        for (int ai = 0; ai < 2; ++ai)
#pragma unroll
            for (int m = 0; m < 4; ++m) { if (ai == 1 && u.pm * BM + HALF >= M_VALID) continue; float* rowp = base + (size_t)(row0 + ai * HALF + m * 16) * ldc + col0;
#pragma unroll
                for (int bj = 0; bj < 2; ++bj)
#pragma unroll
                    for (int n = 0; n < 2; ++n) { f32x4 v = acc[ai][bj][m][n]; float* p = rowp + bj * HALF + n * 16;
#if USE_ROUTE_FAST
                        if (isq) { bf16_t* qh = (bf16_t*)QP + (size_t)(row0 + ai * HALF + m * 16) * NQ + col0 + bj * HALF + n * 16; bf16_t* ql = qh + (size_t)MP * NQ;
                            const unsigned h0 = cvt_pk_bf16(v[0], v[1]), h1 = cvt_pk_bf16(v[2], v[3]);
                            const unsigned l0 = cvt_pk_bf16(v[0] - __uint_as_float(h0 << 16), v[1] - __uint_as_float(h0 & 0xffff0000u)), l1 = cvt_pk_bf16(v[2] - __uint_as_float(h1 << 16), v[3] - __uint_as_float(h1 & 0xffff0000u));
                            *(unsigned long long*)qh = (unsigned long long)h0 | ((unsigned long long)h1 << 32); *(unsigned long long*)ql = (unsigned long long)l0 | ((unsigned long long)l1 << 32); continue; }
#endif
                        { const unsigned long long ppv = *(const unsigned long long*)((const bf16_t*)PLE + (size_t)(row0 + ai * HALF + m * 16) * D + col0 + bj * HALF + n * 16); const unsigned pl = (unsigned)ppv, ph = (unsigned)(ppv >> 32);
                          const float p0 = __uint_as_float(pl << 16), p1 = __uint_as_float(pl & 0xffff0000u), p2 = __uint_as_float(ph << 16), p3 = __uint_as_float(ph & 0xffff0000u);
                          v[0] = p0 * __builtin_amdgcn_rcpf(1.f + __expf(-v[0])); v[1] = p1 * __builtin_amdgcn_rcpf(1.f + __expf(-v[1])); v[2] = p2 * __builtin_amdgcn_rcpf(1.f + __expf(-v[2])); v[3] = p3 * __builtin_amdgcn_rcpf(1.f + __expf(-v[3]));
                          *(unsigned long long*)((bf16_t*)PLEO + (size_t)(row0 + ai * HALF + m * 16) * D + col0 + bj * HALF + n * 16) = (unsigned long long)cvt_pk_bf16(v[0], v[1]) | ((unsigned long long)cvt_pk_bf16(v[2], v[3]) << 32); } } }
    }
};
template <class Epi, class Sched, bool ALIGN_EPI = false, bool SP2 = false, bool MX = false>
__device__ __forceinline__ void gemm_phase(PG8_LAS unsigned char* lds, const Gemm g, const Sched& S, const Epi& E) {
    const int tid = threadIdx.x, wid = __builtin_amdgcn_readfirstlane(tid >> 6), lane = tid & 63, wr = wid >> 2, wc = wid & 3, fr = lane & 15, fq = lane >> 4;
    const int K = g.K, nt = K / BK;
    unsigned voffA[2], voffB[2];
#pragma unroll
    for (int i = 0; i < 2; ++i) { int R, C; stage_rc(tid * 16 + i * 8192, R, C); const int Rb = Epi::PERM ? ((R & ~31) + perm32(R & 31)) : R;
        voffA[i] = (unsigned)(R * K + C) * 2u; voffB[i] = (unsigned)(Rb * K + C) * 2u; }
    const size_t kstep = (size_t)(BK * 2);
    const size_t hstep = (size_t)HALF * K * 2;
    const size_t tstep = 2 * hstep;
    const unsigned ldsw = (unsigned)wid * 1024u;
    const int aoff = lds_byte(wr * 64 + fr, fq * 8), boff = lds_byte(wc * 32 + fr, fq * 8);
#define PG8_SA(b, h) (((b) * 2 + (h)) * HTB)
#define PG8_SB(b, h) ((4 + (b) * 2 + (h)) * HTB)
#define PG8_STAGE(bufoff, gbase, voff) do { _Pragma("unroll") for (int _i = 0; _i < 2; ++_i) \
        __builtin_amdgcn_global_load_lds((const unsigned*)((const char*)(gbase) + (voff)[_i]), (PG8_LAS unsigned*)(lds + (bufoff) + ldsw + _i * 8192), 16, 0, 0); } while (0)
#define PG8_LDA(dst, b, h) do { _Pragma("unroll") for (int m = 0; m < 4; ++m) { \
        if constexpr (MX) { const v4i_t _lo = *(const PG8_LAS v4i_t*)(lds + PG8_SA(b, h) + aoff + m * 2048), _hi = *(const PG8_LAS v4i_t*)(lds + PG8_SA(b, h) + aoff + m * 2048 + 1024); dst##8[m] = __builtin_shufflevector(_lo, _hi, 0, 1, 2, 3, 4, 5, 6, 7); } \
        else { _Pragma("unroll") for (int k = 0; k < 2; ++k) dst[m][k] = *(const PG8_LAS bf16x8*)(lds + PG8_SA(b, h) + aoff + m * 2048 + k * 1024); } } } while (0)
#define PG8_LDB(dst, b, h) do { _Pragma("unroll") for (int n = 0; n < 2; ++n) { \
        if constexpr (MX) { const v4i_t _lo = *(const PG8_LAS v4i_t*)(lds + PG8_SB(b, h) + boff + n * 2048), _hi = *(const PG8_LAS v4i_t*)(lds + PG8_SB(b, h) + boff + n * 2048 + 1024); dst##8[n] = __builtin_shufflevector(_lo, _hi, 0, 1, 2, 3, 4, 5, 6, 7); } \
        else { _Pragma("unroll") for (int k = 0; k < 2; ++k) dst[n][k] = *(const PG8_LAS bf16x8*)(lds + PG8_SB(b, h) + boff + n * 2048 + k * 1024); } } } while (0)
#define PG8_MMA(ai, bj, At, Bt) do { __builtin_amdgcn_s_setprio(1); _Pragma("unroll") for (int m = 0; m < 4; ++m) _Pragma("unroll") for (int n = 0; n < 2; ++n) { \
        if constexpr (MX) asm volatile("v_mfma_scale_f32_16x16x128_f8f6f4 %0, %1, %2, %0, %3, %4 op_sel_hi:[0,0,0]" : "+v"(acc[ai][bj][m][n]) : "v"(Bt##8[n]), "v"(At##8[m]), "v"(mx_ws), "v"(mx_one));   \
        else { _Pragma("unroll") for (int k = 0; k < 2; ++k) acc[ai][bj][m][n] = __builtin_amdgcn_mfma_f32_16x16x32_bf16(Bt[n][k], At[m][k], acc[ai][bj][m][n], 0, 0, 0); } } __builtin_amdgcn_s_setprio(0); } while (0)
#define PG8_WAIT_V(n) asm volatile("s_waitcnt vmcnt(" #n ")" ::: "memory")
#define PG8_WAIT_L(n) asm volatile("s_waitcnt lgkmcnt(" #n ")" ::: "memory")
#define PG8_BAR __builtin_amdgcn_s_barrier()
#define PG8_SCHED __builtin_amdgcn_sched_barrier(0)
    Unit cur, nxt; int ui = 0;
    if (!S.next(0, cur)) return;
    f32x4 acc[2][2][4][2];
#pragma unroll
    for (int a = 0; a < 2; ++a)
#pragma unroll
        for (int b = 0; b < 2; ++b)
#pragma unroll
            for (int m = 0; m < 4; ++m)
#pragma unroll
                for (int n = 0; n < 2; ++n) acc[a][b][m][n] = (f32x4){0.f, 0.f, 0.f, 0.f};
    bf16x8 At[4][2], B0[2][2], B1[2][2];
    v8i_t At8[4], B08[2], B18[2];
    const int mx_ws = g.wscale, mx_one = 0x7f7f7f7f;
    const char* cA = (const char*)g.A + (size_t)cur.pm * tstep; const char* cB = (const char*)g.Bt + (size_t)cur.pn * tstep;
    S.a_ready(cur);
    if constexpr (SP2) {
        PG8_STAGE(PG8_SB(0, 0), cB, voffB); PG8_STAGE(PG8_SB(0, 1), cB + hstep, voffB); PG8_STAGE(PG8_SA(0, 0), cA, voffA); PG8_STAGE(PG8_SA(0, 1), cA + hstep, voffA);
        if (wr == 1) PG8_BAR;
        PG8_WAIT_V(2); PG8_BAR;
        PG8_STAGE(PG8_SB(1, 0), cB + kstep, voffB); PG8_STAGE(PG8_SA(1, 0), cA + kstep, voffA); PG8_STAGE(PG8_SB(1, 1), cB + hstep + kstep, voffB);
        PG8_WAIT_V(6); PG8_BAR;
    } else {
        PG8_STAGE(PG8_SB(0, 0), cB, voffB); PG8_STAGE(PG8_SA(0, 0), cA, voffA); PG8_STAGE(PG8_SB(0, 1), cB + hstep, voffB); PG8_STAGE(PG8_SA(0, 1), cA + hstep, voffA);
        if (wr == 1) PG8_BAR;
        PG8_WAIT_V(4); PG8_BAR;
        PG8_STAGE(PG8_SB(1, 0), cB + kstep, voffB); PG8_STAGE(PG8_SA(1, 0), cA + kstep, voffA); PG8_STAGE(PG8_SB(1, 1), cB + hstep + kstep, voffB);
        PG8_WAIT_V(6); PG8_BAR;
    }
    for (;;) {
        const bool has_next = S.next(ui + 1, nxt);
        const bool half = (cur.pm * BM + HALF >= M_VALID);
        const char* nA = has_next ? (const char*)g.A + (size_t)nxt.pm * tstep : cA; const char* nB = has_next ? (const char*)g.Bt + (size_t)nxt.pn * tstep : cB;
        for (int t = 0; t < nt; t += 2) {
            const bool last = (t == nt - 2);
            const char* a1 = cA + (size_t)(t + 1) * kstep;
            const char* a2 = last ? nA : cA + (size_t)(t + 2) * kstep; const char* b2 = last ? nB : cB + (size_t)(t + 2) * kstep;
            const char* a3 = a2 + kstep; const char* b3 = b2 + kstep;
            if (last && has_next) S.a_ready(nxt);
            if constexpr (SP2) {
            PG8_LDB(B0, 0, 0); PG8_LDB(B1, 0, 1); PG8_SCHED; PG8_LDA(At, 0, 0); PG8_STAGE(PG8_SA(1, 1), a1 + hstep, voffA);
            PG8_WAIT_V(8); PG8_WAIT_L(0); PG8_BAR; PG8_MMA(0, 0, At, B0); PG8_MMA(0, 1, At, B1); PG8_BAR; PG8_SCHED;
            PG8_LDA(At, 0, 1); PG8_STAGE(PG8_SB(0, 0), b2, voffB); PG8_STAGE(PG8_SB(0, 1), b2 + hstep, voffB); PG8_STAGE(PG8_SA(0, 0), a2, voffA);
            PG8_WAIT_V(8); PG8_WAIT_L(0); PG8_BAR; if (!half) { PG8_MMA(1, 0, At, B0); PG8_MMA(1, 1, At, B1); } PG8_BAR; PG8_SCHED;
            PG8_LDB(B0, 1, 0); PG8_LDB(B1, 1, 1); PG8_SCHED; PG8_LDA(At, 1, 0); PG8_STAGE(PG8_SA(0, 1), a2 + hstep, voffA);
            PG8_WAIT_V(8); PG8_WAIT_L(0); PG8_BAR; PG8_MMA(0, 0, At, B0); PG8_MMA(0, 1, At, B1); PG8_BAR; PG8_SCHED;
            PG8_LDA(At, 1, 1); PG8_STAGE(PG8_SB(1, 0), b3, voffB); PG8_STAGE(PG8_SB(1, 1), b3 + hstep, voffB); PG8_STAGE(PG8_SA(1, 0), a3, voffA);
            PG8_WAIT_V(8); PG8_WAIT_L(0); PG8_BAR; if (!half) { PG8_MMA(1, 0, At, B0); PG8_MMA(1, 1, At, B1); } PG8_BAR; PG8_SCHED;
            } else {
            PG8_LDB(B0, 0, 0); PG8_SCHED; PG8_LDA(At, 0, 0); PG8_STAGE(PG8_SA(1, 1), a1 + hstep, voffA);
            PG8_WAIT_L(8); PG8_BAR; PG8_WAIT_L(0); PG8_MMA(0, 0, At, B0); PG8_BAR; PG8_SCHED;
            PG8_LDB(B1, 0, 1); PG8_STAGE(PG8_SB(0, 0), b2, voffB);
            PG8_BAR; PG8_WAIT_L(0); PG8_MMA(0, 1, At, B1); PG8_BAR;
            PG8_LDA(At, 0, 1); PG8_STAGE(PG8_SA(0, 0), a2, voffA);
            PG8_BAR; PG8_WAIT_L(0); PG8_MMA(1, 0, At, B0); PG8_BAR; PG8_SCHED;
            PG8_STAGE(PG8_SB(0, 1), b2 + hstep, voffB);
            PG8_WAIT_V(6); PG8_BAR; PG8_MMA(1, 1, At, B1); PG8_BAR;
            PG8_LDB(B0, 1, 0); PG8_SCHED; PG8_LDA(At, 1, 0); PG8_STAGE(PG8_SA(0, 1), a2 + hstep, voffA);
            PG8_WAIT_L(8); PG8_BAR; PG8_WAIT_L(0); PG8_MMA(0, 0, At, B0); PG8_BAR; PG8_SCHED;
            PG8_LDB(B1, 1, 1); PG8_STAGE(PG8_SB(1, 0), b3, voffB);
            PG8_BAR; PG8_WAIT_L(0); PG8_MMA(0, 1, At, B1); PG8_BAR;
            PG8_LDA(At, 1, 1); PG8_STAGE(PG8_SA(1, 0), a3, voffA);
            PG8_BAR; PG8_WAIT_L(0); PG8_MMA(1, 0, At, B0); PG8_BAR; PG8_SCHED;
            PG8_STAGE(PG8_SB(1, 1), b3 + hstep, voffB);
            PG8_WAIT_V(6); PG8_BAR; PG8_MMA(1, 1, At, B1); PG8_BAR;
            }
        }
        if constexpr (MX) asm volatile("s_nop 15\n\ts_nop 15" ::: "memory");
        if constexpr (ALIGN_EPI) { if (wr == 0) PG8_BAR; }
        if constexpr (!Epi::AFTER_DRAIN) { E(acc, cur, wr, wc, fr, fq); S.done(cur); }
        if (!has_next) break;
#pragma unroll
        for (int a = 0; a < 2; ++a)
#pragma unroll
            for (int b = 0; b < 2; ++b)
#pragma unroll
                for (int m = 0; m < 4; ++m)
#pragma unroll
                    for (int n = 0; n < 2; ++n) acc[a][b][m][n] = (f32x4){0.f, 0.f, 0.f, 0.f};
        cur = nxt; cA = nA; cB = nB; ++ui;
        if constexpr (ALIGN_EPI) { if (wr == 1) PG8_BAR; }
    }
    PG8_WAIT_V(0);
    if constexpr (!ALIGN_EPI) { if (wr == 0) PG8_BAR; }
    PG8_BAR;
    if constexpr (Epi::AFTER_DRAIN) { E.fused(acc, cur, wr, wc, fr, fq, lds, wid, lane); S.done(cur); }
#undef PG8_SA
#undef PG8_SB
#undef PG8_STAGE
#undef PG8_LDA
#undef PG8_LDB
#undef PG8_MMA
#undef PG8_WAIT_V
#undef PG8_WAIT_L
#undef PG8_BAR
#undef PG8_SCHED
}
}

struct Args {
    const float* in[28]; float* out; unsigned char* ws;
    double inv[128];
    int ph_lo, ph_hi;
};
enum { I_XP = 0, I_XS, I_SRET, I_SCONV, I_SC, I_SN, I_SM, I_PP, I_PS, I_LNEG, I_LNEB, I_WIN, I_BG, I_CW, I_CB, I_GRN, I_GMN, I_WOUT, I_LN1G, I_LN1B,
       I_WPQ, I_SUBK, I_PU, I_PV, I_WPG, I_WPP, I_LN2G, I_LN2B };

__device__ __forceinline__ void p0_transpose_item(const float* W, int ldw, int col0, int K, int nblk, bf16* WT, LAS float* scr, int item, int lane) {
    const int kb = item / nblk, nb = item % nblk, k0 = 64 * kb, n0 = 32 * nb;
#pragma unroll 1
    for (int hb = 0; hb < 2; ++hb) { float wv[16];
#pragma unroll
        for (int i = 0; i < 16; ++i) wv[i] = W[(size_t)(k0 + 2 * (16 * hb + i) + (lane >> 5)) * ldw + col0 + n0 + (lane & 31)];
#pragma unroll
        for (int i = 0; i < 16; ++i) scr[(2 * (16 * hb + i) + (lane >> 5)) * 33 + (lane & 31)] = wv[i]; }
    LDS_WAIT(); asm volatile("" ::: "memory");
    const int c = lane & 7;
#pragma unroll
    for (int j = 0; j < 4; ++j) { const int n = (lane >> 3) + 8 * j; const LAS float* s = scr + (8 * c) * 33 + n;
        v4u o; o.x = pk2(s[0 * 33], s[1 * 33]); o.y = pk2(s[2 * 33], s[3 * 33]); o.z = pk2(s[4 * 33], s[5 * 33]); o.w = pk2(s[6 * 33], s[7 * 33]);
        *(v4u*)(WT + (size_t)(n0 + n) * K + k0 + 8 * c) = o; }
    LDS_WAIT(); asm volatile("" ::: "memory");
}
__device__ __forceinline__ unsigned pack4_fp8(float a0, float a1, float a2, float a3) {
    a0 = fminf(fmaxf(a0, -448.f), 448.f); a1 = fminf(fmaxf(a1, -448.f), 448.f); a2 = fminf(fmaxf(a2, -448.f), 448.f); a3 = fminf(fmaxf(a3, -448.f), 448.f);
    int p = __builtin_amdgcn_cvt_pk_fp8_f32(a0, a1, 0, false); p = __builtin_amdgcn_cvt_pk_fp8_f32(a2, a3, p, true); return (unsigned)p;
}
__device__ __forceinline__ void p0_transpose_item_fp8(const float* W, int ldw, int col0, int K, int nblk, unsigned char* WT, float scl, LAS float* scr, int item, int lane) {
    const int kb = item / nblk, nb = item % nblk, k0 = 64 * kb, n0 = 32 * nb;
#pragma unroll 1
    for (int hb = 0; hb < 2; ++hb) { float wv[16];
#pragma unroll
        for (int i = 0; i < 16; ++i) wv[i] = W[(size_t)(k0 + 2 * (16 * hb + i) + (lane >> 5)) * ldw + col0 + n0 + (lane & 31)];
#pragma unroll
        for (int i = 0; i < 16; ++i) scr[(2 * (16 * hb + i) + (lane >> 5)) * 33 + (lane & 31)] = wv[i]; }
    LDS_WAIT(); asm volatile("" ::: "memory");
    const int c = lane & 7;
#pragma unroll
    for (int j = 0; j < 4; ++j) { const int n = (lane >> 3) + 8 * j; const LAS float* s = scr + (8 * c) * 33 + n;
        const unsigned lo = pack4_fp8(s[0 * 33] * scl, s[1 * 33] * scl, s[2 * 33] * scl, s[3 * 33] * scl), hi = pack4_fp8(s[4 * 33] * scl, s[5 * 33] * scl, s[6 * 33] * scl, s[7 * 33] * scl);
        *(unsigned long long*)(WT + (size_t)(n0 + n) * K + k0 + 8 * c) = (unsigned long long)lo | ((unsigned long long)hi << 32); }
    LDS_WAIT(); asm volatile("" ::: "memory");
}
template <bool IN_BF16 = false>
__device__ __forceinline__ void ln_row_bf16(const void* xrow, const float* g, const float* b, bf16* orow, int lane, bf16* sl = nullptr, int m = 0, unsigned char* x8row = nullptr) {
    f32x4 v[16]; float s = 0.f;
#pragma unroll
    for (int j = 0; j < 16; ++j) {
        if (IN_BF16) { const unsigned long long xb = ((const unsigned long long*)xrow)[lane + 64 * j];
            v[j] = (f32x4){bf2f((unsigned)xb & 0xffffu), bf2f(((unsigned)xb) >> 16), bf2f((unsigned)(xb >> 32) & 0xffffu), bf2f((unsigned)(xb >> 48))}; }
        else v[j] = ((const f32x4*)xrow)[lane + 64 * j];
        s += (v[j].x + v[j].y) + (v[j].z + v[j].w); }
    const float mean = wave_sum(s) * (1.f / D); float s2 = 0.f;
#pragma unroll
    for (int j = 0; j < 16; ++j) { v[j] = v[j] - mean; s2 += (v[j].x * v[j].x + v[j].y * v[j].y) + (v[j].z * v[j].z + v[j].w * v[j].w); }
    const float rstd = 1.f / sqrtf(wave_sum(s2) * (1.f / D) + LN_EPS);
    unsigned long long* o8 = (unsigned long long*)orow + lane;
#pragma unroll
    for (int j = 0; j < 16; ++j) { const f32x4 gg = ((const f32x4*)g)[lane + 64 * j], bb = ((const f32x4*)b)[lane + 64 * j]; const f32x4 y = v[j] * rstd * gg + bb;
        const unsigned long long pk = (unsigned long long)pk2(y.x, y.y) | ((unsigned long long)pk2(y.z, y.w) << 32);
        o8[64 * j] = pk;
        if (sl) *(unsigned long long*)(sl + ((size_t)(2 * j + (lane >> 5)) * MP + m) * 128 + (lane & 31) * 4) = pk;
        if (x8row) ((unsigned*)x8row)[lane + 64 * j] = pack4_fp8(y.x, y.y, y.z, y.w); }
}
__device__ __forceinline__ void phase_prologue(const Args& a, LAS unsigned char* lds) {
    const int tid = threadIdx.x, lane = tid & 63, wave = tid >> 6;
    const int gw = blockIdx.x * NWAVES + wave, NGW = gridDim.x * NWAVES;
    const int gt = blockIdx.x * NTHR + tid, NGT = gridDim.x * NTHR;
    unsigned char* ws = a.ws;
    LAS float* scr = (LAS float*)(lds + wave * 16384);
    for (int it = gw; it < 64 * 512; it += NGW) p0_transpose_item(a.in[I_WIN], INC, 0, D, 512, (bf16*)(ws + WS_WIN), scr, it, lane);
    { bf16* WGH = (bf16*)(ws + WS_WG); bf16* WGL = WGH + 16 * D;
      for (int j = gt; j < 16 * D; j += NGT) { const int g = j >> 12, k = j & (D - 1); const float x = a.in[I_WIN][(size_t)k * INC + NZ + g]; const unsigned hi = f2bf(x); WGH[j] = (bf16)hi; WGL[j] = (bf16)f2bf(x - bf2f(hi)); } }
    bf16* XN = (bf16*)(ws + WS_XN);
    for (int m = gw; m < MP; m += NGW) {
        if (m < M) { const float* xr = (m < NP) ? a.in[I_XP] + (size_t)m * D : a.in[I_XS] + (size_t)(m - NP) * D; ln_row_bf16(xr, a.in[I_LNEG], a.in[I_LNEB], XN + (size_t)m * D, lane); }
        else { v4u z = {0u, 0u, 0u, 0u}; for (int j = lane; j < D / 8; j += 64) ((v4u*)(XN + (size_t)m * D))[j] = z; }
    }
    if (USE_MX) { unsigned char* MIXp = ws + WS_MIX + (size_t)M * D; v4u z = {0u, 0u, 0u, 0u}; for (int j = gt; j < (MP - M) * D / 16; j += NGT) ((v4u*)MIXp)[j] = z; }
    else { bf16* MIXp = (bf16*)(ws + WS_MIX) + (size_t)M * D; v4u z = {0u, 0u, 0u, 0u}; for (int j = gt; j < (MP - M) * D / 8; j += NGT) ((v4u*)MIXp)[j] = z; }
    { bf16* P16 = (bf16*)(ws + WS_P16);
      for (int j = gt; j < MP * PLE_D / 2; j += NGT) { const int m = j / (PLE_D / 2), c = (j % (PLE_D / 2)) * 2; unsigned o = 0u;
          if (m < M) { const float* pr = (m < NP) ? a.in[I_PP] + (size_t)m * PLE_D : a.in[I_PS] + (size_t)(m - NP) * PLE_D; o = pk2(pr[c], pr[c + 1]); }
          ((unsigned*)P16)[j] = o; } }
    { bf16* KH = (bf16*)(ws + WS_KH); bf16* KL = KH + 16 * 128 * 128; const float* SK = a.in[I_SUBK];
      for (int j = gt; j < 16 * 128 * 128; j += NGT) { const float x = SK[j]; const unsigned hi = f2bf(x); KH[j] = (bf16)hi; KL[j] = (bf16)f2bf(x - bf2f(hi)); } }
    { float* cs = (float*)(ws + WS_ROPE); float* sn = cs + 2049 * 128;
      for (int j = gt; j < 2049 * 128; j += NGT) { const int pi = j >> 7, i = j & 127; const double pos = (pi < 2048) ? (double)pi : (double)PAST_LEN;
          const double rev = pos * a.inv[i] * 0.15915494309189535;
          const double fr = rev - floor(rev);
          const float ang = (float)(fr * 6.283185307179586);
          cs[j] = cosf(ang); sn[j] = sinf(ang); } }
}

template <class Epi>
__device__ __forceinline__ void slow_gemm(LAS unsigned char* ldsb, const bf16* A, const bf16* Bt, int Mrows, int N, int K, const Epi& epi) {
    LAS float* As = (LAS float*)ldsb; LAS float* Bs = As + 32 * 132;
    const int tid = threadIdx.x, ty = tid >> 4, tx = tid & 15;
    const int ntm = Mrows / 128, ntn = N / 128;
    for (int tile = blockIdx.x; tile < ntm * ntn; tile += gridDim.x) {
        const int tm = tile / ntn, tn = tile % ntn, m0 = tm * 128, n0 = tn * 128;
        float acc[4][8];
#pragma unroll
        for (int i = 0; i < 4; ++i)
#pragma unroll
            for (int j = 0; j < 8; ++j) acc[i][j] = 0.f;
        const int r = tid >> 2, c = tid & 3;
        for (int k0 = 0; k0 < K; k0 += 32) {
            const v4u av = *(const v4u*)(A + (size_t)(m0 + r) * K + k0 + 8 * c);
            const v4u bv = *(const v4u*)(Bt + (size_t)(n0 + r) * K + k0 + 8 * c);
            __syncthreads();
#pragma unroll
            for (int i = 0; i < 4; ++i) {
                As[(8 * c + 2 * i) * 132 + r] = bf2f(av[i] & 0xffffu); As[(8 * c + 2 * i + 1) * 132 + r] = bf2f(av[i] >> 16);
                Bs[(8 * c + 2 * i) * 132 + r] = bf2f(bv[i] & 0xffffu); Bs[(8 * c + 2 * i + 1) * 132 + r] = bf2f(bv[i] >> 16);
            }
            __syncthreads();
#pragma unroll 8
            for (int kk = 0; kk < 32; ++kk) {
                const f32x4 av4 = *(const LAS f32x4*)(As + kk * 132 + ty * 4);
                const f32x4 b0 = *(const LAS f32x4*)(Bs + kk * 132 + tx * 8), b1 = *(const LAS f32x4*)(Bs + kk * 132 + tx * 8 + 4);
#pragma unroll
                for (int i = 0; i < 4; ++i) {
#pragma unroll
                    for (int j = 0; j < 4; ++j) { acc[i][j] += av4[i] * b0[j]; acc[i][4 + j] += av4[i] * b1[j]; }
                }
            }
        }
#pragma unroll
        for (int i = 0; i < 4; ++i)
#pragma unroll
            for (int j = 0; j < 8; ++j) epi(m0 + ty * 4 + i, n0 + tx * 8 + j, acc[i][j]);
        __syncthreads();
    }
}

constexpr float WO8_SCALE = 256.f; constexpr int WO8_E8M0 = 0x77777777;
constexpr float WG8_SCALE = 128.f; constexpr int WG8_E8M0 = 0x78787878;
constexpr float U8_SCALE = 256.f;
constexpr float V8_SCALE = 16.f;
constexpr int BG_T1Q = 64 * 128 + 64 * 64;
constexpr int BG_TS = BG_T1Q + 64 * 64;
constexpr int BG_T1 = 64 * 128  , BG_T2 = BG_T1 + 64 * 64 + 64 * 128  , BG_TN = BG_T2 + 4 * 128  ;
__device__ __forceinline__ void bg_transposes(const Args& a, LAS unsigned char* lds, int it_lo, int it_hi, int widx, int nw) {
    unsigned char* ws = a.ws; const int lane = threadIdx.x & 63, wave = threadIdx.x >> 6; LAS float* scr = (LAS float*)(lds + wave * 16384);
    constexpr int I_OUT = 64 * 128, I_Q = 64 * 64, I_GT = 64 * 128, I_PR = 4 * 128;
    for (int it = it_lo + widx; it < it_hi; it += nw) { int r = it;
#if USE_MX
        if (r < I_OUT) { p0_transpose_item_fp8(a.in[I_WOUT], D, 0, D, 128, ws + WS_WOUT, WO8_SCALE, scr, r, lane); continue; } r -= I_OUT;
#else
        if (r < I_OUT) { p0_transpose_item(a.in[I_WOUT], D, 0, D, 128, (bf16*)(ws + WS_WOUT), scr, r, lane); continue; } r -= I_OUT;
#endif
        if (r < I_Q) { p0_transpose_item(a.in[I_WPQ], NQ, 0, D, 64, (bf16*)(ws + WS_W3), scr, r, lane); continue; } r -= I_Q;
#if USE_MX
        if (r < I_GT) { p0_transpose_item_fp8(a.in[I_WPG], D, 0, D, 128, ws + WS_W3 + (size_t)NQ * D * 2, WG8_SCALE, scr, r, lane); continue; } r -= I_GT;
#else
        if (r < I_GT) { p0_transpose_item(a.in[I_WPG], D, 0, D, 128, (bf16*)(ws + WS_W3) + (size_t)NQ * D, scr, r, lane); continue; } r -= I_GT;
#endif
        p0_transpose_item(a.in[I_WPP], D, 0, PLE_D, 128, (bf16*)(ws + WS_WP), scr, r, lane); }
}
__device__ __forceinline__ void bg_tables(const Args& a, int row_lo, int row_hi, int widx, int nw) {
    unsigned char* ws = a.ws; const int lane = threadIdx.x & 63;
    for (int e2 = row_lo + widx; e2 < row_hi; e2 += nw) { const int e = e2 & (NEXP - 1); const bool isv = e2 >= NEXP; const float* src = (isv ? a.in[I_PV] : a.in[I_PU]) + (size_t)e * D;
        f32x4 rv[16];
#pragma unroll
        for (int j = 0; j < 16; ++j) rv[j] = __builtin_nontemporal_load((const f32x4*)src + j * 64 + lane);
        { unsigned char* dst = ws + (isv ? WS_VB : WS_UB); const float scl = isv ? V8_SCALE : U8_SCALE;
#pragma unroll
            for (int j = 0; j < 16; ++j) { f32x4 v = rv[j] * scl; v = __builtin_elementwise_min(__builtin_elementwise_max(v, (f32x4){-448.f, -448.f, -448.f, -448.f}), (f32x4){448.f, 448.f, 448.f, 448.f});
                int p = __builtin_amdgcn_cvt_pk_fp8_f32(v.x, v.y, 0, false); p = __builtin_amdgcn_cvt_pk_fp8_f32(v.z, v.w, p, true);
                const int s = j * 2 + (lane >> 5);
                __builtin_nontemporal_store((unsigned)p, (unsigned*)(dst + ((size_t)s * NEXP + e) * 128 + (lane & 31) * 4)); } }
    }
}
__device__ __forceinline__ void idle_rank(int nunits, int& rank, int& count) { const int G = (int)gridDim.x, rem = nunits % G; if (rem == 0) { rank = (int)blockIdx.x; count = G; } else { rank = (int)blockIdx.x - rem; count = G - rem; } }
__device__ __forceinline__ void gates_mfma(const Args& a, int widx, int nw) {
    unsigned char* ws = a.ws; const int lane = threadIdx.x & 63, r = lane & 31, hh = lane >> 5;
    const bf16* XN = (const bf16*)(ws + WS_XN); const bf16* WGH = (const bf16*)(ws + WS_WG); const bf16* WGL = WGH + 16 * D; float* G = (float*)(ws + WS_G);
    for (int u = widx; u < (M / 32) * 4; u += nw) { const int t0 = (u >> 2) * 32, kq = u & 3;
        f32x16 acc;
#pragma unroll
        for (int q = 0; q < 16; ++q) acc[q] = 0.f;
        const bf16* ap = XN + (size_t)(t0 + r) * D + kq * (D / 4) + 8 * hh; const bf16* bhp = WGH + (size_t)(r & 15) * D + kq * (D / 4) + 8 * hh; const bf16* blp = WGL + (size_t)(r & 15) * D + kq * (D / 4) + 8 * hh;
#pragma unroll 8
        for (int ks = 0; ks < D / 64; ++ks) { const bf16x8 af = *(const bf16x8*)(ap + ks * 16); bf16x8 bh = *(const bf16x8*)(bhp + ks * 16), bl = *(const bf16x8*)(blp + ks * 16);
            if (r >= 16) { const v4u z = {0u, 0u, 0u, 0u}; bh = __builtin_bit_cast(bf16x8, z); bl = bh; }
            acc = MFMA32(af, bh, acc); acc = MFMA32(af, bl, acc); }
        if (r < 16) { float* Gq = G + (size_t)kq * MP * 16;
#pragma unroll
            for (int q = 0; q < 16; ++q) Gq[(size_t)(t0 + (q & 3) + 8 * (q >> 2) + 4 * hh) * 16 + r] = acc[q]; }
    }
}

struct EpiZ { bf16* Z; __device__ __forceinline__ void operator()(int m, int n, float v) const { Z[(size_t)m * NZ + n] = (bf16)f2bf(v); } };
__device__ __forceinline__ void phase_gemm1(const Args& a, LAS unsigned char* lds) {
    unsigned char* ws = a.ws;
#if USE_MFMA
    { pg8::Gemm g{(const bf16*)(ws + WS_XN), (const bf16*)(ws + WS_WIN), MP, NZ, D}; pg8::TailOrder S; S.init(NP, NZ, (int)gridDim.x, (int)blockIdx.x);
      const float* cs = (const float*)(ws + WS_ROPE); pg8::EpiZRope E{(bf16*)(ws + WS_Z), cs, cs + 2049 * 128};
      pg8::gemm_phase<pg8::EpiZRope, pg8::TailOrder, true, true>(lds, g, S, E); }
#else
    EpiZ e{(bf16*)(ws + WS_Z)};
    slow_gemm(lds, (const bf16*)(ws + WS_XN), (const bf16*)(ws + WS_WIN), MP, NZ, D, e);
#endif
#if USE_MFMA
    { int rank, cnt; idle_rank((MP / 256) * (NZ / 256), rank, cnt);
      if (rank >= 0) { const int widx = rank * NWAVES + (int)(threadIdx.x >> 6), nw = cnt * NWAVES; gates_mfma(a, widx, nw); bg_transposes(a, lds, 0, BG_TS, widx, nw); bg_transposes(a, lds, BG_T2, BG_TN, widx, nw); } }
#else
    { const int wv = (int)(threadIdx.x >> 6), widx = (int)blockIdx.x * NWAVES + wv, nw = (int)gridDim.x * NWAVES; gates_mfma(a, widx, nw); bg_transposes(a, lds, 0, BG_TN, widx, nw); bg_tables(a, 0, 2 * NEXP, widx, nw); }
#endif
}

__device__ __forceinline__ void phase_rope_conv(const Args& a) {
    unsigned char* ws = a.ws; const int gt = blockIdx.x * NTHR + threadIdx.x, NGT = gridDim.x * NTHR;
    bf16* Z = (bf16*)(ws + WS_Z); const float* cs = (const float*)(ws + WS_ROPE); const float* sn = cs + 2049 * 128;
    if (!USE_MFMA) for (size_t j = gt; j < (size_t)M * 2048; j += NGT) {
        const int m = (int)(j >> 11), p = (int)(j & 2047), hh = p >> 7, i = p & 127;
        const int col = hh * 256 + i; const int pi = (m < NP) ? (m & (SEQ - 1)) : 2048;
        const float c = cs[pi * 128 + i], s = sn[pi * 128 + i];
        const float x1 = bf2f(Z[(size_t)m * NZ + col]), x2 = bf2f(Z[(size_t)m * NZ + col + 128]);
        float y1 = x1 * c - x2 * s, y2 = x1 * s + x2 * c;
        if (hh >= 8) { y1 *= 0.0625f; y2 *= 0.0625f; }
        Z[(size_t)m * NZ + col] = (bf16)f2bf(y1); Z[(size_t)m * NZ + col + 128] = (bf16)f2bf(y2);
    }
    bf16* MQK = (bf16*)(ws + WS_MQK); const float* cw = a.in[I_CW]; const float* cb = a.in[I_CB]; const float* sconv = a.in[I_SCONV];
    for (int j = gt; j < M * 512; j += NGT) {
        const int m = j >> 9, c = (j & 511) * 8;
        float acc[8];
        { const f32x4 b0 = *(const f32x4*)(cb + c), b1 = *(const f32x4*)(cb + c + 4); acc[0] = b0.x; acc[1] = b0.y; acc[2] = b0.z; acc[3] = b0.w; acc[4] = b1.x; acc[5] = b1.y; acc[6] = b1.z; acc[7] = b1.w; }
#pragma unroll
        for (int q = 0; q < 4; ++q) {
            float xv[8]; bool have = true;
            if (m < NP) { const int t = m & (SEQ - 1); have = (t - 3 + q) >= 0;
                if (have) { const v4u z = *(const v4u*)(Z + (size_t)(m - 3 + q) * NZ + ZMQK + c);
#pragma unroll
                    for (int i = 0; i < 4; ++i) { xv[2 * i] = bf2f(z[i] & 0xffffu); xv[2 * i + 1] = bf2f(z[i] >> 16); } } }
            else if (q < 3) { const float* sp = sconv + ((size_t)(m - NP) * 3 + q) * 4096 + c; const f32x4 s0 = *(const f32x4*)sp, s1 = *(const f32x4*)(sp + 4);
                xv[0] = s0.x; xv[1] = s0.y; xv[2] = s0.z; xv[3] = s0.w; xv[4] = s1.x; xv[5] = s1.y; xv[6] = s1.z; xv[7] = s1.w; }
            else { const v4u z = *(const v4u*)(Z + (size_t)m * NZ + ZMQK + c);
#pragma unroll
                for (int i = 0; i < 4; ++i) { xv[2 * i] = bf2f(z[i] & 0xffffu); xv[2 * i + 1] = bf2f(z[i] >> 16); } }
            if (have) { const f32x4 w0 = *(const f32x4*)(cw + q * 4096 + c), w1 = *(const f32x4*)(cw + q * 4096 + c + 4);
                acc[0] += w0.x * xv[0]; acc[1] += w0.y * xv[1]; acc[2] += w0.z * xv[2]; acc[3] += w0.w * xv[3]; acc[4] += w1.x * xv[4]; acc[5] += w1.y * xv[5]; acc[6] += w1.z * xv[6]; acc[7] += w1.w * xv[7]; }
        }
        const float sc = (c >= 2048) ? 0.0625f : 1.f;
        v4u o;
#pragma unroll
        for (int i = 0; i < 4; ++i) o[i] = pk2(siluf_(acc[2 * i]) * sc, siluf_(acc[2 * i + 1]) * sc);
        *(v4u*)(MQK + (size_t)m * 4096 + c) = o;
    }
    float* convp = a.out + O_CONVP; float* convs = a.out + O_CONVS;
    for (int j = gt; j < NPB * 3 * 1024; j += NGT) { const int b = j / (3 * 1024), q = (j >> 10) % 3, c = (j & 1023) * 4; const unsigned long long z = *(const unsigned long long*)(Z + (size_t)(b * SEQ + SEQ - 3 + q) * NZ + ZMQK + c);
        *(f32x4*)(convp + (size_t)j * 4) = (f32x4){bf2f((unsigned)z & 0xffffu), bf2f(((unsigned)z) >> 16), bf2f((unsigned)(z >> 32) & 0xffffu), bf2f((unsigned)(z >> 48))}; }
    for (int j = gt; j < NS * 3 * 1024; j += NGT) { const int b = j / (3 * 1024), q = (j >> 10) % 3, c = (j & 1023) * 4; f32x4 o;
        if (q < 2) o = *(const f32x4*)(sconv + ((size_t)b * 3 + q + 1) * 4096 + c);
        else { const unsigned long long z = *(const unsigned long long*)(Z + (size_t)(NP + b) * NZ + ZMQK + c); o = (f32x4){bf2f((unsigned)z & 0xffffu), bf2f(((unsigned)z) >> 16), bf2f((unsigned)(z >> 32) & 0xffffu), bf2f((unsigned)(z >> 48))}; }
        *(f32x4*)(convs + (size_t)j * 4) = o; }
}

__device__ __forceinline__ float block_sum256(float v, LAS float* red, int tid) {
    v = wave_sum(v);
    __syncthreads();
    if ((tid & 63) == 0) red[tid >> 6] = v;
    __syncthreads();
    return (red[0] + red[1]) + (red[2] + red[3]) + (red[4] + red[5]) + (red[6] + red[7]);
}
template <bool ML>
__device__ __forceinline__ void seq_mixer_unit(const Args& a, LAS unsigned char* ldsb, int row0, int T, int h, const float* S0, const float* n0p, const float* m0p,
                                               float* Sout, float* nout, float* mout) {
    LAS float* qs = (LAS float*)ldsb; LAS float* ks = qs + 256; LAS float* vs = ks + 256; LAS float* part = vs + 256  ; LAS float* red = part + 512  ;
    unsigned char* ws = a.ws; const bf16* Z = (const bf16*)(ws + WS_Z); const bf16* MQK = (const bf16*)(ws + WS_MQK); const float* G = (const float*)(ws + WS_G); bf16* MIX = (bf16*)(ws + WS_MIX);
    const int tid = threadIdx.x, e = tid & 255, hf = tid >> 8;
    float S[128];
#pragma unroll
    for (int dd = 0; dd < 128; ++dd) S[dd] = S0 ? S0[(size_t)(hf * 128 + dd) * 256 + e] : 0.f;
    float nvec = 0.f, mst = 0.f;
    if (ML) { if (n0p && tid < 256) nvec = n0p[tid]; if (m0p) mst = m0p[0]; }
    const float gamma = 1.f - exp2f(-5.f - (float)h);
    const float gn = ML ? a.in[I_GMN][h * 256 + e] : a.in[I_GRN][h * 256 + e];
    const float big = a.in[I_BG][h], bfg = a.in[I_BG][8 + h];
    for (int t = 0; t < T; ++t) {
        const int row = row0 + t;
        __syncthreads();
        if (tid < 256) {
            if (ML) { qs[tid] = bf2f(MQK[(size_t)row * 4096 + h * 256 + tid]); ks[tid] = bf2f(MQK[(size_t)row * 4096 + 2048 + h * 256 + tid]); vs[tid] = bf2f(Z[(size_t)row * NZ + ZMV + h * 256 + tid]); }
            else { qs[tid] = bf2f(Z[(size_t)row * NZ + ZQ + h * 256 + tid]); ks[tid] = bf2f(Z[(size_t)row * NZ + ZK + h * 256 + tid]); vs[tid] = bf2f(Z[(size_t)row * NZ + ZV + h * 256 + tid]); }
        }
        float dec = gamma, wk = 1.f, mnew = 0.f;
        if (ML) { const float ig = gate_ld(G, row, h) + big, lf = log_sigmoidf_(gate_ld(G, row, 8 + h) + bfg);
            mnew = fmaxf(lf + mst, ig); dec = __expf(lf + mst - mnew); wk = __expf(ig - mnew); mst = mnew; }
        __syncthreads();
        const float ve = vs[e] * wk; float po = 0.f;
#pragma unroll
        for (int dd = 0; dd < 128; ++dd) { const int d = hf * 128 + dd; S[dd] = dec * S[dd] + ks[d] * ve; po += qs[d] * S[dd]; }
        part[tid] = po;
        float den = 0.f;
        if (ML) { float dp = 0.f; if (tid < 256) { nvec = dec * nvec + wk * ks[tid]; dp = qs[tid] * nvec; } den = block_sum256(dp, red, tid); }
        __syncthreads();
        float o = 0.f;
        if (tid < 256) { o = part[tid] + part[tid + 256]; if (ML) o = o / fmaxf(fabsf(den), __expf(-mnew)); }
        const float mu = block_sum256(tid < 256 ? o : 0.f, red, tid) * (1.f / 256.f);
        const float dv = (tid < 256) ? (o - mu) : 0.f;
        const float var = block_sum256(dv * dv, red, tid) * (1.f / 256.f);
        if (tid < 256) {
            const float on = dv * (1.f / sqrtf(var + LN_EPS)) * gn;
            float gate;
            if (ML) gate = sigmoidf_(bf2f(Z[(size_t)row * NZ + ZMO + h * 256 + tid])); else gate = siluf_(bf2f(Z[(size_t)row * NZ + ZG + h * 256 + tid]));
            MIX[(size_t)row * D + (ML ? RW : 0) + h * 256 + tid] = (bf16)f2bf(on * gate);
        }
    }
#pragma unroll
    for (int dd = 0; dd < 128; ++dd) Sout[(size_t)(hf * 128 + dd) * 256 + e] = S[dd];
    if (ML) { if (tid < 256) nout[tid] = nvec; if (tid == 0) mout[0] = mst; }
}
__device__ __forceinline__ void phase_seq_mixers(const Args& a, LAS unsigned char* lds) {
    for (int u = blockIdx.x; u < 64 + 2048; u += gridDim.x) {
        const bool sample = u >= 64; const int uu = sample ? u - 64 : u; const bool ml = sample ? (uu >= 1024) : (uu >= 32); const int v = sample ? (uu & 1023) : (uu & 31);
        const int b = v >> 3, h = v & 7; const int row0 = sample ? NP + b : b * SEQ, T = sample ? 1 : SEQ;
        if (!ml) { seq_mixer_unit<false>(a, lds, row0, T, h, sample ? a.in[I_SRET] + (size_t)v * 65536 : nullptr, nullptr, nullptr, a.out + (sample ? O_RETS : O_RETP) + (size_t)v * 65536, nullptr, nullptr); }
        else { seq_mixer_unit<true>(a, lds, row0, T, h, sample ? a.in[I_SC] + (size_t)v * 65536 : nullptr, sample ? a.in[I_SN] + (size_t)v * 256 : nullptr, sample ? a.in[I_SM] + v : nullptr,
                                    a.out + (sample ? O_CS : O_CP) + (size_t)v * 65536, a.out + (sample ? O_NS : O_NP) + (size_t)v * 256, a.out + (sample ? O_MS : O_MP) + v); }
        __syncthreads();
    }
}

constexpr int KT_P = 136;
constexpr int QL_P = 264;
constexpr int VT_P = 132;
constexpr int ST_P = 136;
constexpr int M3_SMALL = 67584 + 256 * ST_P * 2;
__device__ __forceinline__ float wave_incl_scan(float v, int lane) {
#pragma unroll
    for (int o = 1; o < 64; o <<= 1) { const float t = __shfl_up(v, o); if (lane >= o) v += t; }
    return v;
}
__device__ __forceinline__ float wave_incl_scanmax(float v, int lane) {
#pragma unroll
    for (int o = 1; o < 64; o <<= 1) { const float t = __shfl_up(v, o); if (lane >= o) v = fmaxf(v, t); }
    return v;
}
__device__ __forceinline__ float wave_max(float v) {
#pragma unroll
    for (int o = 1; o < 64; o <<= 1) v = fmaxf(v, __shfl_xor(v, o));
    return v;
}
__device__ __forceinline__ void gate_scan(const float* G, const float* bgate, int row0, int h, int lane, LAS float* aj, LAS float* btv, LAS float* cmx, float& amax, float& bl) {
    const float big = bgate[h], bfg = bgate[8 + h];
    const float ig0 = gate_ld(G, row0 + lane, h) + big, ig1 = gate_ld(G, row0 + 64 + lane, h) + big;
    const float lf0 = log_sigmoidf_(gate_ld(G, row0 + lane, 8 + h) + bfg), lf1 = log_sigmoidf_(gate_ld(G, row0 + 64 + lane, 8 + h) + bfg);
    const float b0 = wave_incl_scan(lf0, lane); const float tot0 = __shfl(b0, 63); const float b1 = wave_incl_scan(lf1, lane) + tot0;
    const float a0 = ig0 - b0, a1 = ig1 - b1;
    const float c0 = wave_incl_scanmax(a0, lane); const float mx0 = __shfl(c0, 63); const float c1 = fmaxf(wave_incl_scanmax(a1, lane), mx0);
    aj[lane] = a0; aj[lane + 64] = a1; btv[lane] = b0; btv[lane + 64] = b1; cmx[lane] = c0; cmx[lane + 64] = c1;
    amax = __shfl(c1, 63); bl = __shfl(b1, 63);
}
__device__ __forceinline__ void conv8_prompt(const Args& a, const bf16* Z, int row, int t, int col, float (&out)[8]) {
    const float* cw = a.in[I_CW]; const float* cb = a.in[I_CB];
    { const f32x4 b0 = *(const f32x4*)(cb + col), b1 = *(const f32x4*)(cb + col + 4); out[0] = b0.x; out[1] = b0.y; out[2] = b0.z; out[3] = b0.w; out[4] = b1.x; out[5] = b1.y; out[6] = b1.z; out[7] = b1.w; }
#pragma unroll
    for (int q = 0; q < 4; ++q) { if (t - 3 + q >= 0) { const v4u z = *(const v4u*)(Z + (size_t)(row - 3 + q) * NZ + ZMQK + col); const f32x4 w0 = *(const f32x4*)(cw + q * 4096 + col), w1 = *(const f32x4*)(cw + q * 4096 + col + 4);
            out[0] += w0.x * bf2f(z.x & 0xffffu); out[1] += w0.y * bf2f(z.x >> 16); out[2] += w0.z * bf2f(z.y & 0xffffu); out[3] += w0.w * bf2f(z.y >> 16);
            out[4] += w1.x * bf2f(z.z & 0xffffu); out[5] += w1.y * bf2f(z.z >> 16); out[6] += w1.z * bf2f(z.w & 0xffffu); out[7] += w1.w * bf2f(z.w >> 16); } }
    const float sc = (col >= 2048) ? 0.0625f : 1.f;
#pragma unroll
    for (int i = 0; i < 8; ++i) out[i] = siluf_(out[i]) * sc;
}
__device__ __forceinline__ float conv1_sample(const Args& a, const bf16* Z, int b, int col) {
    const float* cw = a.in[I_CW]; const float* sconv = a.in[I_SCONV]; float acc = a.in[I_CB][col];
#pragma unroll
    for (int q = 0; q < 3; ++q) acc += cw[q * 4096 + col] * sconv[((size_t)b * 3 + q) * 4096 + col];
    acc += cw[3 * 4096 + col] * bf2f(Z[(size_t)(NP + b) * NZ + ZMQK + col]);
    return siluf_(acc) * ((col >= 2048) ? 0.0625f : 1.f);
}
__device__ __forceinline__ void m1_unit(const Args& a, LAS unsigned char* ldsb, int kind, int bh, int c) {
    unsigned char* ws = a.ws; const int tid = threadIdx.x, lane = tid & 63, w = tid >> 6, r = lane & 31, hh = lane >> 5;
    const int b = bh >> 3, h = bh & 7, row0 = b * SEQ + c * 128, unit = (kind * 32 + bh) * 16 + c;
    LAS bf16* KT = (LAS bf16*)ldsb; LAS bf16* VT = KT + 256 * KT_P; LAS float* wj = (LAS float*)(ldsb + 2 * 256 * KT_P * 2); LAS float* aj = wj + 128; LAS float* btv = aj + 128; LAS float* cmx = btv + 128;
    const bf16* Z = (const bf16*)(ws + WS_Z); const bf16* MQK = (const bf16*)(ws + WS_MQK);
    const bf16* Ksrc = kind ? MQK + (size_t)row0 * 4096 + 2048 + h * 256 : Z + (size_t)row0 * NZ + ZK + h * 256; const int kst = kind ? 4096 : NZ;
    const bf16* Vsrc = Z + (size_t)row0 * NZ + (kind ? ZMV : ZV) + h * 256;
    __syncthreads();
    if (kind) { if (w == 0) { float amax, bl; gate_scan((const float*)(ws + WS_G), a.in[I_BG], row0, h, lane, aj, btv, cmx, amax, bl);
            wj[lane] = __expf(aj[lane] - amax); wj[lane + 64] = __expf(aj[lane + 64] - amax);
            if (lane == 0) { float* sc = (float*)(ws + WS_SCAL); sc[bh * 16 + c] = amax; sc[512 + bh * 16 + c] = bl; } } }
    else { if (tid < 128) { const float lg = log1pf(-exp2f(-5.f - (float)h)); wj[tid] = __expf(lg * (float)(127 - tid)); } }
    __syncthreads();
#pragma unroll 4
    for (int idx = tid; idx < 128 * 32; idx += NTHR) { const int j = idx & 127, dg = idx >> 7; const float wv = wj[j];
        const v4u vv = *(const v4u*)(Vsrc + (size_t)j * NZ + dg * 8);
        float kf[8];
        if (kFuseConv && kind != 0) conv8_prompt(a, Z, row0 + j, c * 128 + j, 2048 + h * 256 + dg * 8, kf);
        else { const v4u kv = *(const v4u*)(Ksrc + (size_t)j * kst + dg * 8);
#pragma unroll
            for (int i = 0; i < 4; ++i) { kf[2 * i] = bf2f(kv[i] & 0xffffu); kf[2 * i + 1] = bf2f(kv[i] >> 16); } }
#pragma unroll
        for (int i = 0; i < 4; ++i) {
            KT[(dg * 8 + 2 * i) * KT_P + j] = (bf16)f2bf(kf[2 * i] * wv); KT[(dg * 8 + 2 * i + 1) * KT_P + j] = (bf16)f2bf(kf[2 * i + 1] * wv);
            VT[(dg * 8 + 2 * i) * KT_P + j] = (bf16)(vv[i] & 0xffffu); VT[(dg * 8 + 2 * i + 1) * KT_P + j] = (bf16)(vv[i] >> 16); } }
    __syncthreads();
    const int wr = w >> 1, wc = w & 1;
    f32x16 acc[2][4];
#pragma unroll
    for (int mi = 0; mi < 2; ++mi)
#pragma unroll
        for (int ni = 0; ni < 4; ++ni)
#pragma unroll
            for (int q = 0; q < 16; ++q) acc[mi][ni][q] = 0.f;
#pragma unroll 2
    for (int ks = 0; ks < 8; ++ks) { const int k0 = ks * 16 + 8 * hh;
        bf16x8 af[2], bfr[4];
#pragma unroll
        for (int mi = 0; mi < 2; ++mi) af[mi] = *(const LAS bf16x8*)(KT + (64 * wr + 32 * mi + r) * KT_P + k0);
#pragma unroll
        for (int ni = 0; ni < 4; ++ni) bfr[ni] = *(const LAS bf16x8*)(VT + (128 * wc + 32 * ni + r) * KT_P + k0);
#pragma unroll
        for (int mi = 0; mi < 2; ++mi)
#pragma unroll
            for (int ni = 0; ni < 4; ++ni) acc[mi][ni] = MFMA32(af[mi], bfr[ni], acc[mi][ni]); }
    if (kind && tid < 256) { float s = 0.f;
        for (int j = 0; j < 128; j += 8) { const v4u kk = *(const LAS v4u*)(KT + tid * KT_P + j);
            s += (bf2f(kk.x & 0xffffu) + bf2f(kk.x >> 16)) + (bf2f(kk.y & 0xffffu) + bf2f(kk.y >> 16)) + (bf2f(kk.z & 0xffffu) + bf2f(kk.z >> 16)) + (bf2f(kk.w & 0xffffu) + bf2f(kk.w >> 16)); }
        ((float*)(ws + WS_NLOC))[(size_t)(bh * 16 + c) * 256 + tid] = s; }
    __syncthreads();
    LAS bf16* OT = (LAS bf16*)ldsb;
#pragma unroll
    for (int mi = 0; mi < 2; ++mi)
#pragma unroll
        for (int ni = 0; ni < 4; ++ni)
#pragma unroll
            for (int rq = 0; rq < 4; ++rq) { const int d0 = 64 * wr + 32 * mi + 8 * rq + 4 * hh, e = 128 * wc + 32 * ni + r;
                *(LAS unsigned long long*)(OT + e * QL_P + d0) = (unsigned long long)pk2(acc[mi][ni][4 * rq], acc[mi][ni][4 * rq + 1]) | ((unsigned long long)pk2(acc[mi][ni][4 * rq + 2], acc[mi][ni][4 * rq + 3]) << 32); }
    __syncthreads();
    { bf16* UT = (bf16*)(ws + WS_UT) + (size_t)unit * 65536;
#pragma unroll 8
      for (int idx = tid; idx < 256 * 32; idx += NTHR) { const int e = idx >> 5, p = idx & 31; *(v4u*)(UT + e * 256 + p * 8) = *(const LAS v4u*)(OT + e * QL_P + p * 8); } }
}
__device__ __forceinline__ void sample_unit(const Args& a, LAS unsigned char* ldsb, int kind, int v) {
    unsigned char* ws = a.ws; const int tid = threadIdx.x, lane = tid & 63, w = tid >> 6; const int b = v >> 3, h = v & 7, row = NP + b;
    LAS float* qs = (LAS float*)ldsb; LAS float* ks = qs + 256; LAS float* vs = ks + 256; LAS float* red = vs + 256; LAS float* opart = red + 16;
    const bf16* Z = (const bf16*)(ws + WS_Z); const bf16* MQK = (const bf16*)(ws + WS_MQK); const float* G = (const float*)(ws + WS_G); bf16* MIX = (bf16*)(ws + WS_MIX);
    const float* S0 = (kind ? a.in[I_SC] : a.in[I_SRET]) + (size_t)v * 65536; float* Sout = a.out + (kind ? O_CS : O_RETS) + (size_t)v * 65536;
    __syncthreads();
    if (tid < 256) {
        if (kind) { if (FUSE_CONV) { qs[tid] = bf2f(f2bf(conv1_sample(a, Z, b, h * 256 + tid))); ks[tid] = bf2f(f2bf(conv1_sample(a, Z, b, 2048 + h * 256 + tid))); }
                    else { qs[tid] = bf2f(MQK[(size_t)row * 4096 + h * 256 + tid]); ks[tid] = bf2f(MQK[(size_t)row * 4096 + 2048 + h * 256 + tid]); }
                    vs[tid] = bf2f(Z[(size_t)row * NZ + ZMV + h * 256 + tid]); }
        else { qs[tid] = bf2f(Z[(size_t)row * NZ + ZQ + h * 256 + tid]); ks[tid] = bf2f(Z[(size_t)row * NZ + ZK + h * 256 + tid]); vs[tid] = bf2f(Z[(size_t)row * NZ + ZV + h * 256 + tid]); } }
    float dec = 1.f - exp2f(-5.f - (float)h), wk = 1.f, mnew = 0.f;
    if (kind) { const float ig = gate_ld(G, row, h) + a.in[I_BG][h], lf = log_sigmoidf_(gate_ld(G, row, 8 + h) + a.in[I_BG][8 + h]); const float m0 = a.in[I_SM][v];
        mnew = fmaxf(lf + m0, ig); dec = __expf(lf + m0 - mnew); wk = __expf(ig - mnew); }
    __syncthreads();
    const f32x4 v4 = *(const LAS f32x4*)(vs + lane * 4);
    f32x4 o = {0.f, 0.f, 0.f, 0.f};
#pragma unroll 1
    for (int hb = 0; hb < 2; ++hb) {
        f32x4 sv[16];
#pragma unroll
        for (int dd = 0; dd < 16; ++dd) sv[dd] = __builtin_nontemporal_load((const f32x4*)(S0 + (size_t)(32 * w + 16 * hb + dd) * 256 + lane * 4));
#pragma unroll
        for (int dd = 0; dd < 16; ++dd) { const int d = 32 * w + 16 * hb + dd; const float kd = ks[d] * wk;
            const f32x4 sn = dec * sv[dd] + kd * v4; __builtin_nontemporal_store(sn, (f32x4*)(Sout + (size_t)d * 256 + lane * 4)); o += qs[d] * sn; }
    }
    *(LAS f32x4*)(opart + w * 256 + lane * 4) = o;
    float den = 0.f;
    if (kind) { float dp = 0.f; if (tid < 256) { const float nn = dec * a.in[I_SN][(size_t)v * 256 + tid] + wk * ks[tid]; (a.out + O_NS)[(size_t)v * 256 + tid] = nn; dp = qs[tid] * nn; } den = block_sum256(dp, red, tid);
        if (tid == 0) (a.out + O_MS)[v] = mnew; }
    __syncthreads();
    float ov = 0.f;
    if (tid < 256) { ov = ((opart[tid] + opart[256 + tid]) + (opart[512 + tid] + opart[768 + tid])) + ((opart[1024 + tid] + opart[1280 + tid]) + (opart[1536 + tid] + opart[1792 + tid]));
        if (kind) ov = ov / fmaxf(fabsf(den), __expf(-mnew)); }
    const float mu = block_sum256(tid < 256 ? ov : 0.f, red, tid) * (1.f / 256.f);
    const float dv = (tid < 256) ? (ov - mu) : 0.f;
    const float var = block_sum256(dv * dv, red, tid) * (1.f / 256.f);
    if (tid < 256) { const float gn = (kind ? a.in[I_GMN] : a.in[I_GRN])[h * 256 + tid]; const float on = dv * (1.f / sqrtf(var + LN_EPS)) * gn;
        const float gate = kind ? sigmoidf_(bf2f(Z[(size_t)row * NZ + ZMO + h * 256 + tid])) : siluf_(bf2f(Z[(size_t)row * NZ + ZG + h * 256 + tid]));
        if (USE_MX) { const float vq = fminf(fmaxf(on * gate, -448.f), 448.f); (ws + WS_MIX)[(size_t)row * D + (kind ? RW : 0) + h * 256 + tid] = (unsigned char)(__builtin_amdgcn_cvt_pk_fp8_f32(vq, vq, 0, false) & 0xff); }
        else MIX[(size_t)row * D + (kind ? RW : 0) + h * 256 + tid] = (bf16)f2bf(on * gate); }
}
__device__ __forceinline__ void phase_scan(const Args& a, LAS unsigned char* ldsb) {
    unsigned char* ws = a.ws; const int tid = threadIdx.x, gt = blockIdx.x * NTHR + tid, NGT = gridDim.x * NTHR;
    const bf16* UT = (const bf16*)(ws + WS_UT); bf16* ST = (bf16*)(ws + WS_ST); const float* sc = (const float*)(ws + WS_SCAL);
    LAS float* T = (LAS float*)ldsb;
    for (int blk = blockIdx.x; blk < 64 * 16; blk += gridDim.x) { const int kbh = blk >> 4, e0 = ((blk >> 2) & 3) * 64, d0 = (blk & 3) * 64, kind = kbh >> 5, bh = kbh & 31, h = bh & 7;
        const int el = tid >> 3, dch = tid & 7;
        float S[8];
#pragma unroll
        for (int i = 0; i < 8; ++i) S[i] = 0.f;
        float m = 0.f; const float g128 = __expf(128.f * log1pf(-exp2f(-5.f - (float)h)));
        const size_t ub0 = (size_t)kbh * 16 * 65536 + (size_t)(e0 + el) * 256 + d0 + 8 * dch;
        v4u ubv[16];
#pragma unroll
        for (int c = 0; c < 16; ++c) ubv[c] = __builtin_nontemporal_load((const v4u*)(UT + ub0 + (size_t)c * 65536));
#pragma unroll
        for (int c = 0; c < 16; ++c) { const v4u ub = ubv[c];
            v4u so; so.x = pk2(S[0], S[1]); so.y = pk2(S[2], S[3]); so.z = pk2(S[4], S[5]); so.w = pk2(S[6], S[7]);
            *(v4u*)(ST + ub0 + (size_t)c * 65536) = so;
            float dec = g128, scl = 1.f;
            if (kind) { const float amax = sc[bh * 16 + c], bl = sc[512 + bh * 16 + c]; const float mn = bl + fmaxf(m, amax); dec = __expf(bl + m - mn); scl = __expf(bl + amax - mn); m = mn; }
#pragma unroll
            for (int i = 0; i < 4; ++i) { S[2 * i] = dec * S[2 * i] + scl * bf2f(ub[i] & 0xffffu); S[2 * i + 1] = dec * S[2 * i + 1] + scl * bf2f(ub[i] >> 16); } }
        __syncthreads();
#pragma unroll
        for (int i = 0; i < 8; ++i) T[el * 65 + 8 * dch + i] = S[i];
        __syncthreads();
        { const int dl = tid >> 3, ech = tid & 7; float* So = a.out + (kind ? O_CP : O_RETP) + (size_t)bh * 65536 + (size_t)(d0 + dl) * 256 + e0 + 8 * ech;
          f32x4 o0, o1;
#pragma unroll
          for (int i = 0; i < 4; ++i) { o0[i] = T[(8 * ech + i) * 65 + dl]; o1[i] = T[(8 * ech + 4 + i) * 65 + dl]; }
          *(f32x4*)So = o0; *(f32x4*)(So + 4) = o1; }
    }
    const float* NLOC = (const float*)(ws + WS_NLOC); float* NST = (float*)(ws + WS_NST); float* scw = (float*)(ws + WS_SCAL);
    for (int it = gt; it < 32 * 256; it += NGT) { const int bh = it >> 8, d = it & 255; float n = 0.f, m = 0.f;
        for (int c = 0; c < 16; ++c) { NST[(size_t)(bh * 16 + c) * 256 + d] = n; if (d == 0) scw[1024 + bh * 16 + c] = m;
            const float amax = sc[bh * 16 + c], bl = sc[512 + bh * 16 + c]; const float mn = bl + fmaxf(m, amax);
            n = __expf(bl + m - mn) * n + __expf(bl + amax - mn) * NLOC[(size_t)(bh * 16 + c) * 256 + d]; m = mn; }
        (a.out + O_NP)[(size_t)bh * 256 + d] = n; if (d == 0) (a.out + O_MP)[bh] = m; }
}
__device__ __forceinline__ void m3_unit(const Args& a, LAS unsigned char* ldsb, int kind, int bh, int c) {
    unsigned char* ws = a.ws; const int tid = threadIdx.x, lane = tid & 63, w = tid >> 6, r = lane & 31, hh = lane >> 5;
    const int b = bh >> 3, h = bh & 7, row0 = b * SEQ + c * 128, unit = (kind * 32 + bh) * 16 + c;
    LAS bf16* Ql = (LAS bf16*)ldsb; LAS bf16* Kl = Ql + 128 * QL_P; LAS bf16* VT = Kl;
    LAS float* aj = (LAS float*)(ldsb + M3_SMALL); LAS float* btv = aj + 128; LAS float* cmx = btv + 128; LAS float* nv = cmx + 128  ; LAS float* st = nv + 256  ;
    const bf16* Z = (const bf16*)(ws + WS_Z); const bf16* MQK = (const bf16*)(ws + WS_MQK);
    const bf16* Qsrc = kind ? MQK + (size_t)row0 * 4096 + h * 256 : Z + (size_t)row0 * NZ + ZQ + h * 256;
    const bf16* Ksrc = kind ? MQK + (size_t)row0 * 4096 + 2048 + h * 256 : Z + (size_t)row0 * NZ + ZK + h * 256; const int qst = kind ? 4096 : NZ;
    const bf16* Vsrc = Z + (size_t)row0 * NZ + (kind ? ZMV : ZV) + h * 256;
    const float l2g = log2f(1.f - exp2f(-5.f - (float)h));
    __syncthreads();
    float mc = 0.f;
    if (kind) { mc = ((const float*)(ws + WS_SCAL))[1024 + bh * 16 + c];
        if (w == 0) { float amax, bl; gate_scan((const float*)(ws + WS_G), a.in[I_BG], row0, h, lane, aj, btv, cmx, amax, bl); }
        if (tid >= 256) nv[tid - 256] = ((const float*)(ws + WS_NST))[(size_t)(bh * 16 + c) * 256 + tid - 256]; }
#pragma unroll 2
    for (int idx = tid; idx < 128 * 32; idx += NTHR) { const int i = idx >> 5, p = idx & 31;
        if (kFuseConv && kind != 0) { float qf[8], kf[8]; conv8_prompt(a, Z, row0 + i, c * 128 + i, h * 256 + p * 8, qf); conv8_prompt(a, Z, row0 + i, c * 128 + i, 2048 + h * 256 + p * 8, kf);
            v4u qo, ko;
#pragma unroll
            for (int k = 0; k < 4; ++k) { qo[k] = pk2(qf[2 * k], qf[2 * k + 1]); ko[k] = pk2(kf[2 * k], kf[2 * k + 1]); }
            *(LAS v4u*)(Ql + i * QL_P + p * 8) = qo; *(LAS v4u*)(Kl + i * QL_P + p * 8) = ko; }
        else { *(LAS v4u*)(Ql + i * QL_P + p * 8) = *(const v4u*)(Qsrc + (size_t)i * qst + p * 8); *(LAS v4u*)(Kl + i * QL_P + p * 8) = *(const v4u*)(Ksrc + (size_t)i * qst + p * 8); } }
    __syncthreads();
    int hq = 4 * hh; asm volatile("" : "+v"(hq));
    const int it = w & 3, eh = w >> 2, il = 32 * it + r;
    float Mi = 0.f, rs;
    if (kind) { Mi = fmaxf(mc, cmx[il]); rs = __expf(mc - Mi); } else rs = exp2f((float)(il + 1) * l2g);
    bf16x8 xb[4][2]; float rowsum = 0.f;
#pragma unroll
    for (int jt = 0; jt < 4; ++jt) {
        if (jt <= it) {
            f32x16 x;
#pragma unroll
            for (int q = 0; q < 16; ++q) x[q] = 0.f;
#pragma unroll 4
            for (int ks = 0; ks < 16; ++ks) { const bf16x8 af = *(const LAS bf16x8*)(Kl + (32 * jt + r) * QL_P + ks * 16 + 8 * hh); const bf16x8 bq = *(const LAS bf16x8*)(Ql + il * QL_P + ks * 16 + 8 * hh); x = MFMA32(af, bq, x); }
            float xw[16];
#pragma unroll
            for (int q = 0; q < 16; ++q) { const int j = 32 * jt + (q & 3) + 8 * (q >> 2) + hq;
                float wgt; if (kind) wgt = __expf(aj[j] - Mi); else wgt = exp2f((float)(il - j) * l2g);
                xw[q] = (j <= il) ? x[q] * wgt : 0.f; rowsum += xw[q]; }
#pragma unroll
            for (int s = 0; s < 2; ++s) { v4u pk; pk.x = pk2(xw[8 * s + 0], xw[8 * s + 1]); pk.y = pk2(xw[8 * s + 2], xw[8 * s + 3]); pk.z = pk2(xw[8 * s + 4], xw[8 * s + 5]); pk.w = pk2(xw[8 * s + 6], xw[8 * s + 7]);
                xb[jt][s] = __builtin_bit_cast(bf16x8, pk); }
        } else { const v4u z = {0u, 0u, 0u, 0u}; xb[jt][0] = __builtin_bit_cast(bf16x8, z); xb[jt][1] = __builtin_bit_cast(bf16x8, z); }
    }
    float qn = 0.f;
    if (kind) { const LAS bf16* qr = Ql + il * QL_P + hh * 128;
        for (int d = 0; d < 128; d += 8) { const v4u qq = *(const LAS v4u*)(qr + d); const LAS float* np = nv + hh * 128 + d;
            qn += bf2f(qq.x & 0xffffu) * np[0] + bf2f(qq.x >> 16) * np[1] + bf2f(qq.y & 0xffffu) * np[2] + bf2f(qq.y >> 16) * np[3] + bf2f(qq.z & 0xffffu) * np[4] + bf2f(qq.z >> 16) * np[5] + bf2f(qq.w & 0xffffu) * np[6] + bf2f(qq.w >> 16) * np[7]; }
        qn += __shfl_xor(qn, 32); rowsum += __shfl_xor(rowsum, 32); }
    f32x16 acc[4];
#pragma unroll
    for (int et = 0; et < 4; ++et)
#pragma unroll
        for (int q = 0; q < 16; ++q) acc[et][q] = 0.f;
    const bf16* STu = (const bf16*)(ws + WS_ST) + (size_t)unit * 65536;
    LAS bf16* SL = Kl;
#pragma unroll 1
    for (int ch = 0; ch < 2; ++ch) {
        __syncthreads();
        { v4u sv[8];
#pragma unroll
          for (int k = 0; k < 8; ++k) { const int idx = tid + k * NTHR, e = idx >> 4, p = idx & 15; sv[k] = *(const v4u*)(STu + (size_t)e * 256 + ch * 128 + p * 8); }
#pragma unroll
          for (int k = 0; k < 8; ++k) { const int idx = tid + k * NTHR, e = idx >> 4, p = idx & 15; *(LAS v4u*)(SL + e * ST_P + p * 8) = sv[k]; } }
        __syncthreads();
#pragma unroll 2
        for (int ks = 0; ks < 8; ++ks) { const bf16x8 bq = *(const LAS bf16x8*)(Ql + il * QL_P + (ch * 8 + ks) * 16 + 8 * hh);
#pragma unroll
            for (int et = 0; et < 4; ++et) { const bf16x8 af = *(const LAS bf16x8*)(SL + (128 * eh + 32 * et + r) * ST_P + ks * 16 + 8 * hh); acc[et] = MFMA32(af, bq, acc[et]); } }
    }
    __syncthreads();
    { v4u vq[8];
#pragma unroll
      for (int k = 0; k < 8; ++k) { const int idx = tid + k * NTHR, j = idx & 127, dg = idx >> 7; vq[k] = *(const v4u*)(Vsrc + (size_t)j * NZ + dg * 8); }
#pragma unroll
      for (int k = 0; k < 8; ++k) { const int idx = tid + k * NTHR, j = idx & 127, dg = idx >> 7; const v4u vv = vq[k];
#pragma unroll
        for (int i = 0; i < 4; ++i) { VT[(dg * 8 + 2 * i) * VT_P + j] = (bf16)(vv[i] & 0xffffu); VT[(dg * 8 + 2 * i + 1) * VT_P + j] = (bf16)(vv[i] >> 16); } } }
    __syncthreads();
#pragma unroll
    for (int et = 0; et < 4; ++et)
#pragma unroll
        for (int q = 0; q < 16; ++q) acc[et][q] *= rs;
#pragma unroll
    for (int jt = 0; jt < 4; ++jt) {
        if (jt <= it) {
#pragma unroll
            for (int s = 0; s < 2; ++s)
#pragma unroll
                for (int et = 0; et < 4; ++et) { const LAS bf16* vp = VT + (128 * eh + 32 * et + r) * VT_P + 32 * jt + 16 * s + 4 * hh;
                    const unsigned long long lo = *(const LAS unsigned long long*)vp, hi = *(const LAS unsigned long long*)(vp + 8);
                    v4u av; av.x = (unsigned)lo; av.y = (unsigned)(lo >> 32); av.z = (unsigned)hi; av.w = (unsigned)(hi >> 32);
                    acc[et] = MFMA32(__builtin_bit_cast(bf16x8, av), xb[jt][s], acc[et]); }
        }
    }
    float hdiv = 1.f;
    if (kind) { const float den = rowsum + rs * qn; hdiv = 1.f / fmaxf(fabsf(den), __expf(-(btv[il] + Mi))); }
    float s1 = 0.f, s2 = 0.f;
#pragma unroll
    for (int et = 0; et < 4; ++et)
#pragma unroll
        for (int q = 0; q < 16; ++q) { const float v = acc[et][q] * hdiv; acc[et][q] = v; s1 += v; s2 += v * v; }
    s1 += __shfl_xor(s1, 32); s2 += __shfl_xor(s2, 32);
    if (hh == 0) { st[(w * 32 + r) * 2] = s1; st[(w * 32 + r) * 2 + 1] = s2; }
    __syncthreads();
    { const int pw = w ^ 4; s1 += st[(pw * 32 + r) * 2]; s2 += st[(pw * 32 + r) * 2 + 1]; }
    const float mu = s1 * (1.f / 256.f); const float var = fmaxf(s2 * (1.f / 256.f) - mu * mu, 0.f); const float rstd = 1.f / sqrtf(var + LN_EPS);
    LAS bf16* OL = (LAS bf16*)ldsb;
#pragma unroll
    for (int et = 0; et < 4; ++et)
#pragma unroll
        for (int rq = 0; rq < 4; ++rq) { const int e = 128 * eh + 32 * et + 8 * rq + 4 * hh;
            *(LAS unsigned long long*)(OL + il * QL_P + e) = (unsigned long long)pk2((acc[et][4 * rq] - mu) * rstd, (acc[et][4 * rq + 1] - mu) * rstd) | ((unsigned long long)pk2((acc[et][4 * rq + 2] - mu) * rstd, (acc[et][4 * rq + 3] - mu) * rstd) << 32); }
    __syncthreads();
    const float* gn = (kind ? a.in[I_GMN] : a.in[I_GRN]) + h * 256;
#pragma unroll 4
    for (int idx = tid; idx < 128 * 32; idx += NTHR) { const int i = idx >> 5, p = idx & 31; const int row = row0 + i;
        const v4u ov = *(const LAS v4u*)(OL + i * QL_P + p * 8); const v4u gz = *(const v4u*)(Z + (size_t)row * NZ + (kind ? ZMO : ZG) + h * 256 + p * 8);
        const f32x4 g0 = *(const f32x4*)(gn + p * 8), g1 = *(const f32x4*)(gn + p * 8 + 4); const float gg[8] = {g0.x, g0.y, g0.z, g0.w, g1.x, g1.y, g1.z, g1.w};
        float of[8];
#pragma unroll
        for (int k = 0; k < 4; ++k) { const float x0 = bf2f(ov[k] & 0xffffu), x1 = bf2f(ov[k] >> 16), z0 = bf2f(gz[k] & 0xffffu), z1 = bf2f(gz[k] >> 16);
            const float a0 = kind ? sigmoidf_(z0) : siluf_(z0), a1 = kind ? sigmoidf_(z1) : siluf_(z1);
            of[2 * k] = x0 * gg[2 * k] * a0; of[2 * k + 1] = x1 * gg[2 * k + 1] * a1; }
        if (USE_MX) *(unsigned long long*)(ws + WS_MIX + (size_t)row * D + (kind ? RW : 0) + h * 256 + p * 8) = (unsigned long long)pack4_fp8(of[0], of[1], of[2], of[3]) | ((unsigned long long)pack4_fp8(of[4], of[5], of[6], of[7]) << 32);
        else { v4u out; out.x = pk2(of[0], of[1]); out.y = pk2(of[2], of[3]); out.z = pk2(of[4], of[5]); out.w = pk2(of[6], of[7]);
            *(v4u*)((bf16*)(ws + WS_MIX) + (size_t)row * D + (kind ? RW : 0) + h * 256 + p * 8) = out; } }
}
__device__ __forceinline__ void conv_state_outputs(const Args& a) {
    unsigned char* ws = a.ws; const int gt = blockIdx.x * NTHR + threadIdx.x, NGT = gridDim.x * NTHR; const bf16* Z = (const bf16*)(ws + WS_Z); const float* sconv = a.in[I_SCONV];
    float* convp = a.out + O_CONVP; float* convs = a.out + O_CONVS;
    for (int j = gt; j < NPB * 3 * 1024; j += NGT) { const int b = j / (3 * 1024), q = (j >> 10) % 3, c = (j & 1023) * 4; const unsigned long long z = *(const unsigned long long*)(Z + (size_t)(b * SEQ + SEQ - 3 + q) * NZ + ZMQK + c);
        *(f32x4*)(convp + (size_t)j * 4) = (f32x4){bf2f((unsigned)z & 0xffffu), bf2f(((unsigned)z) >> 16), bf2f((unsigned)(z >> 32) & 0xffffu), bf2f((unsigned)(z >> 48))}; }
    for (int j = gt; j < NS * 3 * 1024; j += NGT) { const int b = j / (3 * 1024), q = (j >> 10) % 3, c = (j & 1023) * 4; f32x4 o;
        if (q < 2) o = *(const f32x4*)(sconv + ((size_t)b * 3 + q + 1) * 4096 + c);
        else { const unsigned long long z = *(const unsigned long long*)(Z + (size_t)(NP + b) * NZ + ZMQK + c); o = (f32x4){bf2f((unsigned)z & 0xffffu), bf2f(((unsigned)z) >> 16), bf2f((unsigned)(z >> 32) & 0xffffu), bf2f((unsigned)(z >> 48))}; }
        *(f32x4*)(convs + (size_t)j * 4) = o; }
}
__device__ __forceinline__ void phase_m1_sample(const Args& a, LAS unsigned char* lds) {
    if (FUSE_CONV) conv_state_outputs(a);
    const int nb = gridDim.x, bx = blockIdx.x;
    for (int pass = 0; pass < 2; ++pass) {
        const bool do_m1 = (pass == 0);
        if (do_m1) { for (int u = bx; u < 1024; u += nb) { const int kind = u >> 9, bh = (u >> 4) & 31, c = u & 15; m1_unit(a, lds, kind, bh, c); } }
        else { for (int u = bx; u < 1024; u += nb) { sample_unit(a, lds, 0, u); } }
        __syncthreads();
    }
}
__device__ __forceinline__ void phase_m3(const Args& a, LAS unsigned char* lds) {
    const int nb = gridDim.x, bx = blockIdx.x;
    for (int pass = 0; pass < 2; ++pass) {
        const bool do_m3 = (pass == 0);
        if (do_m3) { for (int u = bx; u < 1024; u += nb) { const int kind = u >> 9, bh = (u >> 4) & 31, c = u & 15; m3_unit(a, lds, kind, bh, c); } }
        else { for (int u = bx; u < 1024; u += nb) { sample_unit(a, lds, 1, u); } }
        __syncthreads();
    }
}

struct EpiY1 { float* Y1; const bf16* XN; __device__ __forceinline__ void operator()(int m, int n, float v) const { Y1[(size_t)m * D + n] = ALPHA * bf2f(XN[(size_t)m * D + n]) + v; } };
struct EpiF32 { float* C; int ldc; __device__ __forceinline__ void operator()(int m, int n, float v) const { C[(size_t)m * ldc + n] = v; } };
__device__ __forceinline__ void phase_gemm2(const Args& a, LAS unsigned char* lds) {
    unsigned char* ws = a.ws;
#if USE_MFMA
#if USE_MX
    { pg8::Gemm g{(const bf16*)(ws + WS_MIX), (const bf16*)(ws + WS_WOUT), MP, D, D / 2, WO8_E8M0}; pg8::TailOrder S; S.init(NP, D, (int)gridDim.x, (int)blockIdx.x);
      pg8::EpiY1m E{(bf16*)(ws + WS_Y1), (const bf16*)(ws + WS_XN)};
      pg8::gemm_phase<pg8::EpiY1m, pg8::TailOrder, true, true, true>(lds, g, S, E); }
#else
    { pg8::Gemm g{(const bf16*)(ws + WS_MIX), (const bf16*)(ws + WS_WOUT), MP, D, D}; pg8::TailOrder S; S.init(NP, D, (int)gridDim.x, (int)blockIdx.x);
      pg8::EpiY1m E{(bf16*)(ws + WS_Y1), (const bf16*)(ws + WS_XN)};
      pg8::gemm_phase<pg8::EpiY1m, pg8::TailOrder, true, true>(lds, g, S, E); }
#endif
    { int rank, cnt; idle_rank((MP / 256) * (D / 256), rank, cnt);
      if (rank >= 0) { bg_transposes(a, lds, BG_TS, BG_T2, rank * NWAVES + (int)(threadIdx.x >> 6), cnt * NWAVES); __syncthreads();
          pg8::Gemm g{(const bf16*)(ws + WS_P16), (const bf16*)(ws + WS_WP), MP, D, PLE_D}; pg8::StaticOrder S; S.init(MP, D, cnt, rank);
          pg8::EpiB16n E{(bf16*)(ws + WS_PLE), D};
          pg8::gemm_phase<pg8::EpiB16n, pg8::StaticOrder, true, true>(lds, g, S, E);
          if (!USE_MX) bg_tables(a, 0, NEXP / 2, rank * NWAVES + (int)(threadIdx.x >> 6), cnt * NWAVES); } }
#else
    EpiY1 e{(float*)(ws + WS_Y1), (const bf16*)(ws + WS_XN)};
    slow_gemm(lds, (const bf16*)(ws + WS_MIX), (const bf16*)(ws + WS_WOUT), MP, D, D, e);
    EpiF32 e2{(float*)(ws + WS_PLE), D};
    slow_gemm(lds, (const bf16*)(ws + WS_P16), (const bf16*)(ws + WS_WP), MP, D, PLE_D, e2);
#endif
}
__device__ __forceinline__ void phase_ln1(const Args& a) {
    unsigned char* ws = a.ws; const int lane = threadIdx.x & 63, wave = threadIdx.x >> 6, gw = blockIdx.x * NWAVES + wave, NGW = gridDim.x * NWAVES;
#if USE_MFMA
    for (int m = gw; m < MP; m += NGW) ln_row_bf16<true>((const bf16*)(ws + WS_Y1) + (size_t)m * D, a.in[I_LN1G], a.in[I_LN1B], (bf16*)(ws + WS_X1) + (size_t)m * D, lane, (bf16*)(ws + WS_X1S), m, USE_MX ? ws + WS_X18 + (size_t)m * D : nullptr);
#else
    for (int m = gw; m < MP; m += NGW) ln_row_bf16<false>((const float*)(ws + WS_Y1) + (size_t)m * D, a.in[I_LN1G], a.in[I_LN1B], (bf16*)(ws + WS_X1) + (size_t)m * D, lane, (bf16*)(ws + WS_X1S), m);
#endif
}
struct EpiGate { float* PLE; __device__ __forceinline__ void operator()(int m, int n, float v) const { const size_t i = (size_t)m * D + n; PLE[i] = sigmoidf_(v) * PLE[i]; } };
__device__ __forceinline__ void phase_route_fast(const Args& a, int mode, int crank);
__device__ __forceinline__ void phase_gemm3(const Args& a, LAS unsigned char* lds) {
    unsigned char* ws = a.ws;
#if USE_MFMA
#if USE_MX
    { const int G = (int)gridDim.x, b = (int)blockIdx.x, nqt = NQ / 256, wv = (int)(threadIdx.x >> 6);
      int qs, qst, qn, gs, gst, gn, c_lo = 0, c_hi = 0, c_w = 0, c_nw = 1; bool conv_first = false;
      constexpr int R1 = 11264;
      if (G == 256) { const int x = b & 7, j = b >> 3;
          if (j < 4)       { qs = 0; qst = 1; qn = 0; gs = 0; gst = 1; gn = 0; c_lo = 0; c_hi = R1; c_w = (x * 4 + j) * NWAVES + wv; c_nw = 32 * NWAVES; conv_first = true; }
          else if (j < 8)  { qs = 8 * (j - 4) + x; qst = 32; qn = 2; gs = 8 * (j - 4) + x; gst = 96; gn = 1; }
          else if (j < 20) { qs = 8 * j + x; qst = 96; qn = 1; gs = 8 * (j - 4) + x; gst = 96; gn = 3; }
          else             { qs = 8 * j + x; qst = 80; qn = (j == 22) ? 2 : 1; gs = 8 * (20 + j) + x; gst = 96; gn = (j < 22) ? 3 : 2;
                             if (j >= 23) { c_lo = R1; c_hi = NEXP; c_w = (x * 9 + (j - 23)) * NWAVES + wv; c_nw = 72 * NWAVES; } } }
      else { const int cq = (b + nqt) % G, nqu = (NP / 256 + 1) * nqt, ngu = (NP / 256 + 1) * (D / 256);
          qs = cq; qst = G; qn = (cq < nqu) ? (nqu - cq + G - 1) / G : 0; gs = b; gst = G; gn = (b < ngu) ? (ngu - b + G - 1) / G : 0;
          c_lo = 0; c_hi = NEXP; c_w = b * NWAVES + wv; c_nw = G * NWAVES; }
      unsigned* qs_done = (unsigned*)(ws + WS_CTL) + CW_QS;
      if (conv_first) { bg_tables(a, c_lo, c_hi, c_w, c_nw);
#if USE_ROUTE_FAST
          if (wv == 0) { unsigned sp = 0; while (xb_ld(qs_done) < 8u) { __builtin_amdgcn_s_sleep(8); if (++sp > (1u << 22)) break; } __builtin_amdgcn_fence(__ATOMIC_ACQUIRE, "agent"); asm volatile("s_waitcnt vmcnt(0)" ::: "memory"); }
          phase_route_fast(a, 1, (b & 7) * 4 + (b >> 3));
#endif
      }
      { pg8::Gemm g{(const bf16*)(ws + WS_X1), (const bf16*)(ws + WS_W3), MP, NQ, D}; pg8::SpanOrder S; S.init(NP, NQ, qs, qst, qn);
        pg8::EpiQGate E{(float*)(ws + WS_QP), (float*)(ws + WS_PLE), (float*)(ws + WS_PLE2), nqt};
        pg8::gemm_phase<pg8::EpiQGate, pg8::SpanOrder, true, true>(lds, g, S, E); }
      if (G == 256 && (b >> 3) == 22) { asm volatile("s_waitcnt vmcnt(0)" ::: "memory"); __syncthreads();
          if (threadIdx.x == 0) { __builtin_amdgcn_fence(__ATOMIC_RELEASE, "agent"); asm volatile("s_waitcnt vmcnt(0)" ::: "memory"); (void)xb_add(qs_done, 1u); } }
      { pg8::Gemm g{(const bf16*)(ws + WS_X18), (const bf16*)(ws + WS_W3 + (size_t)NQ * D * 2), MP, D, D / 2, WG8_E8M0}; pg8::SpanOrder S; S.init(NP, D, gs, gst, gn);
        pg8::EpiQGate E{(float*)(ws + WS_QP), (float*)(ws + WS_PLE), (float*)(ws + WS_PLE2), 0};
        pg8::gemm_phase<pg8::EpiQGate, pg8::SpanOrder, true, true, true>(lds, g, S, E); }
      if (!conv_first && c_hi > c_lo) bg_tables(a, c_lo, c_hi, c_w, c_nw); }
    { int rank = -1, cnt = 1;
#else
    { pg8::Gemm g{(const bf16*)(ws + WS_X1), (const bf16*)(ws + WS_W3), MP, NQ + D, D}; pg8::TailOrder S; S.init(NP, NQ + D, (int)gridDim.x, (int)blockIdx.x);
      pg8::EpiQGate E{(float*)(ws + WS_QP), (float*)(ws + WS_PLE), (float*)(ws + WS_PLE2), NQ / 256};
      pg8::gemm_phase<pg8::EpiQGate, pg8::TailOrder, true, true>(lds, g, S, E); }
    { int rank, cnt; idle_rank((MP / 256) * ((NQ + D) / 256), rank, cnt);
#endif
      if (rank >= 0) bg_tables(a, NEXP / 2, NEXP, rank * NWAVES + (int)(threadIdx.x >> 6), cnt * NWAVES); }
#else
    EpiF32 e{(float*)(ws + WS_QP), NQ};
    slow_gemm(lds, (const bf16*)(ws + WS_X1), (const bf16*)(ws + WS_W3), MP, NQ, D, e);
    EpiGate e2{(float*)(ws + WS_PLE)};
    slow_gemm(lds, (const bf16*)(ws + WS_X1), (const bf16*)(ws + WS_W3) + (size_t)NQ * D, MP, D, D, e2);
#endif
}
__device__ __forceinline__ void wave_argmax(float& v, int& i) {
#pragma unroll
    for (int o = 1; o < 64; o <<= 1) { const float ov = __shfl_xor(v, o); const int oi = __shfl_xor(i, o); if (ov > v || (ov == v && oi < i)) { v = ov; i = oi; } }
}
__device__ __forceinline__ void phase_route(const Args& a) {
    unsigned char* ws = a.ws; const int lane = threadIdx.x & 63, wave = threadIdx.x >> 6, gw = blockIdx.x * NWAVES + wave, NGW = gridDim.x * NWAVES;
    const float* QP = (const float*)(ws + WS_QP); const float* SK = a.in[I_SUBK]; int* EIDX = (int*)(ws + WS_EIDX); float* GW = (float*)(ws + WS_GW);
    const float NEG = -3.0e38f;
    for (int u = gw; u < M * H; u += NGW) {
        const int t = u >> 3, h = u & 7;
        const float* q = QP + (size_t)t * NQ + h * 256;
        float svp[2]; int sip[2];
#pragma unroll
        for (int p = 0; p < 2; ++p) {
            const float* k0 = SK + ((size_t)(h * 2 + p) * 128 + lane) * 128; const float* k1 = k0 + 64 * 128; const float* qp = q + p * 128;
            float s0 = 0.f, s1 = 0.f;
            for (int d = 0; d < 128; d += 4) { const f32x4 qv = *(const f32x4*)(qp + d), a0 = *(const f32x4*)(k0 + d), a1 = *(const f32x4*)(k1 + d);
                s0 += qv.x * a0.x + qv.y * a0.y + qv.z * a0.z + qv.w * a0.w; s1 += qv.x * a1.x + qv.y * a1.y + qv.z * a1.z + qv.w * a1.w; }
            float myv = NEG; int myi = 0;
            for (int r = 0; r < TOPK; ++r) {
                float v = (s0 >= s1) ? s0 : s1; int i = (s0 >= s1) ? lane : lane + 64;
                wave_argmax(v, i);
                if (i == lane) s0 = NEG; if (i == lane + 64) s1 = NEG;
                if (lane == r) { myv = v; myi = i; }
            }
            svp[p] = myv; sip[p] = myi;
        }
        float cand[4];
#pragma unroll
        for (int c = 0; c < 4; ++c) { const int f = 4 * lane + c; cand[c] = __shfl(svp[0], f >> 4) + __shfl(svp[1], f & 15); }
        float tv = NEG; int tf = 0;
        for (int r = 0; r < TOPK; ++r) {
            float v = cand[0]; int i = 4 * lane;
#pragma unroll
            for (int c = 1; c < 4; ++c) if (cand[c] > v) { v = cand[c]; i = 4 * lane + c; }
            wave_argmax(v, i);
#pragma unroll
            for (int c = 0; c < 4; ++c) if (i == 4 * lane + c) cand[c] = NEG;
            if (lane == r) { tv = v; tf = i; }
        }
        const int e0 = __shfl(sip[0], tf >> 4), e1 = __shfl(sip[1], tf & 15);
        const float vmax = __shfl(tv, 0);
        float ex = (lane < TOPK) ? __expf(tv - vmax) : 0.f;
        const float den = wave_sum(ex);
        if (lane < TOPK) { EIDX[(size_t)t * NSLOT + h * TOPK + lane] = e0 * 128 + e1; GW[(size_t)t * NSLOT + h * TOPK + lane] = ex / den; }
    }
}
__device__ __forceinline__ int f2key(float x) { const int b = __float_as_int(x); return b ^ ((b >> 31) & 0x7fffffff); }
__device__ __forceinline__ float key2f(int k) { return __int_as_float(k ^ ((k >> 31) & 0x7fffffff)); }
constexpr int IMIN = -2147483647 - 1;

template <int N> __device__ __forceinline__ void bitonic_sort_desc(int* x) {
#pragma unroll
    for (int k = 2; k <= N; k <<= 1)
#pragma unroll
        for (int j = k >> 1; j > 0; j >>= 1)
#pragma unroll
            for (int i = 0; i < N; ++i) { const int l = i ^ j; if (l > i) { const bool desc = ((i & k) == 0); const int a = x[i], b = x[l]; const int hi = max(a, b), lo = min(a, b); x[i] = desc ? hi : lo; x[l] = desc ? lo : hi; } }
}
__device__ __forceinline__ void bitonic_clean_desc16(int* x) {
#pragma unroll
    for (int j = 8; j > 0; j >>= 1)
#pragma unroll
        for (int i = 0; i < 16; ++i) if ((i & j) == 0) { const int a = x[i], b = x[i + j]; x[i] = max(a, b); x[i + j] = min(a, b); }
}
__device__ __forceinline__ void merge_top16(int* a, const int* b) {
#pragma unroll
    for (int i = 0; i < 16; ++i) a[i] = max(a[i], b[15 - i]);
    bitonic_clean_desc16(a);
}
__device__ __forceinline__ void top16_of64(int* kk, int* out) {
    bitonic_sort_desc<16>(kk); bitonic_sort_desc<16>(kk + 16); bitonic_sort_desc<16>(kk + 32); bitonic_sort_desc<16>(kk + 48);
    merge_top16(kk, kk + 16); merge_top16(kk + 32, kk + 48); merge_top16(kk, kk + 32);
#pragma unroll
    for (int i = 0; i < 16; ++i) out[i] = kk[i];
}

template <int N> __device__ __forceinline__ int tree_max(const int (&v)[N]) {
    int t[N];
#pragma unroll
    for (int i = 0; i < N; ++i) t[i] = v[i];
    int n = N;
#pragma unroll
    for (int lvl = 0; lvl < 8; ++lvl) { if (n > 1) { int o = 0;
#pragma unroll
            for (int i = 0; i < N; i += 3) { if (i < n) { int m = t[i]; if (i + 1 < n) m = max(m, t[i + 1]); if (i + 2 < n) m = max(m, t[i + 2]); t[o] = m; ++o; } }
            n = o; } }
    return t[0];
}
__device__ __forceinline__ void phase_route_fast(const Args& a, int mode, int crank) {
    unsigned char* ws = a.ws; const int lane = threadIdx.x & 63, wave = threadIdx.x >> 6, gw = blockIdx.x * NWAVES + wave, NGW = gridDim.x * NWAVES, r = lane & 31, hh = lane >> 5;
    const bf16* QH = (const bf16*)(ws + WS_QP); const bf16* QL = QH + (size_t)MP * NQ; const bf16* KH = (const bf16*)(ws + WS_KH); const bf16* KL = KH + 16 * 128 * 128;
    int* EIDX = (int*)(ws + WS_EIDX); float* GW = (float*)(ws + WS_GW);
    const int nun = (M / 32) * H, nfull = (nun / NGW) * NGW, nrem = nun - nfull;
    const bool rem_elsewhere = ((int)gridDim.x == 256) && USE_MX;
    for (int k = 0; ; ++k) {
        int u;
        if (mode == 1) { if (k > 0 || wave != 0 || crank >= nrem) break; u = nfull + crank; }
        else if (k * NGW < nfull) u = k * NGW + gw;
        else { if (rem_elsewhere || k * NGW > nfull) break; if (nrem <= (int)gridDim.x) { if (wave != 0 || (int)blockIdx.x >= nrem) break; u = nfull + (int)blockIdx.x; } else { if (gw >= nrem) break; u = nfull + gw; } }
        const int tb = u >> 3, h = u & 7, t0 = tb * 32;
        int sk[2][16];
#pragma unroll
        for (int p = 0; p < 2; ++p) {
            f32x16 acc[4];
#pragma unroll
            for (int tl = 0; tl < 4; ++tl)
#pragma unroll
                for (int q = 0; q < 16; ++q) acc[tl][q] = 0.f;
            const bf16* qh = QH + (size_t)(t0 + r) * NQ + h * 256 + p * 128 + 8 * hh; const bf16* ql = QL + (size_t)(t0 + r) * NQ + h * 256 + p * 128 + 8 * hh;
            const bf16* kh = KH + ((size_t)(h * 2 + p) * 128 + r) * 128 + 8 * hh; const bf16* kl = KL + ((size_t)(h * 2 + p) * 128 + r) * 128 + 8 * hh;
#pragma unroll 2
            for (int ks = 0; ks < 8; ++ks) { const bf16x8 bh = *(const bf16x8*)(qh + ks * 16), bl = *(const bf16x8*)(ql + ks * 16);
#pragma unroll
                for (int tl = 0; tl < 4; ++tl) { const bf16x8 ah = *(const bf16x8*)(kh + (size_t)tl * 32 * 128 + ks * 16), al = *(const bf16x8*)(kl + (size_t)tl * 32 * 128 + ks * 16);
                    acc[tl] = MFMA32(ah, bh, acc[tl]); acc[tl] = MFMA32(ah, bl, acc[tl]); acc[tl] = MFMA32(al, bh, acc[tl]); } }
            int kk[64];
#pragma unroll
            for (int tl = 0; tl < 4; ++tl)
#pragma unroll
                for (int q = 0; q < 16; ++q) { const int kidx = 32 * tl + (q & 3) + 8 * (q >> 2) + 4 * hh; kk[tl * 16 + q] = (f2key(acc[tl][q]) & ~127) | (127 - kidx); }
            int x[16];
            top16_of64(kk, x);
            { int o[16];
#pragma unroll
              for (int i = 0; i < 16; ++i) o[i] = __shfl_xor(x[i], 32);
              merge_top16(x, o); }
#pragma unroll
            for (int i = 0; i < 16; ++i) sk[p][i] = x[i];
        }
        float v0[16], v1[16];
#pragma unroll
        for (int i = 0; i < 16; ++i) { v0[i] = key2f(sk[0][i]); v1[i] = key2f(sk[1][i]); }
        int ck[64]; int nc = 0;
#pragma unroll
        for (int i = 0; i < 16; ++i)
#pragma unroll
            for (int j = 0; j < 16; ++j) if ((i + 1) * (j + 1) <= 16) { ck[nc] = (f2key(v0[i] + v1[j]) & ~255) | (255 - (16 * i + j)); ++nc; }
#pragma unroll
        for (int i = 50; i < 64; ++i) ck[i] = IMIN;
        int win[16];
        top16_of64(ck, win);
        const float vmax = key2f(win[0]); float den = 0.f;
#pragma unroll
        for (int i = 0; i < 16; ++i) den += __expf(key2f(win[i]) - vmax);
        const float rden = 1.f / den;
        int eo[8]; float go[8];
#pragma unroll
        for (int k = 0; k < 8; ++k) { const int m = win[k] ^ ((win[k] ^ win[8 + k]) & (-hh)); const int f = 255 - (m & 255), ci = f >> 4, cj = f & 15; int e0 = 0, e1 = 0;
#pragma unroll
            for (int i = 0; i < 16; ++i) { e0 = (ci == i) ? (127 - (sk[0][i] & 127)) : e0; e1 = (cj == i) ? (127 - (sk[1][i] & 127)) : e1; }
            eo[k] = e0 * 128 + e1; go[k] = __expf(key2f(m) - vmax) * rden; }
        const size_t ob = (size_t)(t0 + r) * NSLOT + h * TOPK + 8 * hh;
        { v4u pe; pe.x = (unsigned)eo[0] | ((unsigned)eo[1] << 16); pe.y = (unsigned)eo[2] | ((unsigned)eo[3] << 16); pe.z = (unsigned)eo[4] | ((unsigned)eo[5] << 16); pe.w = (unsigned)eo[6] | ((unsigned)eo[7] << 16);
          *(v4u*)((unsigned short*)EIDX + ob) = pe; }
        *(f32x4*)(GW + ob) = (f32x4){go[0], go[1], go[2], go[3]}; *(f32x4*)(GW + ob + 4) = (f32x4){go[4], go[5], go[6], go[7]};
    }
}
__device__ __forceinline__ void phase_peer_slow(const Args& a, LAS unsigned char* ldsb) {
    unsigned char* ws = a.ws; const int tid = threadIdx.x, lane = tid & 63, wave = tid >> 6;
    LAS float* xs = (LAS float*)ldsb; LAS float* gk = xs + D; LAS int* ek = (LAS int*)(gk + NSLOT);
    const bf16* X1 = (const bf16*)(ws + WS_X1); const int* EIDX = (const int*)(ws + WS_EIDX); const float* GW = (const float*)(ws + WS_GW);
    const float* U = a.in[I_PU]; const float* V = a.in[I_PV]; float* CH = (float*)(ws + WS_CH);
    for (int t = blockIdx.x; t < M; t += gridDim.x) {
        __syncthreads();
        for (int j = tid; j < D; j += NTHR) xs[j] = bf2f(X1[(size_t)t * D + j]);
        if (tid < NSLOT) ek[tid] = EIDX[(size_t)t * NSLOT + tid];
        __syncthreads();
        for (int kk = 0; kk < 16; ++kk) { const int k = wave * 16 + kk; const float* ur = U + (size_t)ek[k] * D; float s = 0.f;
#pragma unroll 4
            for (int c = 0; c < 16; ++c) { const int idx = c * 256 + lane * 4; const f32x4 uv = *(const f32x4*)(ur + idx); const f32x4 xv = *(const LAS f32x4*)(xs + idx);
                s += uv.x * xv.x + uv.y * xv.y + uv.z * xv.z + uv.w * xv.w; }
            s = wave_sum(s);
            if (lane == 0) gk[k] = gelu_tanh(s) * GW[(size_t)t * NSLOT + k]; }
        __syncthreads();
        f32x4 acc0 = {0.f, 0.f, 0.f, 0.f}, acc1 = {0.f, 0.f, 0.f, 0.f};
        for (int k = 0; k < NSLOT; ++k) { const float g = gk[k]; const float* vr = V + (size_t)ek[k] * D + tid * 8; acc0 += g * *(const f32x4*)vr; acc1 += g * *(const f32x4*)(vr + 4); }
        *(f32x4*)(CH + (size_t)t * D + tid * 8) = acc0; *(f32x4*)(CH + (size_t)t * D + tid * 8 + 4) = acc1;
    }
}
typedef __bf16 bf2_t __attribute__((ext_vector_type(2)));
__device__ __forceinline__ float dot2bf(unsigned x, unsigned y, float c) { return __builtin_amdgcn_fdot2_f32_bf16(__builtin_bit_cast(bf2_t, x), __builtin_bit_cast(bf2_t, y), c, false); }
constexpr int PEER_TL = 260;
__device__ __forceinline__ void phase_peer_u(const Args& a, LAS unsigned char* ldsb) {
    unsigned char* ws = a.ws; const int tid = threadIdx.x, lane = tid & 63, wave = tid >> 6, g = lane >> 3, l8 = lane & 7;
    const int ngrp = (gridDim.x % 8 == 0) ? 8 : 1, xg = blockIdx.x % ngrp, r = blockIdx.x / ngrp, nr = gridDim.x / ngrp;
    LAS float* part = (LAS float*)ldsb;
    const unsigned char* Ub = ws + WS_UB; const bf16* X1s = (const bf16*)(ws + WS_X1S); const int* EIDX = (const int*)(ws + WS_EIDX); float* PA = (float*)(ws + WS_PA);
    const int ntl = (M - r + nr - 1) / nr;
    typedef float f32x2 __attribute__((ext_vector_type(2)));
    for (int n0 = 0; n0 < ntl; n0 += PEER_TL) {
        const int nn = (ntl - n0 < PEER_TL) ? (ntl - n0) : PEER_TL;
        __syncthreads();
        for (int i = tid; i < nn * NSLOT; i += NTHR) part[i] = 0.f;
        __syncthreads();
        for (int s = xg; s < 32; s += ngrp) {
            const int sp = (s - xg) / ngrp, npb = (ngrp == 8) ? 4 : 8, per = (NEXP + npb - 1) / npb; const bool cv = (n0 == 0) && (sp < npb);
            const int cv_lo = NEXP + sp * per, cv_hi = (NEXP + (sp + 1) * per < 2 * NEXP) ? NEXP + (sp + 1) * per : 2 * NEXP;
            const int iters = (nn > wave) ? (nn - wave + NWAVES - 1) / NWAVES : 0, n_cv = wave + NWAVES * ((4 * wave < iters) ? 4 * wave : 0);
            if (cv && iters == 0) bg_tables(a, cv_lo, cv_hi, (int)blockIdx.x * NWAVES + wave, (int)gridDim.x * NWAVES);
            const unsigned char* Us = Ub + (size_t)s * NEXP * 128 + l8 * 16; const bf16* Xs = X1s + (size_t)s * MP * 128 + l8 * 16;
            for (int n = wave; n < nn; n += NWAVES) { const int t = r + nr * (n0 + n);
                if (cv && n == n_cv) bg_tables(a, cv_lo, cv_hi, (int)blockIdx.x * NWAVES + wave, (int)gridDim.x * NWAVES);
                const v4u* ip = (const v4u*)((const unsigned short*)EIDX + (size_t)t * NSLOT + g * 16);
                const v4u ia = ip[0], ib = ip[1];
                const int ej[16] = {(int)(ia.x & 0xffffu), (int)(ia.x >> 16), (int)(ia.y & 0xffffu), (int)(ia.y >> 16), (int)(ia.z & 0xffffu), (int)(ia.z >> 16), (int)(ia.w & 0xffffu), (int)(ia.w >> 16),
                                    (int)(ib.x & 0xffffu), (int)(ib.x >> 16), (int)(ib.y & 0xffffu), (int)(ib.y >> 16), (int)(ib.z & 0xffffu), (int)(ib.z >> 16), (int)(ib.w & 0xffffu), (int)(ib.w >> 16)};
                const v4u xa = *(const v4u*)(Xs + (size_t)t * 128), xb = *(const v4u*)(Xs + (size_t)t * 128 + 8);
                v4u ug[16];
#pragma unroll
                for (int j = 0; j < 16; ++j) ug[j] = *(const v4u*)(Us + (size_t)ej[j] * 128);
                f32x2 x2[8];
#pragma unroll
                for (int i = 0; i < 4; ++i) { x2[i] = (f32x2){__uint_as_float(xa[i] << 16), __uint_as_float(xa[i] & 0xffff0000u)}; x2[4 + i] = (f32x2){__uint_as_float(xb[i] << 16), __uint_as_float(xb[i] & 0xffff0000u)}; }
                float acc[16];
#pragma unroll
                for (int j = 0; j < 16; ++j) { const v4u uv = ug[j]; f32x2 s2 = {0.f, 0.f};
#pragma unroll
                    for (int i = 0; i < 4; ++i) { const f32x2 lo = __builtin_amdgcn_cvt_pk_f32_fp8((int)uv[i], false), hi = __builtin_amdgcn_cvt_pk_f32_fp8((int)uv[i], true);
                        s2 = __builtin_elementwise_fma(lo, x2[2 * i], s2); s2 = __builtin_elementwise_fma(hi, x2[2 * i + 1], s2); }
                    acc[j] = s2.x + s2.y; }
                float b8[8], c4[4], d2[2];
#pragma unroll
                for (int i = 0; i < 8; ++i) { const float snd = (l8 & 4) ? acc[i] : acc[i + 8], kp = (l8 & 4) ? acc[i + 8] : acc[i]; b8[i] = kp + __shfl_xor(snd, 4); }
#pragma unroll
                for (int i = 0; i < 4; ++i) { const float snd = (l8 & 2) ? b8[i] : b8[i + 4], kp = (l8 & 2) ? b8[i + 4] : b8[i]; c4[i] = kp + __shfl_xor(snd, 2); }
#pragma unroll
                for (int i = 0; i < 2; ++i) { const float snd = (l8 & 1) ? c4[i] : c4[i + 2], kp = (l8 & 1) ? c4[i + 2] : c4[i]; d2[i] = kp + __shfl_xor(snd, 1); }
                LAS float* pp = part + n * NSLOT + 2 * lane;
                pp[0] += d2[0]; pp[1] += d2[1];
            }
        }
        __syncthreads();
        for (int i = tid; i < nn * NSLOT; i += NTHR) { const int n = i >> 7, q = i & 127; PA[((size_t)xg * M + (r + nr * (n0 + n))) * NSLOT + q] = part[i] * (1.f / U8_SCALE); }
    }
    if (ngrp == 1) {
        for (size_t i = (size_t)blockIdx.x * NTHR + tid; i < (size_t)7 * M * NSLOT; i += (size_t)gridDim.x * NTHR) PA[(size_t)M * NSLOT + i] = 0.f; }
}
__device__ __forceinline__ void phase_peer_v(const Args& a, LAS unsigned char* ldsb) {
    unsigned char* ws = a.ws; const int tid = threadIdx.x, lane = tid & 63, wave = tid >> 6, g = lane >> 3, l8 = lane & 7;
    const int ngrp = (gridDim.x % 8 == 0) ? 8 : 1, xg = blockIdx.x % ngrp, r = blockIdx.x / ngrp, nr = gridDim.x / ngrp;
    LAS float* gk = (LAS float*)ldsb;
    const unsigned char* Vb = ws + WS_VB; const int* EIDX = (const int*)(ws + WS_EIDX); const float* PA = (const float*)(ws + WS_PA); const float* GW = (const float*)(ws + WS_GW);
    bf16* CH = (bf16*)(ws + WS_CH);
    const int ntl = (M - r + nr - 1) / nr;
    for (int n0 = 0; n0 < ntl; n0 += PEER_TL) {
        const int nn = (ntl - n0 < PEER_TL) ? (ntl - n0) : PEER_TL;
        __syncthreads();
        { const int nit = nn * NSLOT;
          for (int i0 = tid; i0 < nit; i0 += NTHR * 8) {
              float pa[8][8], gw[8];
#pragma unroll
              for (int bb = 0; bb < 8; ++bb) { const int i = i0 + bb * NTHR, ii = (i < nit) ? i : 0; const int n = ii >> 7, q = ii & 127; const size_t t = (size_t)(r + nr * (n0 + n));
#pragma unroll
                  for (int x = 0; x < 8; ++x) pa[bb][x] = PA[((size_t)x * M + t) * NSLOT + q];
                  gw[bb] = GW[t * NSLOT + q]; }
#pragma unroll
              for (int bb = 0; bb < 8; ++bb) { const int i = i0 + bb * NTHR; float sm = 0.f;
#pragma unroll
                  for (int x = 0; x < 8; ++x) sm += pa[bb][x];
                  const float u2 = 1.5957691216057308f * (sm + 0.044715f * sm * sm * sm);
                  if (i < nit) gk[i] = sm * __builtin_amdgcn_rcpf(1.f + __expf(-u2)) * gw[bb] * (1.f / V8_SCALE); } } }
        __syncthreads();
        for (int s = xg; s < 32; s += ngrp) {
            const unsigned char* Vs = Vb + (size_t)s * NEXP * 128 + l8 * 16;
            for (int n = wave; n < nn; n += NWAVES) { const int t = r + nr * (n0 + n);
                const v4u* ip = (const v4u*)((const unsigned short*)EIDX + (size_t)t * NSLOT + g * 16);
                const v4u ia = ip[0], ib = ip[1];
                const int ej[16] = {(int)(ia.x & 0xffffu), (int)(ia.x >> 16), (int)(ia.y & 0xffffu), (int)(ia.y >> 16), (int)(ia.z & 0xffffu), (int)(ia.z >> 16), (int)(ia.w & 0xffffu), (int)(ia.w >> 16),
                                    (int)(ib.x & 0xffffu), (int)(ib.x >> 16), (int)(ib.y & 0xffffu), (int)(ib.y >> 16), (int)(ib.z & 0xffffu), (int)(ib.z >> 16), (int)(ib.w & 0xffffu), (int)(ib.w >> 16)};
                v4u vg[16];
#pragma unroll
                for (int j = 0; j < 16; ++j) vg[j] = *(const v4u*)(Vs + (size_t)ej[j] * 128);
                const LAS f32x4* gp = (const LAS f32x4*)(gk + n * NSLOT + g * 16);
                const f32x4 g0 = gp[0], g1 = gp[1], g2 = gp[2], g3 = gp[3];
                const float gj[16] = {g0.x, g0.y, g0.z, g0.w, g1.x, g1.y, g1.z, g1.w, g2.x, g2.y, g2.z, g2.w, g3.x, g3.y, g3.z, g3.w};
                typedef float f32x2 __attribute__((ext_vector_type(2)));
                f32x2 ac2[8];
#pragma unroll
                for (int i = 0; i < 8; ++i) ac2[i] = (f32x2){0.f, 0.f};
#pragma unroll
                for (int j = 0; j < 16; ++j) { const v4u vv = vg[j]; const f32x2 gg = {gj[j], gj[j]};
#pragma unroll
                    for (int i = 0; i < 4; ++i) { const f32x2 lo = __builtin_amdgcn_cvt_pk_f32_fp8((int)vv[i], false), hi = __builtin_amdgcn_cvt_pk_f32_fp8((int)vv[i], true);
                        ac2[2 * i] = __builtin_elementwise_fma(gg, lo, ac2[2 * i]); ac2[2 * i + 1] = __builtin_elementwise_fma(gg, hi, ac2[2 * i + 1]); } }
                float acc[16];
#pragma unroll
                for (int i = 0; i < 8; ++i) { acc[2 * i] = ac2[i].x; acc[2 * i + 1] = ac2[i].y; }
                float b8[8], c4[4], d2[2];
#pragma unroll
                for (int i = 0; i < 8; ++i) { const float snd = (g & 4) ? acc[i] : acc[i + 8], kp = (g & 4) ? acc[i + 8] : acc[i]; b8[i] = kp + __shfl_xor(snd, 32); }
#pragma unroll
                for (int i = 0; i < 4; ++i) { const float snd = (g & 2) ? b8[i] : b8[i + 4], kp = (g & 2) ? b8[i + 4] : b8[i]; c4[i] = kp + __shfl_xor(snd, 16); }
#pragma unroll
                for (int i = 0; i < 2; ++i) { const float snd = (g & 1) ? c4[i] : c4[i + 2], kp = (g & 1) ? c4[i + 2] : c4[i]; d2[i] = kp + __shfl_xor(snd, 8); }
                *(unsigned*)(CH + (size_t)t * D + s * 128 + l8 * 16 + 2 * g) = pk2(d2[0], d2[1]);
            }
        }
    }
}

__device__ __forceinline__ void phase_final(const Args& a) {
    unsigned char* ws = a.ws; const int lane = threadIdx.x & 63, wave = threadIdx.x >> 6, gw = blockIdx.x * NWAVES + wave, NGW = gridDim.x * NWAVES;
    const bf16* X1 = (const bf16*)(ws + WS_X1); const float* CH = (const float*)(ws + WS_CH); const float* PLE = (const float*)(ws + (USE_MFMA ? WS_PLE2 : WS_PLE));
    const float* g = a.in[I_LN2G]; const float* b = a.in[I_LN2B];
    for (int m = gw; m < M; m += NGW) {
        float* orow = (m < NP) ? a.out + O_YP + (size_t)m * D : a.out + O_YS + (size_t)(m - NP) * D;
        f32x4 v[16]; float s = 0.f;
#pragma unroll
        for (int j = 0; j < 16; ++j) { const int c = (lane + 64 * j) * 4; const unsigned long long xb = *(const unsigned long long*)(X1 + (size_t)m * D + c);
            const f32x4 x = {bf2f((unsigned)xb & 0xffffu), bf2f(((unsigned)xb) >> 16), bf2f((unsigned)(xb >> 32) & 0xffffu), bf2f((unsigned)(xb >> 48))};
            f32x4 pl;
            if (USE_MFMA) { const unsigned long long pb = *(const unsigned long long*)((const bf16*)PLE + (size_t)m * D + c); pl = (f32x4){bf2f((unsigned)pb & 0xffffu), bf2f(((unsigned)pb) >> 16), bf2f((unsigned)(pb >> 32) & 0xffffu), bf2f((unsigned)(pb >> 48))}; }
            else pl = *(const f32x4*)(PLE + (size_t)m * D + c);
            f32x4 chv;
            if (USE_PEER_FAST) { const unsigned long long cb = *(const unsigned long long*)((const bf16*)CH + (size_t)m * D + c); chv = (f32x4){bf2f((unsigned)cb & 0xffffu), bf2f(((unsigned)cb) >> 16), bf2f((unsigned)(cb >> 32) & 0xffffu), bf2f((unsigned)(cb >> 48))}; }
            else chv = *(const f32x4*)(CH + (size_t)m * D + c);
            v[j] = ALPHA * x + chv + pl; s += (v[j].x + v[j].y) + (v[j].z + v[j].w); }
        const float mean = wave_sum(s) * (1.f / D); float s2 = 0.f;
#pragma unroll
        for (int j = 0; j < 16; ++j) { v[j] = v[j] - mean; s2 += (v[j].x * v[j].x + v[j].y * v[j].y) + (v[j].z * v[j].z + v[j].w * v[j].w); }
        const float rstd = 1.f / sqrtf(wave_sum(s2) * (1.f / D) + LN_EPS);
#pragma unroll
        for (int j = 0; j < 16; ++j) { const int c = (lane + 64 * j) * 4; *(f32x4*)(orow + c) = v[j] * rstd * *(const f32x4*)(g + c) + *(const f32x4*)(b + c); }
    }
}

constexpr int N_PHASES = 8 - (FUSE_CONV ? 1 : 0) + (USE_MIX_FAST ? 3 : 1) + (USE_PEER_FAST ? 2 : 1);
__global__ void __launch_bounds__(NTHR, 2) fwd(Args args) {
    extern __shared__ __attribute__((aligned(16))) unsigned char lds_raw[];
    LAS unsigned char* lds = (LAS unsigned char*)lds_raw;
    volatile LAS unsigned* MISC = (volatile LAS unsigned*)(lds + MISC_OFF);
    for (int u = threadIdx.x; u < (LDS_BYTES - LDSCTL_OFF) / 4; u += NTHR) ((LAS unsigned*)(lds + LDSCTL_OFF))[u] = 0u;
    __syncthreads();
    const int lo = args.ph_lo, hi = args.ph_hi;
    XcdBarrier bar; bar.bar = (unsigned*)(args.ws + WS_CTL) + CW_BAR; bar.x = 0; bar.st = nullptr;
    if (hi - lo > 1) bar = xcd_barrier_post((unsigned*)(args.ws + WS_CTL) + CW_BAR, MISC + 8);
    int pk = 0;
#define PHASE(body) do { if (lo <= pk && pk < hi) { body; if (pk + 1 < hi) xcd_barrier(bar); } ++pk; } while (0)
    PHASE(phase_prologue(args, lds));
    PHASE(phase_gemm1(args, lds));
#if !FUSE_CONV
    PHASE(phase_rope_conv(args));
#endif
#if USE_MIX_FAST
    PHASE(phase_m1_sample(args, lds));
    PHASE(phase_scan(args, lds));
    PHASE(phase_m3(args, lds));
#else
    PHASE(phase_seq_mixers(args, lds));
#endif
    PHASE(phase_gemm2(args, lds));
    PHASE(phase_ln1(args));
    PHASE(phase_gemm3(args, lds));
#if USE_ROUTE_FAST
    PHASE(phase_route_fast(args, 0, 0));
#else
    PHASE(phase_route(args));
#endif
#if USE_PEER_FAST
    PHASE(phase_peer_u(args, lds));
    PHASE(phase_peer_v(args, lds));
#else
    PHASE(phase_peer_slow(args, lds));
#endif
    PHASE(phase_final(args));
#undef PHASE
}

extern "C" void kernel_launch(void* const* d_in, const int* in_sizes, int n_in, void* d_out, int out_size, void* d_ws, size_t ws_size, hipStream_t stream) {
    static int grid = 0;
    if (grid == 0) {
        if (n_in != 28 || (size_t)out_size != O_END || ws_size < WS_END) { fprintf(stderr, "kernel_launch: unexpected shapes: n_in %d out %d ws %zu\n", n_in, out_size, ws_size); grid = -1; return; }
        int dev = 0, cus = 0, per_cu = 0;
        if (hipGetDevice(&dev) != hipSuccess || hipDeviceGetAttribute(&cus, hipDeviceAttributeMultiprocessorCount, dev) != hipSuccess) { grid = -1; return; }
        if (hipFuncSetAttribute((const void*)fwd, hipFuncAttributeMaxDynamicSharedMemorySize, LDS_BYTES) != hipSuccess) { fprintf(stderr, "kernel_launch: hipFuncSetAttribute failed\n"); grid = -1; return; }
        if (hipOccupancyMaxActiveBlocksPerMultiprocessor(&per_cu, (const void*)fwd, NTHR, LDS_BYTES) != hipSuccess || per_cu < 1) { fprintf(stderr, "kernel_launch: occupancy query says %d\n", per_cu); }
        (void)hipGetLastError();
        grid = cus;
    }
    if (grid < 0) return;
    (void)hipMemsetAsync((char*)d_ws + WS_CTL, 0, CTL_ZERO_BYTES, stream);
    Args a; memset(&a, 0, sizeof(a));
    for (int i = 0; i < 28; ++i) a.in[i] = (const float*)d_in[i];
    a.out = (float*)d_out; a.ws = (unsigned char*)d_ws;
    for (int i = 0; i < 128; ++i) a.inv[i] = std::pow(10000.0, -(double)i / 128.0);
#if MK_PER_PHASE
    for (int p = 0; p < N_PHASES; ++p) { a.ph_lo = p; a.ph_hi = p + 1; hipLaunchKernelGGL(fwd, dim3(grid), dim3(NTHR), LDS_BYTES, stream, a); }
#else
    a.ph_lo = 0; a.ph_hi = N_PHASES; hipLaunchKernelGGL(fwd, dim3(grid), dim3(NTHR), LDS_BYTES, stream, a);
#endif
}
```

```cpp
#include <hip/hip_runtime.h>
#include <cstdio>
#include <cstdint>
#include <cmath>
#include <cstring>

#ifndef USE_MFMA
#define USE_MFMA 1
#endif
#ifndef USE_PEER_FAST
#define USE_PEER_FAST 1
#endif
#ifndef USE_MIX_FAST
#define USE_MIX_FAST 1
#endif
#ifndef USE_ROUTE_FAST
#define USE_ROUTE_FAST 1
#endif
#ifndef FUSE_CONV
#define FUSE_CONV 1
#endif
static_assert(FUSE_CONV == 0 || (USE_MFMA != 0 && USE_MIX_FAST != 0), "FUSE_CONV needs the MFMA GEMM (fused rope) and the fast mixers");
constexpr bool kFuseConv = FUSE_CONV != 0;
static_assert((USE_ROUTE_FAST != 0) == (USE_PEER_FAST != 0), "the fast routing writes u16 expert ids that only the fast expert phases read");
#ifndef USE_MX
#define USE_MX 1
#endif
#ifndef MK_PER_PHASE
#define MK_PER_PHASE 0
#endif

#define GAS __attribute__((address_space(1)))
#define LAS __attribute__((address_space(3)))
typedef unsigned short bf16;
typedef unsigned v4u __attribute__((ext_vector_type(4)));
typedef float f32x4 __attribute__((ext_vector_type(4)));
typedef GAS unsigned gu32;
typedef short bf16x8 __attribute__((ext_vector_type(8)));
typedef float f32x16 __attribute__((ext_vector_type(16)));
#define MFMA32(a, b, c) __builtin_amdgcn_mfma_f32_32x32x16_bf16((a), (b), (c), 0, 0, 0)

constexpr int D = 4096, SEQ = 2048, NPB = 4, NP = NPB * SEQ  , NS = 128, M = NP + NS  , MP = 8448  ;
constexpr int H = 8, HD = 256, RW = 2048, INC = 16400, NZ = 16384;
constexpr int ZQ = 0, ZK = 2048, ZV = 4096, ZG = 6144, ZMQK = 8192, ZMV = 12288, ZMO = 14336;
constexpr int PLE_D = 256, NQ = 2048, NEXP = 16384, TOPK = 16, NSLOT = 128;
constexpr float LN_EPS = 1e-5f;
constexpr float ALPHA = 1.189207115002721f;
constexpr int PAST_LEN = 16384;
constexpr size_t O_YP = 0, O_YS = O_YP + (size_t)NP * D, O_RETP = O_YS + (size_t)NS * D, O_CONVP = O_RETP + (size_t)NPB * H * HD * HD,
                 O_CP = O_CONVP + (size_t)NPB * 3 * 4096, O_NP = O_CP + (size_t)NPB * H * HD * HD, O_MP = O_NP + (size_t)NPB * H * HD,
                 O_RETS = O_MP + (size_t)NPB * H, O_CONVS = O_RETS + (size_t)NS * H * HD * HD, O_CS = O_CONVS + (size_t)NS * 3 * 4096,
                 O_NS = O_CS + (size_t)NS * H * HD * HD, O_MS = O_NS + (size_t)NS * H * HD, O_END = O_MS + (size_t)NS * H;
static_assert(O_END == 174384160, "output size");

constexpr size_t MiB = 1u << 20;
constexpr size_t WS_CTL = 0, CTL_ZERO_BYTES = 32768;
constexpr size_t WS_ROPE = 1 * MiB;
constexpr size_t WS_G = 764 * MiB;
constexpr size_t WS_WG = 4 * MiB + 614400;
constexpr size_t WS_EIDX = 5 * MiB;
constexpr size_t WS_GW = 10 * MiB;
constexpr size_t WS_KH = 15 * MiB;
constexpr size_t WS_WOUT = 16 * MiB;
constexpr size_t WS_W3 = 48 * MiB;
constexpr size_t WS_WP = 96 * MiB;
constexpr size_t WS_P16 = 98 * MiB;
constexpr size_t WS_XN = 104 * MiB;
constexpr size_t WS_MIX = 170 * MiB;
constexpr size_t WS_X1 = 236 * MiB;
constexpr size_t WS_WIN = 302 * MiB;
constexpr size_t WS_Z = 430 * MiB;
constexpr size_t WS_MQK = 694 * MiB;
constexpr size_t WS_X18 = 694 * MiB;
constexpr size_t WS_Y1 = 302 * MiB;
constexpr size_t WS_PLE = 434 * MiB;
constexpr size_t WS_QP = 566 * MiB;
constexpr size_t WS_CH = 632 * MiB;
constexpr size_t WS_X1S = 170 * MiB;
constexpr size_t WS_PA = 764 * MiB;
constexpr size_t WS_UB = 800 * MiB;
constexpr size_t WS_VB = 928 * MiB;
constexpr size_t WS_ST = 302 * MiB;
constexpr size_t WS_NLOC = 760 * MiB;
constexpr size_t WS_NST = 761 * MiB;
constexpr size_t WS_SCAL = 762 * MiB;
constexpr size_t WS_UT = 1056 * MiB;
constexpr size_t WS_PLE2 = 1184 * MiB;
constexpr size_t WS_END = 1316 * MiB;
constexpr int CW_BAR = 4096;
constexpr int CW_QS = 7936;

constexpr int NWAVES = 8, NTHR = 512;
constexpr int LDS_BYTES = 163840, LDSCTL_OFF = 162816, MISC_OFF = LDSCTL_OFF + 320;

#define LDS_WAIT() asm volatile("s_waitcnt lgkmcnt(0)" ::: "memory")
#define VM_WAIT() asm volatile("s_waitcnt vmcnt(0)" ::: "memory")
__device__ __forceinline__ float bf2f(unsigned v) { return __uint_as_float(v << 16); }
__device__ __forceinline__ unsigned f2bf(float f) { unsigned u = __float_as_uint(f); return (u + 0x7fffu + ((u >> 16) & 1u)) >> 16; }
__device__ __forceinline__ unsigned pk2(float lo, float hi) { return f2bf(lo) | (f2bf(hi) << 16); }
__device__ __forceinline__ float wave_sum(float v) {
#pragma unroll
    for (int o = 1; o < 64; o <<= 1) v += __shfl_xor(v, o);
    return v;
}
__device__ __forceinline__ float sigmoidf_(float x) { return __builtin_amdgcn_rcpf(1.f + __expf(-x)); }
__device__ __forceinline__ float siluf_(float x) { return x * sigmoidf_(x); }
__device__ __forceinline__ float log_sigmoidf_(float x) { return fminf(x, 0.f) - log1pf(__expf(-fabsf(x))); }
__device__ __forceinline__ float gate_ld(const float* G, int row, int col) { const size_t o = (size_t)row * 16 + col; return (G[o] + G[o + (size_t)MP * 16]) + (G[o + (size_t)2 * MP * 16] + G[o + (size_t)3 * MP * 16]); }
__device__ __forceinline__ float gelu_tanh(float x) { const float u = 0.7978845608028654f * (x + 0.044715f * x * x * x); return 0.5f * x * (1.f + tanhf(u)); }

#define XB_TMO      128
#define XB_XCNT(j)  (256  + 64 * (j))
#define XB_XSUB(j)  (1280 + 64 * (j))
#define XB_XGEN(j)  (2304 + 64 * (j))
#define XB_TOP      3328
#define XB_TOPGEN   3392
#define XCD_BAR_WORDS 3456
#define XB_SPIN_CAP (1u << 23)
__device__ __forceinline__ unsigned xb_ld(unsigned* p)              { return __hip_atomic_load(p, __ATOMIC_RELAXED, __HIP_MEMORY_SCOPE_AGENT); }
__device__ __forceinline__ unsigned xb_add(unsigned* p, unsigned v) { return __hip_atomic_fetch_add(p, v, __ATOMIC_RELAXED, __HIP_MEMORY_SCOPE_AGENT); }
__device__ __forceinline__ unsigned xb_xcc_id() { return (unsigned)__builtin_amdgcn_s_getreg((3 << 11) | 20) & 0xFu; }
#define XB_SPIN(cond, bar) do { unsigned _sp = 0; while (cond) { __builtin_amdgcn_s_sleep(1); \
    if ((++_sp & 255u) == 0u) { if (xb_ld(&(bar)[XB_TMO])) break; if (_sp > XB_SPIN_CAP) { atomicAdd(&(bar)[XB_TMO], 1u); break; } } } } while (0)
struct XcdBarrier { unsigned* bar; unsigned x; volatile LAS unsigned* st; };
__device__ __forceinline__ XcdBarrier xcd_barrier_post(unsigned* bar, volatile LAS unsigned* st) {
    XcdBarrier b; b.bar = bar; b.x = xb_xcc_id(); b.st = st;
    if (threadIdx.x == 0) (void)xb_add(&bar[XB_XCNT(b.x)], 1u);
    return b;
}
__device__ __forceinline__ void xcd_barrier_complete(unsigned* bar, unsigned x, unsigned& nloc, unsigned& nx) {
    const unsigned G = gridDim.x * gridDim.y * gridDim.z;
    unsigned sum, cnt, mine, sp = 0u;
    for (;;) {
        sum = 0u; cnt = 0u; mine = 0u;
#pragma unroll
        for (unsigned j = 0; j < 16; ++j) { const unsigned c = xb_ld(&bar[XB_XCNT(j)]); sum += c; cnt += (c > 0u) ? 1u : 0u; mine = (j == x) ? c : mine; }
        if (sum == G) break;
        __builtin_amdgcn_s_sleep(1);
        if ((++sp & 255u) == 0u) { if (xb_ld(&bar[XB_TMO])) break; if (sp > XB_SPIN_CAP) { atomicAdd(&bar[XB_TMO], 1u); break; } }
    }
    nloc = mine > 0u ? mine : 1u; nx = cnt > 0u ? cnt : 1u;
}
__device__ __forceinline__ void xcd_barrier(const XcdBarrier& b) {
    asm volatile("s_waitcnt vmcnt(0)" ::: "memory");
    __syncthreads();
    if (threadIdx.x == 0) {
        unsigned* bar = b.bar;
        __builtin_amdgcn_s_waitcnt(0);
        unsigned nloc = b.st[0], nx = b.st[1];
        if (nloc == 0u) { xcd_barrier_complete(bar, b.x, nloc, nx); b.st[0] = nloc; b.st[1] = nx; }
        const unsigned old = xb_add(&bar[XB_XSUB(b.x)], 1u);
        const unsigned gen = old / nloc;
        if (old + 1u == (gen + 1u) * nloc) {
            __builtin_amdgcn_fence(__ATOMIC_RELEASE, "agent");
            asm volatile("s_waitcnt vmcnt(0)" ::: "memory");
            const unsigned og = xb_add(&bar[XB_TOP], 1u);
            const unsigned tg = og / nx;
            if (og + 1u == (tg + 1u) * nx) xb_add(&bar[XB_TOPGEN], 1u);
            else XB_SPIN(xb_ld(&bar[XB_TOPGEN]) == tg, bar);
            __builtin_amdgcn_fence(__ATOMIC_ACQUIRE, "agent");
            xb_add(&bar[XB_XGEN(b.x)], 1u);
            asm volatile("s_waitcnt vmcnt(0)" ::: "memory");
        } else {
            XB_SPIN(xb_ld(&bar[XB_XGEN(b.x)]) == gen, bar);
            __builtin_amdgcn_fence(__ATOMIC_ACQUIRE, "agent");
            asm volatile("s_waitcnt vmcnt(0)" ::: "memory");
        }
    }
    __syncthreads();
}

namespace pg8 {
#define PG8_LAS __attribute__((address_space(3)))
typedef unsigned short bf16_t;
typedef short bf16x8 __attribute__((ext_vector_type(8)));
typedef float f32x4 __attribute__((ext_vector_type(4)));
typedef unsigned u32x4 __attribute__((ext_vector_type(4)));
constexpr int BM = 256, BK = 64, HALF = 128, HTB = HALF * BK * 2  , STAGE_BYTES = 8 * HTB, NXCD = 8, WGM = 8;

__host__ __device__ __forceinline__ int lds_byte(int r, int c) { const int st = (r >> 4) * 2 + (c >> 5), rr = r & 15, cc = c & 31, ob = rr * 64 + cc * 2; return st * 1024 + (ob ^ (((ob >> 9) & 1) << 5)); }
__host__ __device__ __forceinline__ void stage_rc(int b, int& R, int& C) { const int st = b / 1024, sb = b % 1024, swz = sb ^ (((sb >> 9) & 1) << 5); R = (st >> 1) * 16 + swz / 64; C = (st & 1) * 32 + (swz % 64) / 2; }
__host__ __device__ __forceinline__ int perm32(int rho) { const int n = rho >> 4, i = rho & 15; return 8 * (i >> 2) + 4 * n + (i & 3); }

struct Unit { int pm, pn; };
constexpr int M_VALID = 8320;
struct Gemm { const bf16_t* A; const bf16_t* Bt; int M, N, K; int wscale = 0x7f7f7f7f; };
typedef int v8i_t __attribute__((ext_vector_type(8)));
typedef int v4i_t __attribute__((ext_vector_type(4)));
__device__ __forceinline__ f32x4 mx_mma(bf16x8 b0, bf16x8 b1, bf16x8 a0, bf16x8 a1, f32x4 c, int wscale) {
    const v4i_t B0 = __builtin_bit_cast(v4i_t, b0), B1 = __builtin_bit_cast(v4i_t, b1), A0 = __builtin_bit_cast(v4i_t, a0), A1 = __builtin_bit_cast(v4i_t, a1);
    const v8i_t Bv = {B0.x, B0.y, B0.z, B0.w, B1.x, B1.y, B1.z, B1.w}, Av = {A0.x, A0.y, A0.z, A0.w, A1.x, A1.y, A1.z, A1.w};
    return __builtin_amdgcn_mfma_scale_f32_16x16x128_f8f6f4(Bv, Av, c, 0, 0, 0, wscale, 0, 0x7f7f7f7f);
}

struct StaticOrder {
    int nM, nN, nwg, G, c;
    __host__ __device__ void init(int M, int N, int G_, int c_) { nM = M / BM; nN = N / BM; nwg = nM * nN; G = G_; c = c_; }
    __host__ __device__ bool next(int i, Unit& u) const {
        const long L = (long)i * G + c; if (L >= nwg) return false;
        int wgid = (int)L; { const int q = nwg / NXCD, r = nwg % NXCD, xcd = wgid % NXCD, off = wgid / NXCD; wgid = (xcd < r ? xcd * (q + 1) : r * (q + 1) + (xcd - r) * q) + off; }
        const int nig = WGM * nN, gid = wgid / nig, fm = gid * WGM, gsz = (nM - fm) < WGM ? (nM - fm) : WGM;
        u.pm = fm + ((wgid % nig) % gsz); u.pn = (wgid % nig) / gsz; return true;
    }
    __device__ __forceinline__ void a_ready(const Unit&) const {}
    __device__ __forceinline__ void done(const Unit&) const {}
};
struct TailOrder {
    StaticOrder so; int nmain, nN, nMmain, G, c;
    __host__ __device__ void init(int Mmain, int N, int G_, int c_) { so.init(Mmain, N, G_, c_); nMmain = Mmain / BM; nN = N / BM; nmain = nMmain * nN; G = G_; c = c_; }
    __host__ __device__ bool next(int i, Unit& u) const { const long L = (long)i * G + c; if (L < nmain) return so.next(i, u); if (L >= nmain + nN) return false; u.pm = nMmain; u.pn = (int)(L - nmain); return true; }
    __device__ __forceinline__ void a_ready(const Unit&) const {}
    __device__ __forceinline__ void done(const Unit&) const {}
};
struct SpanOrder {
    TailOrder t; int start, stride, cnt;
    __host__ __device__ void init(int Mmain, int N, int s, int st, int n) { t.init(Mmain, N, 1, 0); start = s; stride = st; cnt = n; }
    __host__ __device__ bool next(int i, Unit& u) const { if (i >= cnt) return false; return t.next(start + i * stride, u); }
    __device__ __forceinline__ void a_ready(const Unit&) const {}
    __device__ __forceinline__ void done(const Unit&) const {}
};
__device__ __forceinline__ unsigned cvt_pk_bf16(float lo, float hi) { unsigned r; asm volatile("v_cvt_pk_bf16_f32 %0, %1, %2" : "=v"(r) : "v"(lo), "v"(hi)); return r; }
struct EpiZRope {
    static constexpr bool PERM = true, AFTER_DRAIN = false;
    bf16_t* Z; const float* cs; const float* sn;
    __device__ __forceinline__ void operator()(const f32x4 (&acc)[2][2][4][2], const Unit& u, int wr, int wc, int fr, int fq) const {
        const int row0 = u.pm * BM + wr * 64 + fr, col0 = u.pn * BM + wc * 32 + 8 * fq, i0 = wc * 32 + 8 * fq;
        const bool rope = u.pn < 16; const float sc = (u.pn >= 8 && u.pn < 16) ? 0.0625f : 1.f;
#pragma unroll
        for (int ai = 0; ai < 2; ++ai)
#pragma unroll
            for (int m = 0; m < 4; ++m) { if (ai == 1 && u.pm * BM + HALF >= M_VALID) continue; const int row = row0 + ai * HALF + m * 16; bf16_t* rowp = Z + (size_t)row * NZ + col0;
                f32x4 v00 = acc[ai][0][m][0], v01 = acc[ai][0][m][1], v10 = acc[ai][1][m][0], v11 = acc[ai][1][m][1];
                if (rope) { const int pi = row < NP ? (row & (SEQ - 1)) : 2048; const float* cp = cs + pi * 128 + i0; const float* sp = sn + pi * 128 + i0;
                    const f32x4 c0 = *(const f32x4*)cp, c1 = *(const f32x4*)(cp + 4), s0 = *(const f32x4*)sp, s1 = *(const f32x4*)(sp + 4);
                    const f32x4 a0 = (v00 * c0 - v10 * s0) * sc, b0 = (v00 * s0 + v10 * c0) * sc, a1 = (v01 * c1 - v11 * s1) * sc, b1 = (v01 * s1 + v11 * c1) * sc;
                    v00 = a0; v10 = b0; v01 = a1; v11 = b1; }
                u32x4 w; w.x = cvt_pk_bf16(v00[0], v00[1]); w.y = cvt_pk_bf16(v00[2], v00[3]); w.z = cvt_pk_bf16(v01[0], v01[1]); w.w = cvt_pk_bf16(v01[2], v01[3]);
                *(u32x4*)rowp = w;
                w.x = cvt_pk_bf16(v10[0], v10[1]); w.y = cvt_pk_bf16(v10[2], v10[3]); w.z = cvt_pk_bf16(v11[0], v11[1]); w.w = cvt_pk_bf16(v11[2], v11[3]);
                *(u32x4*)(rowp + HALF) = w; }
    }
};
struct EpiY1m {
    static constexpr bool PERM = true, AFTER_DRAIN = false;
    bf16_t* Y1; const bf16_t* XN;
    __device__ __forceinline__ void operator()(const f32x4 (&acc)[2][2][4][2], const Unit& u, int wr, int wc, int fr, int fq) const {
        const int row0 = u.pm * BM + wr * 64 + fr, col0 = u.pn * BM + wc * 32 + 8 * fq;
#pragma unroll
        for (int ai = 0; ai < 2; ++ai) { if (ai == 1 && u.pm * BM + HALF >= M_VALID) continue;
            u32x4 xr[4][2];
#pragma unroll
            for (int m = 0; m < 4; ++m)
#pragma unroll
                for (int bj = 0; bj < 2; ++bj) xr[m][bj] = *(const u32x4*)(XN + (size_t)(row0 + ai * HALF + m * 16) * D + col0 + bj * HALF);
#pragma unroll
            for (int m = 0; m < 4; ++m) { const size_t ro = (size_t)(row0 + ai * HALF + m * 16) * D + col0;
#pragma unroll
                for (int bj = 0; bj < 2; ++bj) { const size_t o = ro + bj * HALF; const u32x4 xb = xr[m][bj]; const f32x4 v0 = acc[ai][bj][m][0], v1 = acc[ai][bj][m][1];
                    u32x4 w;
                    w.x = cvt_pk_bf16(__uint_as_float(xb.x << 16) * ALPHA + v0[0], __uint_as_float(xb.x & 0xffff0000u) * ALPHA + v0[1]);
                    w.y = cvt_pk_bf16(__uint_as_float(xb.y << 16) * ALPHA + v0[2], __uint_as_float(xb.y & 0xffff0000u) * ALPHA + v0[3]);
                    w.z = cvt_pk_bf16(__uint_as_float(xb.z << 16) * ALPHA + v1[0], __uint_as_float(xb.z & 0xffff0000u) * ALPHA + v1[1]);
                    w.w = cvt_pk_bf16(__uint_as_float(xb.w << 16) * ALPHA + v1[2], __uint_as_float(xb.w & 0xffff0000u) * ALPHA + v1[3]);
                    *(u32x4*)(Y1 + o) = w; } } }
    }
};
struct EpiB16m {
    static constexpr bool PERM = true, AFTER_DRAIN = false;
    bf16_t* C; int ldc;
    __device__ __forceinline__ void operator()(const f32x4 (&acc)[2][2][4][2], const Unit& u, int wr, int wc, int fr, int fq) const {
        const int row0 = u.pm * BM + wr * 64 + fr, col0 = u.pn * BM + wc * 32 + 8 * fq;
#pragma unroll
        for (int ai = 0; ai < 2; ++ai)
#pragma unroll
            for (int m = 0; m < 4; ++m) { if (ai == 1 && u.pm * BM + HALF >= M_VALID) continue; bf16_t* rowp = C + (size_t)(row0 + ai * HALF + m * 16) * ldc + col0;
#pragma unroll
                for (int bj = 0; bj < 2; ++bj) { const f32x4 v0 = acc[ai][bj][m][0], v1 = acc[ai][bj][m][1]; u32x4 w;
                    w.x = cvt_pk_bf16(v0[0], v0[1]); w.y = cvt_pk_bf16(v0[2], v0[3]); w.z = cvt_pk_bf16(v1[0], v1[1]); w.w = cvt_pk_bf16(v1[2], v1[3]);
                    *(u32x4*)(rowp + bj * HALF) = w; } }
    }
};
struct EpiB16n {
    static constexpr bool PERM = false, AFTER_DRAIN = false;
    bf16_t* C; int ldc;
    __device__ __forceinline__ void operator()(const f32x4 (&acc)[2][2][4][2], const Unit& u, int wr, int wc, int fr, int fq) const {
        const int row0 = u.pm * BM + wr * 64 + fr, col0 = u.pn * BM + wc * 32 + 4 * fq;
#pragma unroll
        for (int ai = 0; ai < 2; ++ai)
#pragma unroll
            for (int m = 0; m < 4; ++m) { if (ai == 1 && u.pm * BM + HALF >= M_VALID) continue; bf16_t* rowp = C + (size_t)(row0 + ai * HALF + m * 16) * ldc + col0;
#pragma unroll
                for (int bj = 0; bj < 2; ++bj)
#pragma unroll
                    for (int n = 0; n < 2; ++n) { const f32x4 v = acc[ai][bj][m][n]; *(unsigned long long*)(rowp + bj * HALF + n * 16) = (unsigned long long)cvt_pk_bf16(v[0], v[1]) | ((unsigned long long)cvt_pk_bf16(v[2], v[3]) << 32); } }
    }
};
struct EpiF32m {
    static constexpr bool PERM = false, AFTER_DRAIN = false;
    float* C; int ldc;
    __device__ __forceinline__ void operator()(const f32x4 (&acc)[2][2][4][2], const Unit& u, int wr, int wc, int fr, int fq) const {
        const int row0 = u.pm * BM + wr * 64 + fr, col0 = u.pn * BM + wc * 32 + 4 * fq;
#pragma unroll
        for (int ai = 0; ai < 2; ++ai)
#pragma unroll
            for (int m = 0; m < 4; ++m) { if (ai == 1 && u.pm * BM + HALF >= M_VALID) continue; float* rowp = C + (size_t)(row0 + ai * HALF + m * 16) * ldc + col0;
#pragma unroll
                for (int bj = 0; bj < 2; ++bj)
#pragma unroll
                    for (int n = 0; n < 2; ++n) *(f32x4*)(rowp + bj * HALF + n * 16) = acc[ai][bj][m][n]; }
    }
};
struct EpiQGate {
    static constexpr bool PERM = false, AFTER_DRAIN = false;
    float* QP; float* PLE; float* PLEO; int nq;
    __device__ __forceinline__ void operator()(const f32x4 (&acc)[2][2][4][2], const Unit& u, int wr, int wc, int fr, int fq) const {
#if USE_ROUTE_FAST
        const int row0 = u.pm * BM + wr * 64 + fr; const bool isq = u.pn < nq; const int col0 = (isq ? u.pn : u.pn - nq) * BM + wc * 32 + 4 * fq; const bool half = (u.pm * BM + HALF >= M_VALID);
        if (isq) {
#pragma unroll
            for (int ai = 0; ai < 2; ++ai) { if (ai == 1 && half) continue;
#pragma unroll
                for (int m = 0; m < 4; ++m)
#pragma unroll
                    for (int bj = 0; bj < 2; ++bj)
#pragma unroll
                        for (int n = 0; n < 2; ++n) { const f32x4 v = acc[ai][bj][m][n];
                            bf16_t* qh = (bf16_t*)QP + (size_t)(row0 + ai * HALF + m * 16) * NQ + col0 + bj * HALF + n * 16; bf16_t* ql = qh + (size_t)MP * NQ;
                            const unsigned h0 = cvt_pk_bf16(v[0], v[1]), h1 = cvt_pk_bf16(v[2], v[3]);
                            const unsigned l0 = cvt_pk_bf16(v[0] - __uint_as_float(h0 << 16), v[1] - __uint_as_float(h0 & 0xffff0000u)), l1 = cvt_pk_bf16(v[2] - __uint_as_float(h1 << 16), v[3] - __uint_as_float(h1 & 0xffff0000u));
                            *(unsigned long long*)qh = (unsigned long long)h0 | ((unsigned long long)h1 << 32); *(unsigned long long*)ql = (unsigned long long)l0 | ((unsigned long long)l1 << 32); } }
        } else {
#pragma unroll
            for (int ai = 0; ai < 2; ++ai) { if (ai == 1 && half) continue;
                unsigned long long pr[4][2][2];
#pragma unroll
                for (int m = 0; m < 4; ++m)
#pragma unroll
                    for (int bj = 0; bj < 2; ++bj)
#pragma unroll
                        for (int n = 0; n < 2; ++n) pr[m][bj][n] = *(const unsigned long long*)((const bf16_t*)PLE + (size_t)(row0 + ai * HALF + m * 16) * D + col0 + bj * HALF + n * 16);
#pragma unroll
                for (int m = 0; m < 4; ++m)
#pragma unroll
                    for (int bj = 0; bj < 2; ++bj)
#pragma unroll
                        for (int n = 0; n < 2; ++n) { f32x4 v = acc[ai][bj][m][n]; const unsigned long long ppv = pr[m][bj][n]; const unsigned pl = (unsigned)ppv, ph = (unsigned)(ppv >> 32);
                            const float p0 = __uint_as_float(pl << 16), p1 = __uint_as_float(pl & 0xffff0000u), p2 = __uint_as_float(ph << 16), p3 = __uint_as_float(ph & 0xffff0000u);
                            v[0] = p0 * __builtin_amdgcn_rcpf(1.f + __expf(-v[0])); v[1] = p1 * __builtin_amdgcn_rcpf(1.f + __expf(-v[1])); v[2] = p2 * __builtin_amdgcn_rcpf(1.f + __expf(-v[2])); v[3] = p3 * __builtin_amdgcn_rcpf(1.f + __expf(-v[3]));
                            *(unsigned long long*)((bf16_t*)PLEO + (size_t)(row0 + ai * HALF + m * 16) * D + col0 + bj * HALF + n * 16) = (unsigned long long)cvt_pk_bf16(v[0], v[1]) | ((unsigned long long)cvt_pk_bf16(v[2], v[3]) << 32); } }
        }
#else
        const int row0 = u.pm * BM + wr * 64 + fr; const bool isq = u.pn < nq; const size_t odelta = PLEO - PLE; const int col0 = (isq ? u.pn : u.pn - nq) * BM + wc * 32 + 4 * fq; const int ldc = isq ? NQ : D; float* base = isq ? QP : PLE;
#pragma unroll
        for (int ai = 0; ai < 2; ++ai)
#pragma unroll
            for (int m = 0; m < 4; ++m) { if (ai == 1 && u.pm * BM + HALF >= M_VALID) continue; float* rowp = base + (size_t)(row0 + ai * HALF + m * 16) * ldc + col0;
#pragma unroll
                for (int bj = 0; bj < 2; ++bj)
#pragma unroll
                    for (int n = 0; n < 2; ++n) { f32x4 v = acc[ai][bj][m][n]; float* p = rowp + bj * HALF + n * 16;
#if USE_ROUTE_FAST
                        if (isq) { bf16_t* qh = (bf16_t*)QP + (size_t)(row0 + ai * HALF + m * 16) * NQ + col0 + bj * HALF + n * 16; bf16_t* ql = qh + (size_t)MP * NQ;
                            const unsigned h0 = cvt_pk_bf16(v[0], v[1]), h1 = cvt_pk_bf16(v[2], v[3]);
                            const unsigned l0 = cvt_pk_bf16(v[0] - __uint_as_float(h0 << 16), v[1] - __uint_as_float(h0 & 0xffff0000u)), l1 = cvt_pk_bf16(v[2] - __uint_as_float(h1 << 16), v[3] - __uint_as_float(h1 & 0xffff0000u));
                            *(unsigned long long*)qh = (unsigned long long)h0 | ((unsigned long long)h1 << 32); *(unsigned long long*)ql = (unsigned long long)l0 | ((unsigned long long)l1 << 32); continue; }
#endif
                        { const unsigned long long ppv = *(const unsigned long long*)((const bf16_t*)PLE + (size_t)(row0 + ai * HALF + m * 16) * D + col0 + bj * HALF + n * 16); const unsigned pl = (unsigned)ppv, ph = (unsigned)(ppv >> 32);
                          const float p0 = __uint_as_float(pl << 16), p1 = __uint_as_float(pl & 0xffff0000u), p2 = __uint_as_float(ph << 16), p3 = __uint_as_float(ph & 0xffff0000u);
                          v[0] = p0 * __builtin_amdgcn_rcpf(1.f + __expf(-v[0])); v[1] = p1 * __builtin_amdgcn_rcpf(1.f + __expf(-v[1])); v[2] = p2 * __builtin_amdgcn_rcpf(1.f + __expf(-v[2])); v[3] = p3 * __builtin_amdgcn_rcpf(1.f + __expf(-v[3]));
                          *(unsigned long long*)((bf16_t*)PLEO + (size_t)(row0 + ai * HALF + m * 16) * D + col0 + bj * HALF + n * 16) = (unsigned long long)cvt_pk_bf16(v[0], v[1]) | ((unsigned long long)cvt_pk_bf16(v[2], v[3]) << 32); } } }
#endif
    }
};
template <class Epi, class Sched, bool ALIGN_EPI = false, bool SP2 = false, bool MX = false>
__device__ __forceinline__ void gemm_phase(PG8_LAS unsigned char* lds, const Gemm g, const Sched& S, const Epi& E) {
    const int tid = threadIdx.x, wid = __builtin_amdgcn_readfirstlane(tid >> 6), lane = tid & 63, wr = wid >> 2, wc = wid & 3, fr = lane & 15, fq = lane >> 4;
    const int K = g.K, nt = K / BK;
    unsigned voffA[2], voffB[2];
#pragma unroll
    for (int i = 0; i < 2; ++i) { int R, C; stage_rc(tid * 16 + i * 8192, R, C); const int Rb = Epi::PERM ? ((R & ~31) + perm32(R & 31)) : R;
        voffA[i] = (unsigned)(R * K + C) * 2u; voffB[i] = (unsigned)(Rb * K + C) * 2u; }
    const size_t kstep = (size_t)(BK * 2);
    const size_t hstep = (size_t)HALF * K * 2;
    const size_t tstep = 2 * hstep;
    const unsigned ldsw = (unsigned)wid * 1024u;
    const int aoff = lds_byte(wr * 64 + fr, fq * 8), boff = lds_byte(wc * 32 + fr, fq * 8);
#define PG8_SA(b, h) (((b) * 2 + (h)) * HTB)
#define PG8_SB(b, h) ((4 + (b) * 2 + (h)) * HTB)
#define PG8_STAGE(bufoff, gbase, voff) do { _Pragma("unroll") for (int _i = 0; _i < 2; ++_i) \
        __builtin_amdgcn_global_load_lds((const unsigned*)((const char*)(gbase) + (voff)[_i]), (PG8_LAS unsigned*)(lds + (bufoff) + ldsw + _i * 8192), 16, 0, 0); } while (0)
#define PG8_LDA(dst, b, h) do { _Pragma("unroll") for (int m = 0; m < 4; ++m) { \
        if constexpr (MX) { const v4i_t _lo = *(const PG8_LAS v4i_t*)(lds + PG8_SA(b, h) + aoff + m * 2048), _hi = *(const PG8_LAS v4i_t*)(lds + PG8_SA(b, h) + aoff + m * 2048 + 1024); dst##8[m] = __builtin_shufflevector(_lo, _hi, 0, 1, 2, 3, 4, 5, 6, 7); } \
        else { _Pragma("unroll") for (int k = 0; k < 2; ++k) dst[m][k] = *(const PG8_LAS bf16x8*)(lds + PG8_SA(b, h) + aoff + m * 2048 + k * 1024); } } } while (0)
#define PG8_LDB(dst, b, h) do { _Pragma("unroll") for (int n = 0; n < 2; ++n) { \
        if constexpr (MX) { const v4i_t _lo = *(const PG8_LAS v4i_t*)(lds + PG8_SB(b, h) + boff + n * 2048), _hi = *(const PG8_LAS v4i_t*)(lds + PG8_SB(b, h) + boff + n * 2048 + 1024); dst##8[n] = __builtin_shufflevector(_lo, _hi, 0, 1, 2, 3, 4, 5, 6, 7); } \
        else { _Pragma("unroll") for (int k = 0; k < 2; ++k) dst[n][k] = *(const PG8_LAS bf16x8*)(lds + PG8_SB(b, h) + boff + n * 2048 + k * 1024); } } } while (0)
#define PG8_MMA(ai, bj, At, Bt) do { __builtin_amdgcn_s_setprio(1); _Pragma("unroll") for (int m = 0; m < 4; ++m) _Pragma("unroll") for (int n = 0; n < 2; ++n) { \
        if constexpr (MX) asm volatile("v_mfma_scale_f32_16x16x128_f8f6f4 %0, %1, %2, %0, %3, %4 op_sel_hi:[0,0,0]" : "+v"(acc[ai][bj][m][n]) : "v"(Bt##8[n]), "v"(At##8[m]), "v"(mx_ws), "v"(mx_one));   \
        else { _Pragma("unroll") for (int k = 0; k < 2; ++k) acc[ai][bj][m][n] = __builtin_amdgcn_mfma_f32_16x16x32_bf16(Bt[n][k], At[m][k], acc[ai][bj][m][n], 0, 0, 0); } } __builtin_amdgcn_s_setprio(0); } while (0)
#define PG8_WAIT_V(n) asm volatile("s_waitcnt vmcnt(" #n ")" ::: "memory")
#define PG8_WAIT_L(n) asm volatile("s_waitcnt lgkmcnt(" #n ")" ::: "memory")
#define PG8_BAR __builtin_amdgcn_s_barrier()
#define PG8_SCHED __builtin_amdgcn_sched_barrier(0)
    Unit cur, nxt; int ui = 0;
    if (!S.next(0, cur)) return;
    f32x4 acc[2][2][4][2];
#pragma unroll
    for (int a = 0; a < 2; ++a)
#pragma unroll
        for (int b = 0; b < 2; ++b)
#pragma unroll
            for (int m = 0; m < 4; ++m)
#pragma unroll
                for (int n = 0; n < 2; ++n) acc[a][b][m][n] = (f32x4){0.f, 0.f, 0.f, 0.f};
    bf16x8 At[4][2], B0[2][2], B1[2][2];
    v8i_t At8[4], B08[2], B18[2];
    const int mx_ws = g.wscale, mx_one = 0x7f7f7f7f;
    const char* cA = (const char*)g.A + (size_t)cur.pm * tstep; const char* cB = (const char*)g.Bt + (size_t)cur.pn * tstep;
    S.a_ready(cur);
    if constexpr (SP2) {
        PG8_STAGE(PG8_SB(0, 0), cB, voffB); PG8_STAGE(PG8_SB(0, 1), cB + hstep, voffB); PG8_STAGE(PG8_SA(0, 0), cA, voffA); PG8_STAGE(PG8_SA(0, 1), cA + hstep, voffA);
        if (wr == 1) PG8_BAR;
        PG8_WAIT_V(2); PG8_BAR;
        PG8_STAGE(PG8_SB(1, 0), cB + kstep, voffB); PG8_STAGE(PG8_SA(1, 0), cA + kstep, voffA); PG8_STAGE(PG8_SB(1, 1), cB + hstep + kstep, voffB);
        PG8_WAIT_V(6); PG8_BAR;
    } else {
        PG8_STAGE(PG8_SB(0, 0), cB, voffB); PG8_STAGE(PG8_SA(0, 0), cA, voffA); PG8_STAGE(PG8_SB(0, 1), cB + hstep, voffB); PG8_STAGE(PG8_SA(0, 1), cA + hstep, voffA);
        if (wr == 1) PG8_BAR;
        PG8_WAIT_V(4); PG8_BAR;
        PG8_STAGE(PG8_SB(1, 0), cB + kstep, voffB); PG8_STAGE(PG8_SA(1, 0), cA + kstep, voffA); PG8_STAGE(PG8_SB(1, 1), cB + hstep + kstep, voffB);
        PG8_WAIT_V(6); PG8_BAR;
    }
    for (;;) {
        const bool has_next = S.next(ui + 1, nxt);
        const bool half = (cur.pm * BM + HALF >= M_VALID);
        const char* nA = has_next ? (const char*)g.A + (size_t)nxt.pm * tstep : cA; const char* nB = has_next ? (const char*)g.Bt + (size_t)nxt.pn * tstep : cB;
        for (int t = 0; t < nt; t += 2) {
            const bool last = (t == nt - 2);
            const char* a1 = cA + (size_t)(t + 1) * kstep;
            const char* a2 = last ? nA : cA + (size_t)(t + 2) * kstep; const char* b2 = last ? nB : cB + (size_t)(t + 2) * kstep;
            const char* a3 = a2 + kstep; const char* b3 = b2 + kstep;
            if (last && has_next) S.a_ready(nxt);
            if constexpr (SP2) {
            PG8_LDB(B0, 0, 0); PG8_LDB(B1, 0, 1); PG8_SCHED; PG8_LDA(At, 0, 0); PG8_STAGE(PG8_SA(1, 1), a1 + hstep, voffA);
            PG8_WAIT_V(8); PG8_WAIT_L(0); PG8_BAR; PG8_MMA(0, 0, At, B0); PG8_MMA(0, 1, At, B1); PG8_BAR; PG8_SCHED;
            PG8_LDA(At, 0, 1); PG8_STAGE(PG8_SB(0, 0), b2, voffB); PG8_STAGE(PG8_SB(0, 1), b2 + hstep, voffB); PG8_STAGE(PG8_SA(0, 0), a2, voffA);
            PG8_WAIT_V(8); PG8_WAIT_L(0); PG8_BAR; if (!half) { PG8_MMA(1, 0, At, B0); PG8_MMA(1, 1, At, B1); } PG8_BAR; PG8_SCHED;
            PG8_LDB(B0, 1, 0); PG8_LDB(B1, 1, 1); PG8_SCHED; PG8_LDA(At, 1, 0); PG8_STAGE(PG8_SA(0, 1), a2 + hstep, voffA);
            PG8_WAIT_V(8); PG8_WAIT_L(0); PG8_BAR; PG8_MMA(0, 0, At, B0); PG8_MMA(0, 1, At, B1); PG8_BAR; PG8_SCHED;
            PG8_LDA(At, 1, 1); PG8_STAGE(PG8_SB(1, 0), b3, voffB); PG8_STAGE(PG8_SB(1, 1), b3 + hstep, voffB); PG8_STAGE(PG8_SA(1, 0), a3, voffA);
            PG8_WAIT_V(8); PG8_WAIT_L(0); PG8_BAR; if (!half) { PG8_MMA(1, 0, At, B0); PG8_MMA(1, 1, At, B1); } PG8_BAR; PG8_SCHED;
            } else {
            PG8_LDB(B0, 0, 0); PG8_SCHED; PG8_LDA(At, 0, 0); PG8_STAGE(PG8_SA(1, 1), a1 + hstep, voffA);
            PG8_WAIT_L(8); PG8_BAR; PG8_WAIT_L(0); PG8_MMA(0, 0, At, B0); PG8_BAR; PG8_SCHED;
            PG8_LDB(B1, 0, 1); PG8_STAGE(PG8_SB(0, 0), b2, voffB);
            PG8_BAR; PG8_WAIT_L(0); PG8_MMA(0, 1, At, B1); PG8_BAR;
            PG8_LDA(At, 0, 1); PG8_STAGE(PG8_SA(0, 0), a2, voffA);
            PG8_BAR; PG8_WAIT_L(0); PG8_MMA(1, 0, At, B0); PG8_BAR; PG8_SCHED;
            PG8_STAGE(PG8_SB(0, 1), b2 + hstep, voffB);
            PG8_WAIT_V(6); PG8_BAR; PG8_MMA(1, 1, At, B1); PG8_BAR;
            PG8_LDB(B0, 1, 0); PG8_SCHED; PG8_LDA(At, 1, 0); PG8_STAGE(PG8_SA(0, 1), a2 + hstep, voffA);
            PG8_WAIT_L(8); PG8_BAR; PG8_WAIT_L(0); PG8_MMA(0, 0, At, B0); PG8_BAR; PG8_SCHED;
            PG8_LDB(B1, 1, 1); PG8_STAGE(PG8_SB(1, 0), b3, voffB);
            PG8_BAR; PG8_WAIT_L(0); PG8_MMA(0, 1, At, B1); PG8_BAR;
            PG8_LDA(At, 1, 1); PG8_STAGE(PG8_SA(1, 0), a3, voffA);
            PG8_BAR; PG8_WAIT_L(0); PG8_MMA(1, 0, At, B0); PG8_BAR; PG8_SCHED;
            PG8_STAGE(PG8_SB(1, 1), b3 + hstep, voffB);
            PG8_WAIT_V(6); PG8_BAR; PG8_MMA(1, 1, At, B1); PG8_BAR;
            }
        }
        if constexpr (MX) asm volatile("s_nop 15\n\ts_nop 15" ::: "memory");
        if constexpr (ALIGN_EPI) { if (wr == 0) PG8_BAR; }
        if constexpr (!Epi::AFTER_DRAIN) { E(acc, cur, wr, wc, fr, fq); S.done(cur); }
        if (!has_next) break;
#pragma unroll
        for (int a = 0; a < 2; ++a)
#pragma unroll
            for (int b = 0; b < 2; ++b)
#pragma unroll
                for (int m = 0; m < 4; ++m)
#pragma unroll
                    for (int n = 0; n < 2; ++n) acc[a][b][m][n] = (f32x4){0.f, 0.f, 0.f, 0.f};
        cur = nxt; cA = nA; cB = nB; ++ui;
        if constexpr (ALIGN_EPI) { if (wr == 1) PG8_BAR; }
    }
    PG8_WAIT_V(0);
    if constexpr (!ALIGN_EPI) { if (wr == 0) PG8_BAR; }
    PG8_BAR;
    if constexpr (Epi::AFTER_DRAIN) { E.fused(acc, cur, wr, wc, fr, fq, lds, wid, lane); S.done(cur); }
#undef PG8_SA
#undef PG8_SB
#undef PG8_STAGE
#undef PG8_LDA
#undef PG8_LDB
#undef PG8_MMA
#undef PG8_WAIT_V
#undef PG8_WAIT_L
#undef PG8_BAR
#undef PG8_SCHED
}
}

struct Args {
    const float* in[28]; float* out; unsigned char* ws;
    double inv[128];
    int ph_lo, ph_hi;
};
enum { I_XP = 0, I_XS, I_SRET, I_SCONV, I_SC, I_SN, I_SM, I_PP, I_PS, I_LNEG, I_LNEB, I_WIN, I_BG, I_CW, I_CB, I_GRN, I_GMN, I_WOUT, I_LN1G, I_LN1B,
       I_WPQ, I_SUBK, I_PU, I_PV, I_WPG, I_WPP, I_LN2G, I_LN2B };

__device__ __forceinline__ void p0_transpose_item(const float* W, int ldw, int col0, int K, int nblk, bf16* WT, LAS float* scr, int item, int lane) {
    const int kb = item / nblk, nb = item % nblk, k0 = 64 * kb, n0 = 32 * nb;
#pragma unroll 1
    for (int hb = 0; hb < 2; ++hb) { float wv[16];
#pragma unroll
        for (int i = 0; i < 16; ++i) wv[i] = W[(size_t)(k0 + 2 * (16 * hb + i) + (lane >> 5)) * ldw + col0 + n0 + (lane & 31)];
#pragma unroll
        for (int i = 0; i < 16; ++i) scr[(2 * (16 * hb + i) + (lane >> 5)) * 33 + (lane & 31)] = wv[i]; }
    LDS_WAIT(); asm volatile("" ::: "memory");
    const int c = lane & 7;
#pragma unroll
    for (int j = 0; j < 4; ++j) { const int n = (lane >> 3) + 8 * j; const LAS float* s = scr + (8 * c) * 33 + n;
        v4u o; o.x = pk2(s[0 * 33], s[1 * 33]); o.y = pk2(s[2 * 33], s[3 * 33]); o.z = pk2(s[4 * 33], s[5 * 33]); o.w = pk2(s[6 * 33], s[7 * 33]);
        *(v4u*)(WT + (size_t)(n0 + n) * K + k0 + 8 * c) = o; }
    LDS_WAIT(); asm volatile("" ::: "memory");
}
__device__ __forceinline__ unsigned pack4_fp8(float a0, float a1, float a2, float a3) {
    a0 = fminf(fmaxf(a0, -448.f), 448.f); a1 = fminf(fmaxf(a1, -448.f), 448.f); a2 = fminf(fmaxf(a2, -448.f), 448.f); a3 = fminf(fmaxf(a3, -448.f), 448.f);
    int p = __builtin_amdgcn_cvt_pk_fp8_f32(a0, a1, 0, false); p = __builtin_amdgcn_cvt_pk_fp8_f32(a2, a3, p, true); return (unsigned)p;
}
__device__ __forceinline__ void p0_transpose_item_fp8(const float* W, int ldw, int col0, int K, int nblk, unsigned char* WT, float scl, LAS float* scr, int item, int lane) {
    const int kb = item / nblk, nb = item % nblk, k0 = 64 * kb, n0 = 32 * nb;
#pragma unroll 1
    for (int hb = 0; hb < 2; ++hb) { float wv[16];
#pragma unroll
        for (int i = 0; i < 16; ++i) wv[i] = W[(size_t)(k0 + 2 * (16 * hb + i) + (lane >> 5)) * ldw + col0 + n0 + (lane & 31)];
#pragma unroll
        for (int i = 0; i < 16; ++i) scr[(2 * (16 * hb + i) + (lane >> 5)) * 33 + (lane & 31)] = wv[i]; }
    LDS_WAIT(); asm volatile("" ::: "memory");
    const int c = lane & 7;
#pragma unroll
    for (int j = 0; j < 4; ++j) { const int n = (lane >> 3) + 8 * j; const LAS float* s = scr + (8 * c) * 33 + n;
        const unsigned lo = pack4_fp8(s[0 * 33] * scl, s[1 * 33] * scl, s[2 * 33] * scl, s[3 * 33] * scl), hi = pack4_fp8(s[4 * 33] * scl, s[5 * 33] * scl, s[6 * 33] * scl, s[7 * 33] * scl);
        *(unsigned long long*)(WT + (size_t)(n0 + n) * K + k0 + 8 * c) = (unsigned long long)lo | ((unsigned long long)hi << 32); }
    LDS_WAIT(); asm volatile("" ::: "memory");
}
template <bool IN_BF16 = false>
__device__ __forceinline__ void ln_row_bf16(const void* xrow, const float* g, const float* b, bf16* orow, int lane, bf16* sl = nullptr, int m = 0, unsigned char* x8row = nullptr) {
    f32x4 v[16]; float s = 0.f;
#pragma unroll
    for (int j = 0; j < 16; ++j) {
        if (IN_BF16) { const unsigned long long xb = ((const unsigned long long*)xrow)[lane + 64 * j];
            v[j] = (f32x4){bf2f((unsigned)xb & 0xffffu), bf2f(((unsigned)xb) >> 16), bf2f((unsigned)(xb >> 32) & 0xffffu), bf2f((unsigned)(xb >> 48))}; }
        else v[j] = ((const f32x4*)xrow)[lane + 64 * j];
        s += (v[j].x + v[j].y) + (v[j].z + v[j].w); }
    const float mean = wave_sum(s) * (1.f / D); float s2 = 0.f;
#pragma unroll
    for (int j = 0; j < 16; ++j) { v[j] = v[j] - mean; s2 += (v[j].x * v[j].x + v[j].y * v[j].y) + (v[j].z * v[j].z + v[j].w * v[j].w); }
    const float rstd = 1.f / sqrtf(wave_sum(s2) * (1.f / D) + LN_EPS);
    unsigned long long* o8 = (unsigned long long*)orow + lane;
#pragma unroll
    for (int j = 0; j < 16; ++j) { const f32x4 gg = ((const f32x4*)g)[lane + 64 * j], bb = ((const f32x4*)b)[lane + 64 * j]; const f32x4 y = v[j] * rstd * gg + bb;
        const unsigned long long pk = (unsigned long long)pk2(y.x, y.y) | ((unsigned long long)pk2(y.z, y.w) << 32);
        o8[64 * j] = pk;
        if (sl) *(unsigned long long*)(sl + ((size_t)(2 * j + (lane >> 5)) * MP + m) * 128 + (lane & 31) * 4) = pk;
        if (x8row) ((unsigned*)x8row)[lane + 64 * j] = pack4_fp8(y.x, y.y, y.z, y.w); }
}
__device__ __forceinline__ void phase_prologue(const Args& a, LAS unsigned char* lds) {
    const int tid = threadIdx.x, lane = tid & 63, wave = tid >> 6;
    const int gw = blockIdx.x * NWAVES + wave, NGW = gridDim.x * NWAVES;
    const int gt = blockIdx.x * NTHR + tid, NGT = gridDim.x * NTHR;
    unsigned char* ws = a.ws;
    LAS float* scr = (LAS float*)(lds + wave * 16384);
    for (int it = gw; it < 64 * 512; it += NGW) p0_transpose_item(a.in[I_WIN], INC, 0, D, 512, (bf16*)(ws + WS_WIN), scr, it, lane);
    { bf16* WGH = (bf16*)(ws + WS_WG); bf16* WGL = WGH + 16 * D;
      for (int j = gt; j < 16 * D; j += NGT) { const int g = j >> 12, k = j & (D - 1); const float x = a.in[I_WIN][(size_t)k * INC + NZ + g]; const unsigned hi = f2bf(x); WGH[j] = (bf16)hi; WGL[j] = (bf16)f2bf(x - bf2f(hi)); } }
    bf16* XN = (bf16*)(ws + WS_XN);
    for (int m = gw; m < MP; m += NGW) {
        if (m < M) { const float* xr = (m < NP) ? a.in[I_XP] + (size_t)m * D : a.in[I_XS] + (size_t)(m - NP) * D; ln_row_bf16(xr, a.in[I_LNEG], a.in[I_LNEB], XN + (size_t)m * D, lane); }
        else { v4u z = {0u, 0u, 0u, 0u}; for (int j = lane; j < D / 8; j += 64) ((v4u*)(XN + (size_t)m * D))[j] = z; }
    }
    if (USE_MX) { unsigned char* MIXp = ws + WS_MIX + (size_t)M * D; v4u z = {0u, 0u, 0u, 0u}; for (int j = gt; j < (MP - M) * D / 16; j += NGT) ((v4u*)MIXp)[j] = z; }
    else { bf16* MIXp = (bf16*)(ws + WS_MIX) + (size_t)M * D; v4u z = {0u, 0u, 0u, 0u}; for (int j = gt; j < (MP - M) * D / 8; j += NGT) ((v4u*)MIXp)[j] = z; }
    { bf16* P16 = (bf16*)(ws + WS_P16);
      for (int j = gt; j < MP * PLE_D / 2; j += NGT) { const int m = j / (PLE_D / 2), c = (j % (PLE_D / 2)) * 2; unsigned o = 0u;
          if (m < M) { const float* pr = (m < NP) ? a.in[I_PP] + (size_t)m * PLE_D : a.in[I_PS] + (size_t)(m - NP) * PLE_D; o = pk2(pr[c], pr[c + 1]); }
          ((unsigned*)P16)[j] = o; } }
    { bf16* KH = (bf16*)(ws + WS_KH); bf16* KL = KH + 16 * 128 * 128; const float* SK = a.in[I_SUBK];
      for (int j = gt; j < 16 * 128 * 128; j += NGT) { const float x = SK[j]; const unsigned hi = f2bf(x); KH[j] = (bf16)hi; KL[j] = (bf16)f2bf(x - bf2f(hi)); } }
    { float* cs = (float*)(ws + WS_ROPE); float* sn = cs + 2049 * 128;
      for (int j = gt; j < 2049 * 128; j += NGT) { const int pi = j >> 7, i = j & 127; const double pos = (pi < 2048) ? (double)pi : (double)PAST_LEN;
          const double rev = pos * a.inv[i] * 0.15915494309189535;
          const double fr = rev - floor(rev);
          const float ang = (float)(fr * 6.283185307179586);
          cs[j] = cosf(ang); sn[j] = sinf(ang); } }
}

template <class Epi>
__device__ __forceinline__ void slow_gemm(LAS unsigned char* ldsb, const bf16* A, const bf16* Bt, int Mrows, int N, int K, const Epi& epi) {
    LAS float* As = (LAS float*)ldsb; LAS float* Bs = As + 32 * 132;
    const int tid = threadIdx.x, ty = tid >> 4, tx = tid & 15;
    const int ntm = Mrows / 128, ntn = N / 128;
    for (int tile = blockIdx.x; tile < ntm * ntn; tile += gridDim.x) {
        const int tm = tile / ntn, tn = tile % ntn, m0 = tm * 128, n0 = tn * 128;
        float acc[4][8];
#pragma unroll
        for (int i = 0; i < 4; ++i)
#pragma unroll
            for (int j = 0; j < 8; ++j) acc[i][j] = 0.f;
        const int r = tid >> 2, c = tid & 3;
        for (int k0 = 0; k0 < K; k0 += 32) {
            const v4u av = *(const v4u*)(A + (size_t)(m0 + r) * K + k0 + 8 * c);
            const v4u bv = *(const v4u*)(Bt + (size_t)(n0 + r) * K + k0 + 8 * c);
            __syncthreads();
#pragma unroll
            for (int i = 0; i < 4; ++i) {
                As[(8 * c + 2 * i) * 132 + r] = bf2f(av[i] & 0xffffu); As[(8 * c + 2 * i + 1) * 132 + r] = bf2f(av[i] >> 16);
                Bs[(8 * c + 2 * i) * 132 + r] = bf2f(bv[i] & 0xffffu); Bs[(8 * c + 2 * i + 1) * 132 + r] = bf2f(bv[i] >> 16);
            }
            __syncthreads();
#pragma unroll 8
            for (int kk = 0; kk < 32; ++kk) {
                const f32x4 av4 = *(const LAS f32x4*)(As + kk * 132 + ty * 4);
                const f32x4 b0 = *(const LAS f32x4*)(Bs + kk * 132 + tx * 8), b1 = *(const LAS f32x4*)(Bs + kk * 132 + tx * 8 + 4);
#pragma unroll
                for (int i = 0; i < 4; ++i) {
#pragma unroll
                    for (int j = 0; j < 4; ++j) { acc[i][j] += av4[i] * b0[j]; acc[i][4 + j] += av4[i] * b1[j]; }
                }
            }
        }
#pragma unroll
        for (int i = 0; i < 4; ++i)
#pragma unroll
            for (int j = 0; j < 8; ++j) epi(m0 + ty * 4 + i, n0 + tx * 8 + j, acc[i][j]);
        __syncthreads();
    }
}

constexpr float WO8_SCALE = 256.f; constexpr int WO8_E8M0 = 0x77777777;
constexpr float WG8_SCALE = 128.f; constexpr int WG8_E8M0 = 0x78787878;
constexpr float U8_SCALE = 256.f;
constexpr float V8_SCALE = 16.f;
constexpr int BG_T1Q = 64 * 128 + 64 * 64;
constexpr int BG_TS = BG_T1Q + 64 * 64;
constexpr int BG_T1 = 64 * 128  , BG_T2 = BG_T1 + 64 * 64 + 64 * 128  , BG_TN = BG_T2 + 4 * 128  ;
__device__ __forceinline__ void bg_transposes(const Args& a, LAS unsigned char* lds, int it_lo, int it_hi, int widx, int nw) {
    unsigned char* ws = a.ws; const int lane = threadIdx.x & 63, wave = threadIdx.x >> 6; LAS float* scr = (LAS float*)(lds + wave * 16384);
    constexpr int I_OUT = 64 * 128, I_Q = 64 * 64, I_GT = 64 * 128, I_PR = 4 * 128;
    for (int it = it_lo + widx; it < it_hi; it += nw) { int r = it;
#if USE_MX
        if (r < I_OUT) { p0_transpose_item_fp8(a.in[I_WOUT], D, 0, D, 128, ws + WS_WOUT, WO8_SCALE, scr, r, lane); continue; } r -= I_OUT;
#else
        if (r < I_OUT) { p0_transpose_item(a.in[I_WOUT], D, 0, D, 128, (bf16*)(ws + WS_WOUT), scr, r, lane); continue; } r -= I_OUT;
#endif
        if (r < I_Q) { p0_transpose_item(a.in[I_WPQ], NQ, 0, D, 64, (bf16*)(ws + WS_W3), scr, r, lane); continue; } r -= I_Q;
#if USE_MX
        if (r < I_GT) { p0_transpose_item_fp8(a.in[I_WPG], D, 0, D, 128, ws + WS_W3 + (size_t)NQ * D * 2, WG8_SCALE, scr, r, lane); continue; } r -= I_GT;
#else
        if (r < I_GT) { p0_transpose_item(a.in[I_WPG], D, 0, D, 128, (bf16*)(ws + WS_W3) + (size_t)NQ * D, scr, r, lane); continue; } r -= I_GT;
#endif
        p0_transpose_item(a.in[I_WPP], D, 0, PLE_D, 128, (bf16*)(ws + WS_WP), scr, r, lane); }
}
__device__ __forceinline__ void bg_tables(const Args& a, int row_lo, int row_hi, int widx, int nw) {
    unsigned char* ws = a.ws; const int lane = threadIdx.x & 63;
    for (int e2 = row_lo + widx; e2 < row_hi; e2 += nw) { const int e = e2 & (NEXP - 1); const bool isv = e2 >= NEXP; const float* src = (isv ? a.in[I_PV] : a.in[I_PU]) + (size_t)e * D;
        f32x4 rv[16];
#pragma unroll
        for (int j = 0; j < 16; ++j) rv[j] = __builtin_nontemporal_load((const f32x4*)src + j * 64 + lane);
        { unsigned char* dst = ws + (isv ? WS_VB : WS_UB); const float scl = isv ? V8_SCALE : U8_SCALE;
#pragma unroll
            for (int j = 0; j < 16; ++j) { f32x4 v = rv[j] * scl; v = __builtin_elementwise_min(__builtin_elementwise_max(v, (f32x4){-448.f, -448.f, -448.f, -448.f}), (f32x4){448.f, 448.f, 448.f, 448.f});
                int p = __builtin_amdgcn_cvt_pk_fp8_f32(v.x, v.y, 0, false); p = __builtin_amdgcn_cvt_pk_fp8_f32(v.z, v.w, p, true);
                const int s = j * 2 + (lane >> 5);
                __builtin_nontemporal_store((unsigned)p, (unsigned*)(dst + ((size_t)s * NEXP + e) * 128 + (lane & 31) * 4)); } }
    }
}
__device__ __forceinline__ void idle_rank(int nunits, int& rank, int& count) { const int G = (int)gridDim.x, rem = nunits % G; if (rem == 0) { rank = (int)blockIdx.x; count = G; } else { rank = (int)blockIdx.x - rem; count = G - rem; } }
__device__ __forceinline__ void gates_mfma(const Args& a, int widx, int nw) {
    unsigned char* ws = a.ws; const int lane = threadIdx.x & 63, r = lane & 31, hh = lane >> 5;
    const bf16* XN = (const bf16*)(ws + WS_XN); const bf16* WGH = (const bf16*)(ws + WS_WG); const bf16* WGL = WGH + 16 * D; float* G = (float*)(ws + WS_G);
    for (int u = widx; u < (M / 32) * 4; u += nw) { const int t0 = (u >> 2) * 32, kq = u & 3;
        f32x16 acc;
#pragma unroll
        for (int q = 0; q < 16; ++q) acc[q] = 0.f;
        const bf16* ap = XN + (size_t)(t0 + r) * D + kq * (D / 4) + 8 * hh; const bf16* bhp = WGH + (size_t)(r & 15) * D + kq * (D / 4) + 8 * hh; const bf16* blp = WGL + (size_t)(r & 15) * D + kq * (D / 4) + 8 * hh;
#pragma unroll 8
        for (int ks = 0; ks < D / 64; ++ks) { const bf16x8 af = *(const bf16x8*)(ap + ks * 16); bf16x8 bh = *(const bf16x8*)(bhp + ks * 16), bl = *(const bf16x8*)(blp + ks * 16);
            if (r >= 16) { const v4u z = {0u, 0u, 0u, 0u}; bh = __builtin_bit_cast(bf16x8, z); bl = bh; }
            acc = MFMA32(af, bh, acc); acc = MFMA32(af, bl, acc); }
        if (r < 16) { float* Gq = G + (size_t)kq * MP * 16;
#pragma unroll
            for (int q = 0; q < 16; ++q) Gq[(size_t)(t0 + (q & 3) + 8 * (q >> 2) + 4 * hh) * 16 + r] = acc[q]; }
    }
}

struct EpiZ { bf16* Z; __device__ __forceinline__ void operator()(int m, int n, float v) const { Z[(size_t)m * NZ + n] = (bf16)f2bf(v); } };
__device__ __forceinline__ void phase_gemm1(const Args& a, LAS unsigned char* lds) {
    unsigned char* ws = a.ws;
#if USE_MFMA
    { pg8::Gemm g{(const bf16*)(ws + WS_XN), (const bf16*)(ws + WS_WIN), MP, NZ, D}; pg8::TailOrder S; S.init(NP, NZ, (int)gridDim.x, (int)blockIdx.x);
      const float* cs = (const float*)(ws + WS_ROPE); pg8::EpiZRope E{(bf16*)(ws + WS_Z), cs, cs + 2049 * 128};
      pg8::gemm_phase<pg8::EpiZRope, pg8::TailOrder, true, true>(lds, g, S, E); }
#else
    EpiZ e{(bf16*)(ws + WS_Z)};
    slow_gemm(lds, (const bf16*)(ws + WS_XN), (const bf16*)(ws + WS_WIN), MP, NZ, D, e);
#endif
#if USE_MFMA
    { int rank, cnt; idle_rank((MP / 256) * (NZ / 256), rank, cnt);
      if (rank >= 0) { const int widx = rank * NWAVES + (int)(threadIdx.x >> 6), nw = cnt * NWAVES; gates_mfma(a, widx, nw); bg_transposes(a, lds, 0, BG_TS, widx, nw); bg_transposes(a, lds, BG_T2, BG_TN, widx, nw); } }
#else
    { const int wv = (int)(threadIdx.x >> 6), widx = (int)blockIdx.x * NWAVES + wv, nw = (int)gridDim.x * NWAVES; gates_mfma(a, widx, nw); bg_transposes(a, lds, 0, BG_TN, widx, nw); bg_tables(a, 0, 2 * NEXP, widx, nw); }
#endif
}

__device__ __forceinline__ void phase_rope_conv(const Args& a) {
    unsigned char* ws = a.ws; const int gt = blockIdx.x * NTHR + threadIdx.x, NGT = gridDim.x * NTHR;
    bf16* Z = (bf16*)(ws + WS_Z); const float* cs = (const float*)(ws + WS_ROPE); const float* sn = cs + 2049 * 128;
    if (!USE_MFMA) for (size_t j = gt; j < (size_t)M * 2048; j += NGT) {
        const int m = (int)(j >> 11), p = (int)(j & 2047), hh = p >> 7, i = p & 127;
        const int col = hh * 256 + i; const int pi = (m < NP) ? (m & (SEQ - 1)) : 2048;
        const float c = cs[pi * 128 + i], s = sn[pi * 128 + i];
        const float x1 = bf2f(Z[(size_t)m * NZ + col]), x2 = bf2f(Z[(size_t)m * NZ + col + 128]);
        float y1 = x1 * c - x2 * s, y2 = x1 * s + x2 * c;
        if (hh >= 8) { y1 *= 0.0625f; y2 *= 0.0625f; }
        Z[(size_t)m * NZ + col] = (bf16)f2bf(y1); Z[(size_t)m * NZ + col + 128] = (bf16)f2bf(y2);
    }
    bf16* MQK = (bf16*)(ws + WS_MQK); const float* cw = a.in[I_CW]; const float* cb = a.in[I_CB]; const float* sconv = a.in[I_SCONV];
    for (int j = gt; j < M * 512; j += NGT) {
        const int m = j >> 9, c = (j & 511) * 8;
        float acc[8];
        { const f32x4 b0 = *(const f32x4*)(cb + c), b1 = *(const f32x4*)(cb + c + 4); acc[0] = b0.x; acc[1] = b0.y; acc[2] = b0.z; acc[3] = b0.w; acc[4] = b1.x; acc[5] = b1.y; acc[6] = b1.z; acc[7] = b1.w; }
#pragma unroll
        for (int q = 0; q < 4; ++q) {
            float xv[8]; bool have = true;
            if (m < NP) { const int t = m & (SEQ - 1); have = (t - 3 + q) >= 0;
                if (have) { const v4u z = *(const v4u*)(Z + (size_t)(m - 3 + q) * NZ + ZMQK + c);
#pragma unroll
                    for (int i = 0; i < 4; ++i) { xv[2 * i] = bf2f(z[i] & 0xffffu); xv[2 * i + 1] = bf2f(z[i] >> 16); } } }
            else if (q < 3) { const float* sp = sconv + ((size_t)(m - NP) * 3 + q) * 4096 + c; const f32x4 s0 = *(const f32x4*)sp, s1 = *(const f32x4*)(sp + 4);
                xv[0] = s0.x; xv[1] = s0.y; xv[2] = s0.z; xv[3] = s0.w; xv[4] = s1.x; xv[5] = s1.y; xv[6] = s1.z; xv[7] = s1.w; }
            else { const v4u z = *(const v4u*)(Z + (size_t)m * NZ + ZMQK + c);
#pragma unroll
                for (int i = 0; i < 4; ++i) { xv[2 * i] = bf2f(z[i] & 0xffffu); xv[2 * i + 1] = bf2f(z[i] >> 16); } }
            if (have) { const f32x4 w0 = *(const f32x4*)(cw + q * 4096 + c), w1 = *(const f32x4*)(cw + q * 4096 + c + 4);
                acc[0] += w0.x * xv[0]; acc[1] += w0.y * xv[1]; acc[2] += w0.z * xv[2]; acc[3] += w0.w * xv[3]; acc[4] += w1.x * xv[4]; acc[5] += w1.y * xv[5]; acc[6] += w1.z * xv[6]; acc[7] += w1.w * xv[7]; }
        }
        const float sc = (c >= 2048) ? 0.0625f : 1.f;
        v4u o;
#pragma unroll
        for (int i = 0; i < 4; ++i) o[i] = pk2(siluf_(acc[2 * i]) * sc, siluf_(acc[2 * i + 1]) * sc);
        *(v4u*)(MQK + (size_t)m * 4096 + c) = o;
    }
    float* convp = a.out + O_CONVP; float* convs = a.out + O_CONVS;
    for (int j = gt; j < NPB * 3 * 1024; j += NGT) { const int b = j / (3 * 1024), q = (j >> 10) % 3, c = (j & 1023) * 4; const unsigned long long z = *(const unsigned long long*)(Z + (size_t)(b * SEQ + SEQ - 3 + q) * NZ + ZMQK + c);
        *(f32x4*)(convp + (size_t)j * 4) = (f32x4){bf2f((unsigned)z & 0xffffu), bf2f(((unsigned)z) >> 16), bf2f((unsigned)(z >> 32) & 0xffffu), bf2f((unsigned)(z >> 48))}; }
    for (int j = gt; j < NS * 3 * 1024; j += NGT) { const int b = j / (3 * 1024), q = (j >> 10) % 3, c = (j & 1023) * 4; f32x4 o;
        if (q < 2) o = *(const f32x4*)(sconv + ((size_t)b * 3 + q + 1) * 4096 + c);
        else { const unsigned long long z = *(const unsigned long long*)(Z + (size_t)(NP + b) * NZ + ZMQK + c); o = (f32x4){bf2f((unsigned)z & 0xffffu), bf2f(((unsigned)z) >> 16), bf2f((unsigned)(z >> 32) & 0xffffu), bf2f((unsigned)(z >> 48))}; }
        *(f32x4*)(convs + (size_t)j * 4) = o; }
}

__device__ __forceinline__ float block_sum256(float v, LAS float* red, int tid) {
    v = wave_sum(v);
    __syncthreads();
    if ((tid & 63) == 0) red[tid >> 6] = v;
    __syncthreads();
    return (red[0] + red[1]) + (red[2] + red[3]) + (red[4] + red[5]) + (red[6] + red[7]);
}
template <bool ML>
__device__ __forceinline__ void seq_mixer_unit(const Args& a, LAS unsigned char* ldsb, int row0, int T, int h, const float* S0, const float* n0p, const float* m0p,
                                               float* Sout, float* nout, float* mout) {
    LAS float* qs = (LAS float*)ldsb; LAS float* ks = qs + 256; LAS float* vs = ks + 256; LAS float* part = vs + 256  ; LAS float* red = part + 512  ;
    unsigned char* ws = a.ws; const bf16* Z = (const bf16*)(ws + WS_Z); const bf16* MQK = (const bf16*)(ws + WS_MQK); const float* G = (const float*)(ws + WS_G); bf16* MIX = (bf16*)(ws + WS_MIX);
    const int tid = threadIdx.x, e = tid & 255, hf = tid >> 8;
    float S[128];
#pragma unroll
    for (int dd = 0; dd < 128; ++dd) S[dd] = S0 ? S0[(size_t)(hf * 128 + dd) * 256 + e] : 0.f;
    float nvec = 0.f, mst = 0.f;
    if (ML) { if (n0p && tid < 256) nvec = n0p[tid]; if (m0p) mst = m0p[0]; }
    const float gamma = 1.f - exp2f(-5.f - (float)h);
    const float gn = ML ? a.in[I_GMN][h * 256 + e] : a.in[I_GRN][h * 256 + e];
    const float big = a.in[I_BG][h], bfg = a.in[I_BG][8 + h];
    for (int t = 0; t < T; ++t) {
        const int row = row0 + t;
        __syncthreads();
        if (tid < 256) {
            if (ML) { qs[tid] = bf2f(MQK[(size_t)row * 4096 + h * 256 + tid]); ks[tid] = bf2f(MQK[(size_t)row * 4096 + 2048 + h * 256 + tid]); vs[tid] = bf2f(Z[(size_t)row * NZ + ZMV + h * 256 + tid]); }
            else { qs[tid] = bf2f(Z[(size_t)row * NZ + ZQ + h * 256 + tid]); ks[tid] = bf2f(Z[(size_t)row * NZ + ZK + h * 256 + tid]); vs[tid] = bf2f(Z[(size_t)row * NZ + ZV + h * 256 + tid]); }
        }
        float dec = gamma, wk = 1.f, mnew = 0.f;
        if (ML) { const float ig = gate_ld(G, row, h) + big, lf = log_sigmoidf_(gate_ld(G, row, 8 + h) + bfg);
            mnew = fmaxf(lf + mst, ig); dec = __expf(lf + mst - mnew); wk = __expf(ig - mnew); mst = mnew; }
        __syncthreads();
        const float ve = vs[e] * wk; float po = 0.f;
#pragma unroll
        for (int dd = 0; dd < 128; ++dd) { const int d = hf * 128 + dd; S[dd] = dec * S[dd] + ks[d] * ve; po += qs[d] * S[dd]; }
        part[tid] = po;
        float den = 0.f;
        if (ML) { float dp = 0.f; if (tid < 256) { nvec = dec * nvec + wk * ks[tid]; dp = qs[tid] * nvec; } den = block_sum256(dp, red, tid); }
        __syncthreads();
        float o = 0.f;
        if (tid < 256) { o = part[tid] + part[tid + 256]; if (ML) o = o / fmaxf(fabsf(den), __expf(-mnew)); }
        const float mu = block_sum256(tid < 256 ? o : 0.f, red, tid) * (1.f / 256.f);
        const float dv = (tid < 256) ? (o - mu) : 0.f;
        const float var = block_sum256(dv * dv, red, tid) * (1.f / 256.f);
        if (tid < 256) {
            const float on = dv * (1.f / sqrtf(var + LN_EPS)) * gn;
            float gate;
            if (ML) gate = sigmoidf_(bf2f(Z[(size_t)row * NZ + ZMO + h * 256 + tid])); else gate = siluf_(bf2f(Z[(size_t)row * NZ + ZG + h * 256 + tid]));
            MIX[(size_t)row * D + (ML ? RW : 0) + h * 256 + tid] = (bf16)f2bf(on * gate);
        }
    }
#pragma unroll
    for (int dd = 0; dd < 128; ++dd) Sout[(size_t)(hf * 128 + dd) * 256 + e] = S[dd];
    if (ML) { if (tid < 256) nout[tid] = nvec; if (tid == 0) mout[0] = mst; }
}
__device__ __forceinline__ void phase_seq_mixers(const Args& a, LAS unsigned char* lds) {
    for (int u = blockIdx.x; u < 64 + 2048; u += gridDim.x) {
        const bool sample = u >= 64; const int uu = sample ? u - 64 : u; const bool ml = sample ? (uu >= 1024) : (uu >= 32); const int v = sample ? (uu & 1023) : (uu & 31);
        const int b = v >> 3, h = v & 7; const int row0 = sample ? NP + b : b * SEQ, T = sample ? 1 : SEQ;
        if (!ml) { seq_mixer_unit<false>(a, lds, row0, T, h, sample ? a.in[I_SRET] + (size_t)v * 65536 : nullptr, nullptr, nullptr, a.out + (sample ? O_RETS : O_RETP) + (size_t)v * 65536, nullptr, nullptr); }
        else { seq_mixer_unit<true>(a, lds, row0, T, h, sample ? a.in[I_SC] + (size_t)v * 65536 : nullptr, sample ? a.in[I_SN] + (size_t)v * 256 : nullptr, sample ? a.in[I_SM] + v : nullptr,
                                    a.out + (sample ? O_CS : O_CP) + (size_t)v * 65536, a.out + (sample ? O_NS : O_NP) + (size_t)v * 256, a.out + (sample ? O_MS : O_MP) + v); }
        __syncthreads();
    }
}

constexpr int KT_P = 136;
constexpr int QL_P = 264;
constexpr int VT_P = 132;
constexpr int ST_P = 136;
constexpr int M3_SMALL = 67584 + 256 * ST_P * 2;
__device__ __forceinline__ float wave_incl_scan(float v, int lane) {
#pragma unroll
    for (int o = 1; o < 64; o <<= 1) { const float t = __shfl_up(v, o); if (lane >= o) v += t; }
    return v;
}
__device__ __forceinline__ float wave_incl_scanmax(float v, int lane) {
#pragma unroll
    for (int o = 1; o < 64; o <<= 1) { const float t = __shfl_up(v, o); if (lane >= o) v = fmaxf(v, t); }
    return v;
}
__device__ __forceinline__ float wave_max(float v) {
#pragma unroll
    for (int o = 1; o < 64; o <<= 1) v = fmaxf(v, __shfl_xor(v, o));
    return v;
}
__device__ __forceinline__ void gate_scan(const float* G, const float* bgate, int row0, int h, int lane, LAS float* aj, LAS float* btv, LAS float* cmx, float& amax, float& bl) {
    const float big = bgate[h], bfg = bgate[8 + h];
    const float ig0 = gate_ld(G, row0 + lane, h) + big, ig1 = gate_ld(G, row0 + 64 + lane, h) + big;
    const float lf0 = log_sigmoidf_(gate_ld(G, row0 + lane, 8 + h) + bfg), lf1 = log_sigmoidf_(gate_ld(G, row0 + 64 + lane, 8 + h) + bfg);
    const float b0 = wave_incl_scan(lf0, lane); const float tot0 = __shfl(b0, 63); const float b1 = wave_incl_scan(lf1, lane) + tot0;
    const float a0 = ig0 - b0, a1 = ig1 - b1;
    const float c0 = wave_incl_scanmax(a0, lane); const float mx0 = __shfl(c0, 63); const float c1 = fmaxf(wave_incl_scanmax(a1, lane), mx0);
    aj[lane] = a0; aj[lane + 64] = a1; btv[lane] = b0; btv[lane + 64] = b1; cmx[lane] = c0; cmx[lane + 64] = c1;
    amax = __shfl(c1, 63); bl = __shfl(b1, 63);
}
__device__ __forceinline__ void conv8_prompt(const Args& a, const bf16* Z, int row, int t, int col, float (&out)[8]) {
    const float* cw = a.in[I_CW]; const float* cb = a.in[I_CB];
    { const f32x4 b0 = *(const f32x4*)(cb + col), b1 = *(const f32x4*)(cb + col + 4); out[0] = b0.x; out[1] = b0.y; out[2] = b0.z; out[3] = b0.w; out[4] = b1.x; out[5] = b1.y; out[6] = b1.z; out[7] = b1.w; }
#pragma unroll
    for (int q = 0; q < 4; ++q) { if (t - 3 + q >= 0) { const v4u z = *(const v4u*)(Z + (size_t)(row - 3 + q) * NZ + ZMQK + col); const f32x4 w0 = *(const f32x4*)(cw + q * 4096 + col), w1 = *(const f32x4*)(cw + q * 4096 + col + 4);
            out[0] += w0.x * bf2f(z.x & 0xffffu); out[1] += w0.y * bf2f(z.x >> 16); out[2] += w0.z * bf2f(z.y & 0xffffu); out[3] += w0.w * bf2f(z.y >> 16);
            out[4] += w1.x * bf2f(z.z & 0xffffu); out[5] += w1.y * bf2f(z.z >> 16); out[6] += w1.z * bf2f(z.w & 0xffffu); out[7] += w1.w * bf2f(z.w >> 16); } }
    const float sc = (col >= 2048) ? 0.0625f : 1.f;
#pragma unroll
    for (int i = 0; i < 8; ++i) out[i] = siluf_(out[i]) * sc;
}
__device__ __forceinline__ float conv1_sample(const Args& a, const bf16* Z, int b, int col) {
    const float* cw = a.in[I_CW]; const float* sconv = a.in[I_SCONV]; float acc = a.in[I_CB][col];
#pragma unroll
    for (int q = 0; q < 3; ++q) acc += cw[q * 4096 + col] * sconv[((size_t)b * 3 + q) * 4096 + col];
    acc += cw[3 * 4096 + col] * bf2f(Z[(size_t)(NP + b) * NZ + ZMQK + col]);
    return siluf_(acc) * ((col >= 2048) ? 0.0625f : 1.f);
}
__device__ __forceinline__ void m1_unit(const Args& a, LAS unsigned char* ldsb, int kind, int bh, int c) {
    unsigned char* ws = a.ws; const int tid = threadIdx.x, lane = tid & 63, w = tid >> 6, r = lane & 31, hh = lane >> 5;
    const int b = bh >> 3, h = bh & 7, row0 = b * SEQ + c * 128, unit = (kind * 32 + bh) * 16 + c;
    LAS bf16* KT = (LAS bf16*)ldsb; LAS bf16* VT = KT + 256 * KT_P; LAS float* wj = (LAS float*)(ldsb + 2 * 256 * KT_P * 2); LAS float* aj = wj + 128; LAS float* btv = aj + 128; LAS float* cmx = btv + 128;
    const bf16* Z = (const bf16*)(ws + WS_Z); const bf16* MQK = (const bf16*)(ws + WS_MQK);
    const bf16* Ksrc = kind ? MQK + (size_t)row0 * 4096 + 2048 + h * 256 : Z + (size_t)row0 * NZ + ZK + h * 256; const int kst = kind ? 4096 : NZ;
    const bf16* Vsrc = Z + (size_t)row0 * NZ + (kind ? ZMV : ZV) + h * 256;
    __syncthreads();
    if (kind) { if (w == 0) { float amax, bl; gate_scan((const float*)(ws + WS_G), a.in[I_BG], row0, h, lane, aj, btv, cmx, amax, bl);
            wj[lane] = __expf(aj[lane] - amax); wj[lane + 64] = __expf(aj[lane + 64] - amax);
            if (lane == 0) { float* sc = (float*)(ws + WS_SCAL); sc[bh * 16 + c] = amax; sc[512 + bh * 16 + c] = bl; } } }
    else { if (tid < 128) { const float lg = log1pf(-exp2f(-5.f - (float)h)); wj[tid] = __expf(lg * (float)(127 - tid)); } }
    __syncthreads();
#pragma unroll 4
    for (int idx = tid; idx < 128 * 32; idx += NTHR) { const int j = idx & 127, dg = idx >> 7; const float wv = wj[j];
        const v4u vv = *(const v4u*)(Vsrc + (size_t)j * NZ + dg * 8);
        float kf[8];
        if (kFuseConv && kind != 0) conv8_prompt(a, Z, row0 + j, c * 128 + j, 2048 + h * 256 + dg * 8, kf);
        else { const v4u kv = *(const v4u*)(Ksrc + (size_t)j * kst + dg * 8);
#pragma unroll
            for (int i = 0; i < 4; ++i) { kf[2 * i] = bf2f(kv[i] & 0xffffu); kf[2 * i + 1] = bf2f(kv[i] >> 16); } }
#pragma unroll
        for (int i = 0; i < 4; ++i) {
            KT[(dg * 8 + 2 * i) * KT_P + j] = (bf16)f2bf(kf[2 * i] * wv); KT[(dg * 8 + 2 * i + 1) * KT_P + j] = (bf16)f2bf(kf[2 * i + 1] * wv);
            VT[(dg * 8 + 2 * i) * KT_P + j] = (bf16)(vv[i] & 0xffffu); VT[(dg * 8 + 2 * i + 1) * KT_P + j] = (bf16)(vv[i] >> 16); } }
    __syncthreads();
    const int wr = w >> 1, wc = w & 1;
    f32x16 acc[2][4];
#pragma unroll
    for (int mi = 0; mi < 2; ++mi)
#pragma unroll
        for (int ni = 0; ni < 4; ++ni)
#pragma unroll
            for (int q = 0; q < 16; ++q) acc[mi][ni][q] = 0.f;
#pragma unroll 2
    for (int ks = 0; ks < 8; ++ks) { const int k0 = ks * 16 + 8 * hh;
        bf16x8 af[2], bfr[4];
#pragma unroll
        for (int mi = 0; mi < 2; ++mi) af[mi] = *(const LAS bf16x8*)(KT + (64 * wr + 32 * mi + r) * KT_P + k0);
#pragma unroll
        for (int ni = 0; ni < 4; ++ni) bfr[ni] = *(const LAS bf16x8*)(VT + (128 * wc + 32 * ni + r) * KT_P + k0);
#pragma unroll
        for (int mi = 0; mi < 2; ++mi)
#pragma unroll
            for (int ni = 0; ni < 4; ++ni) acc[mi][ni] = MFMA32(af[mi], bfr[ni], acc[mi][ni]); }
    if (kind && tid < 256) { float s = 0.f;
        for (int j = 0; j < 128; j += 8) { const v4u kk = *(const LAS v4u*)(KT + tid * KT_P + j);
            s += (bf2f(kk.x & 0xffffu) + bf2f(kk.x >> 16)) + (bf2f(kk.y & 0xffffu) + bf2f(kk.y >> 16)) + (bf2f(kk.z & 0xffffu) + bf2f(kk.z >> 16)) + (bf2f(kk.w & 0xffffu) + bf2f(kk.w >> 16)); }
        ((float*)(ws + WS_NLOC))[(size_t)(bh * 16 + c) * 256 + tid] = s; }
    __syncthreads();
    LAS bf16* OT = (LAS bf16*)ldsb;
#pragma unroll
    for (int mi = 0; mi < 2; ++mi)
#pragma unroll
        for (int ni = 0; ni < 4; ++ni)
#pragma unroll
            for (int rq = 0; rq < 4; ++rq) { const int d0 = 64 * wr + 32 * mi + 8 * rq + 4 * hh, e = 128 * wc + 32 * ni + r;
                *(LAS unsigned long long*)(OT + e * QL_P + d0) = (unsigned long long)pk2(acc[mi][ni][4 * rq], acc[mi][ni][4 * rq + 1]) | ((unsigned long long)pk2(acc[mi][ni][4 * rq + 2], acc[mi][ni][4 * rq + 3]) << 32); }
    __syncthreads();
    { bf16* UT = (bf16*)(ws + WS_UT) + (size_t)unit * 65536;
#pragma unroll 8
      for (int idx = tid; idx < 256 * 32; idx += NTHR) { const int e = idx >> 5, p = idx & 31; *(v4u*)(UT + e * 256 + p * 8) = *(const LAS v4u*)(OT + e * QL_P + p * 8); } }
}
__device__ __forceinline__ void sample_unit(const Args& a, LAS unsigned char* ldsb, int kind, int v) {
    unsigned char* ws = a.ws; const int tid = threadIdx.x, lane = tid & 63, w = tid >> 6; const int b = v >> 3, h = v & 7, row = NP + b;
    LAS float* qs = (LAS float*)ldsb; LAS float* ks = qs + 256; LAS float* vs = ks + 256; LAS float* red = vs + 256; LAS float* opart = red + 16;
    const bf16* Z = (const bf16*)(ws + WS_Z); const bf16* MQK = (const bf16*)(ws + WS_MQK); const float* G = (const float*)(ws + WS_G); bf16* MIX = (bf16*)(ws + WS_MIX);
    const float* S0 = (kind ? a.in[I_SC] : a.in[I_SRET]) + (size_t)v * 65536; float* Sout = a.out + (kind ? O_CS : O_RETS) + (size_t)v * 65536;
    __syncthreads();
    if (tid < 256) {
        if (kind) { if (FUSE_CONV) { qs[tid] = bf2f(f2bf(conv1_sample(a, Z, b, h * 256 + tid))); ks[tid] = bf2f(f2bf(conv1_sample(a, Z, b, 2048 + h * 256 + tid))); }
                    else { qs[tid] = bf2f(MQK[(size_t)row * 4096 + h * 256 + tid]); ks[tid] = bf2f(MQK[(size_t)row * 4096 + 2048 + h * 256 + tid]); }
                    vs[tid] = bf2f(Z[(size_t)row * NZ + ZMV + h * 256 + tid]); }
        else { qs[tid] = bf2f(Z[(size_t)row * NZ + ZQ + h * 256 + tid]); ks[tid] = bf2f(Z[(size_t)row * NZ + ZK + h * 256 + tid]); vs[tid] = bf2f(Z[(size_t)row * NZ + ZV + h * 256 + tid]); } }
    float dec = 1.f - exp2f(-5.f - (float)h), wk = 1.f, mnew = 0.f;
    if (kind) { const float ig = gate_ld(G, row, h) + a.in[I_BG][h], lf = log_sigmoidf_(gate_ld(G, row, 8 + h) + a.in[I_BG][8 + h]); const float m0 = a.in[I_SM][v];
        mnew = fmaxf(lf + m0, ig); dec = __expf(lf + m0 - mnew); wk = __expf(ig - mnew); }
    __syncthreads();
    const f32x4 v4 = *(const LAS f32x4*)(vs + lane * 4);
    f32x4 o = {0.f, 0.f, 0.f, 0.f};
#pragma unroll 1
    for (int hb = 0; hb < 2; ++hb) {
        f32x4 sv[16];
#pragma unroll
        for (int dd = 0; dd < 16; ++dd) sv[dd] = __builtin_nontemporal_load((const f32x4*)(S0 + (size_t)(32 * w + 16 * hb + dd) * 256 + lane * 4));
#pragma unroll
        for (int dd = 0; dd < 16; ++dd) { const int d = 32 * w + 16 * hb + dd; const float kd = ks[d] * wk;
            const f32x4 sn = dec * sv[dd] + kd * v4; __builtin_nontemporal_store(sn, (f32x4*)(Sout + (size_t)d * 256 + lane * 4)); o += qs[d] * sn; }
    }
    *(LAS f32x4*)(opart + w * 256 + lane * 4) = o;
    float den = 0.f;
    if (kind) { float dp = 0.f; if (tid < 256) { const float nn = dec * a.in[I_SN][(size_t)v * 256 + tid] + wk * ks[tid]; (a.out + O_NS)[(size_t)v * 256 + tid] = nn; dp = qs[tid] * nn; } den = block_sum256(dp, red, tid);
        if (tid == 0) (a.out + O_MS)[v] = mnew; }
    __syncthreads();
    float ov = 0.f;
    if (tid < 256) { ov = ((opart[tid] + opart[256 + tid]) + (opart[512 + tid] + opart[768 + tid])) + ((opart[1024 + tid] + opart[1280 + tid]) + (opart[1536 + tid] + opart[1792 + tid]));
        if (kind) ov = ov / fmaxf(fabsf(den), __expf(-mnew)); }
    const float mu = block_sum256(tid < 256 ? ov : 0.f, red, tid) * (1.f / 256.f);
    const float dv = (tid < 256) ? (ov - mu) : 0.f;
    const float var = block_sum256(dv * dv, red, tid) * (1.f / 256.f);
    if (tid < 256) { const float gn = (kind ? a.in[I_GMN] : a.in[I_GRN])[h * 256 + tid]; const float on = dv * (1.f / sqrtf(var + LN_EPS)) * gn;
        const float gate = kind ? sigmoidf_(bf2f(Z[(size_t)row * NZ + ZMO + h * 256 + tid])) : siluf_(bf2f(Z[(size_t)row * NZ + ZG + h * 256 + tid]));
        if (USE_MX) { const float vq = fminf(fmaxf(on * gate, -448.f), 448.f); (ws + WS_MIX)[(size_t)row * D + (kind ? RW : 0) + h * 256 + tid] = (unsigned char)(__builtin_amdgcn_cvt_pk_fp8_f32(vq, vq, 0, false) & 0xff); }
        else MIX[(size_t)row * D + (kind ? RW : 0) + h * 256 + tid] = (bf16)f2bf(on * gate); }
}
__device__ __forceinline__ void phase_scan(const Args& a, LAS unsigned char* ldsb) {
    unsigned char* ws = a.ws; const int tid = threadIdx.x, gt = blockIdx.x * NTHR + tid, NGT = gridDim.x * NTHR;
    const bf16* UT = (const bf16*)(ws + WS_UT); bf16* ST = (bf16*)(ws + WS_ST); const float* sc = (const float*)(ws + WS_SCAL);
    LAS float* T = (LAS float*)ldsb;
    for (int blk = blockIdx.x; blk < 64 * 16; blk += gridDim.x) { const int kbh = blk >> 4, e0 = ((blk >> 2) & 3) * 64, d0 = (blk & 3) * 64, kind = kbh >> 5, bh = kbh & 31, h = bh & 7;
        const int el = tid >> 3, dch = tid & 7;
        float S[8];
#pragma unroll
        for (int i = 0; i < 8; ++i) S[i] = 0.f;
        float m = 0.f; const float g128 = __expf(128.f * log1pf(-exp2f(-5.f - (float)h)));
        const size_t ub0 = (size_t)kbh * 16 * 65536 + (size_t)(e0 + el) * 256 + d0 + 8 * dch;
        v4u ubv[16];
#pragma unroll
        for (int c = 0; c < 16; ++c) ubv[c] = __builtin_nontemporal_load((const v4u*)(UT + ub0 + (size_t)c * 65536));
#pragma unroll
        for (int c = 0; c < 16; ++c) { const v4u ub = ubv[c];
            v4u so; so.x = pk2(S[0], S[1]); so.y = pk2(S[2], S[3]); so.z = pk2(S[4], S[5]); so.w = pk2(S[6], S[7]);
            *(v4u*)(ST + ub0 + (size_t)c * 65536) = so;
            float dec = g128, scl = 1.f;
            if (kind) { const float amax = sc[bh * 16 + c], bl = sc[512 + bh * 16 + c]; const float mn = bl + fmaxf(m, amax); dec = __expf(bl + m - mn); scl = __expf(bl + amax - mn); m = mn; }
#pragma unroll
            for (int i = 0; i < 4; ++i) { S[2 * i] = dec * S[2 * i] + scl * bf2f(ub[i] & 0xffffu); S[2 * i + 1] = dec * S[2 * i + 1] + scl * bf2f(ub[i] >> 16); } }
        __syncthreads();
#pragma unroll
        for (int i = 0; i < 8; ++i) T[el * 65 + 8 * dch + i] = S[i];
        __syncthreads();
        { const int dl = tid >> 3, ech = tid & 7; float* So = a.out + (kind ? O_CP : O_RETP) + (size_t)bh * 65536 + (size_t)(d0 + dl) * 256 + e0 + 8 * ech;
          f32x4 o0, o1;
#pragma unroll
          for (int i = 0; i < 4; ++i) { o0[i] = T[(8 * ech + i) * 65 + dl]; o1[i] = T[(8 * ech + 4 + i) * 65 + dl]; }
          *(f32x4*)So = o0; *(f32x4*)(So + 4) = o1; }
    }
    const float* NLOC = (const float*)(ws + WS_NLOC); float* NST = (float*)(ws + WS_NST); float* scw = (float*)(ws + WS_SCAL);
    for (int it = gt; it < 32 * 256; it += NGT) { const int bh = it >> 8, d = it & 255; float n = 0.f, m = 0.f;
        for (int c = 0; c < 16; ++c) { NST[(size_t)(bh * 16 + c) * 256 + d] = n; if (d == 0) scw[1024 + bh * 16 + c] = m;
            const float amax = sc[bh * 16 + c], bl = sc[512 + bh * 16 + c]; const float mn = bl + fmaxf(m, amax);
            n = __expf(bl + m - mn) * n + __expf(bl + amax - mn) * NLOC[(size_t)(bh * 16 + c) * 256 + d]; m = mn; }
        (a.out + O_NP)[(size_t)bh * 256 + d] = n; if (d == 0) (a.out + O_MP)[bh] = m; }
}
__device__ __forceinline__ void m3_unit(const Args& a, LAS unsigned char* ldsb, int kind, int bh, int c) {
    unsigned char* ws = a.ws; const int tid = threadIdx.x, lane = tid & 63, w = tid >> 6, r = lane & 31, hh = lane >> 5;
    const int b = bh >> 3, h = bh & 7, row0 = b * SEQ + c * 128, unit = (kind * 32 + bh) * 16 + c;
    LAS bf16* Ql = (LAS bf16*)ldsb; LAS bf16* Kl = Ql + 128 * QL_P; LAS bf16* VT = Kl;
    LAS float* aj = (LAS float*)(ldsb + M3_SMALL); LAS float* btv = aj + 128; LAS float* cmx = btv + 128; LAS float* nv = cmx + 128  ; LAS float* st = nv + 256  ;
    const bf16* Z = (const bf16*)(ws + WS_Z); const bf16* MQK = (const bf16*)(ws + WS_MQK);
    const bf16* Qsrc = kind ? MQK + (size_t)row0 * 4096 + h * 256 : Z + (size_t)row0 * NZ + ZQ + h * 256;
    const bf16* Ksrc = kind ? MQK + (size_t)row0 * 4096 + 2048 + h * 256 : Z + (size_t)row0 * NZ + ZK + h * 256; const int qst = kind ? 4096 : NZ;
    const bf16* Vsrc = Z + (size_t)row0 * NZ + (kind ? ZMV : ZV) + h * 256;
    const float l2g = log2f(1.f - exp2f(-5.f - (float)h));
    __syncthreads();
    float mc = 0.f;
    if (kind) { mc = ((const float*)(ws + WS_SCAL))[1024 + bh * 16 + c];
        if (w == 0) { float amax, bl; gate_scan((const float*)(ws + WS_G), a.in[I_BG], row0, h, lane, aj, btv, cmx, amax, bl); }
        if (tid >= 256) nv[tid - 256] = ((const float*)(ws + WS_NST))[(size_t)(bh * 16 + c) * 256 + tid - 256]; }
#pragma unroll 2
    for (int idx = tid; idx < 128 * 32; idx += NTHR) { const int i = idx >> 5, p = idx & 31;
        if (kFuseConv && kind != 0) { float qf[8], kf[8]; conv8_prompt(a, Z, row0 + i, c * 128 + i, h * 256 + p * 8, qf); conv8_prompt(a, Z, row0 + i, c * 128 + i, 2048 + h * 256 + p * 8, kf);
            v4u qo, ko;
#pragma unroll
            for (int k = 0; k < 4; ++k) { qo[k] = pk2(qf[2 * k], qf[2 * k + 1]); ko[k] = pk2(kf[2 * k], kf[2 * k + 1]); }
            *(LAS v4u*)(Ql + i * QL_P + p * 8) = qo; *(LAS v4u*)(Kl + i * QL_P + p * 8) = ko; }
        else { *(LAS v4u*)(Ql + i * QL_P + p * 8) = *(const v4u*)(Qsrc + (size_t)i * qst + p * 8); *(LAS v4u*)(Kl + i * QL_P + p * 8) = *(const v4u*)(Ksrc + (size_t)i * qst + p * 8); } }
    __syncthreads();
    int hq = 4 * hh; asm volatile("" : "+v"(hq));
    const int it = w & 3, eh = w >> 2, il = 32 * it + r;
    float Mi = 0.f, rs;
    if (kind) { Mi = fmaxf(mc, cmx[il]); rs = __expf(mc - Mi); } else rs = exp2f((float)(il + 1) * l2g);
    bf16x8 xb[4][2]; float rowsum = 0.f;
#pragma unroll
    for (int jt = 0; jt < 4; ++jt) {
        if (jt <= it) {
            f32x16 x;
#pragma unroll
            for (int q = 0; q < 16; ++q) x[q] = 0.f;
#pragma unroll 4
            for (int ks = 0; ks < 16; ++ks) { const bf16x8 af = *(const LAS bf16x8*)(Kl + (32 * jt + r) * QL_P + ks * 16 + 8 * hh); const bf16x8 bq = *(const LAS bf16x8*)(Ql + il * QL_P + ks * 16 + 8 * hh); x = MFMA32(af, bq, x); }
            float xw[16];
#pragma unroll
            for (int q = 0; q < 16; ++q) { const int j = 32 * jt + (q & 3) + 8 * (q >> 2) + hq;
                float wgt; if (kind) wgt = __expf(aj[j] - Mi); else wgt = exp2f((float)(il - j) * l2g);
                xw[q] = (j <= il) ? x[q] * wgt : 0.f; rowsum += xw[q]; }
#pragma unroll
            for (int s = 0; s < 2; ++s) { v4u pk; pk.x = pk2(xw[8 * s + 0], xw[8 * s + 1]); pk.y = pk2(xw[8 * s + 2], xw[8 * s + 3]); pk.z = pk2(xw[8 * s + 4], xw[8 * s + 5]); pk.w = pk2(xw[8 * s + 6], xw[8 * s + 7]);
                xb[jt][s] = __builtin_bit_cast(bf16x8, pk); }
        } else { const v4u z = {0u, 0u, 0u, 0u}; xb[jt][0] = __builtin_bit_cast(bf16x8, z); xb[jt][1] = __builtin_bit_cast(bf16x8, z); }
    }
    float qn = 0.f;
    if (kind) { const LAS bf16* qr = Ql + il * QL_P + hh * 128;
        for (int d = 0; d < 128; d += 8) { const v4u qq = *(const LAS v4u*)(qr + d); const LAS float* np = nv + hh * 128 + d;
            qn += bf2f(qq.x & 0xffffu) * np[0] + bf2f(qq.x >> 16) * np[1] + bf2f(qq.y & 0xffffu) * np[2] + bf2f(qq.y >> 16) * np[3] + bf2f(qq.z & 0xffffu) * np[4] + bf2f(qq.z >> 16) * np[5] + bf2f(qq.w & 0xffffu) * np[6] + bf2f(qq.w >> 16) * np[7]; }
        qn += __shfl_xor(qn, 32); rowsum += __shfl_xor(rowsum, 32); }
    f32x16 acc[4];
#pragma unroll
    for (int et = 0; et < 4; ++et)
#pragma unroll
        for (int q = 0; q < 16; ++q) acc[et][q] = 0.f;
    const bf16* STu = (const bf16*)(ws + WS_ST) + (size_t)unit * 65536;
    LAS bf16* SL = Kl;
#pragma unroll 1
    for (int ch = 0; ch < 2; ++ch) {
        __syncthreads();
        { v4u sv[8];
#pragma unroll
          for (int k = 0; k < 8; ++k) { const int idx = tid + k * NTHR, e = idx >> 4, p = idx & 15; sv[k] = *(const v4u*)(STu + (size_t)e * 256 + ch * 128 + p * 8); }
#pragma unroll
          for (int k = 0; k < 8; ++k) { const int idx = tid + k * NTHR, e = idx >> 4, p = idx & 15; *(LAS v4u*)(SL + e * ST_P + p * 8) = sv[k]; } }
        __syncthreads();
#pragma unroll 2
        for (int ks = 0; ks < 8; ++ks) { const bf16x8 bq = *(const LAS bf16x8*)(Ql + il * QL_P + (ch * 8 + ks) * 16 + 8 * hh);
#pragma unroll
            for (int et = 0; et < 4; ++et) { const bf16x8 af = *(const LAS bf16x8*)(SL + (128 * eh + 32 * et + r) * ST_P + ks * 16 + 8 * hh); acc[et] = MFMA32(af, bq, acc[et]); } }
    }
    __syncthreads();
    { v4u vq[8];
#pragma unroll
      for (int k = 0; k < 8; ++k) { const int idx = tid + k * NTHR, j = idx & 127, dg = idx >> 7; vq[k] = *(const v4u*)(Vsrc + (size_t)j * NZ + dg * 8); }
#pragma unroll
      for (int k = 0; k < 8; ++k) { const int idx = tid + k * NTHR, j = idx & 127, dg = idx >> 7; const v4u vv = vq[k];
#pragma unroll
        for (int i = 0; i < 4; ++i) { VT[(dg * 8 + 2 * i) * VT_P + j] = (bf16)(vv[i] & 0xffffu); VT[(dg * 8 + 2 * i + 1) * VT_P + j] = (bf16)(vv[i] >> 16); } } }
    __syncthreads();
#pragma unroll
    for (int et = 0; et < 4; ++et)
#pragma unroll
        for (int q = 0; q < 16; ++q) acc[et][q] *= rs;
#pragma unroll
    for (int jt = 0; jt < 4; ++jt) {
        if (jt <= it) {
#pragma unroll
            for (int s = 0; s < 2; ++s)
#pragma unroll
                for (int et = 0; et < 4; ++et) { const LAS bf16* vp = VT + (128 * eh + 32 * et + r) * VT_P + 32 * jt + 16 * s + 4 * hh;
                    const unsigned long long lo = *(const LAS unsigned long long*)vp, hi = *(const LAS unsigned long long*)(vp + 8);
                    v4u av; av.x = (unsigned)lo; av.y = (unsigned)(lo >> 32); av.z = (unsigned)hi; av.w = (unsigned)(hi >> 32);
                    acc[et] = MFMA32(__builtin_bit_cast(bf16x8, av), xb[jt][s], acc[et]); }
        }
    }
    float hdiv = 1.f;
    if (kind) { const float den = rowsum + rs * qn; hdiv = 1.f / fmaxf(fabsf(den), __expf(-(btv[il] + Mi))); }
    float s1 = 0.f, s2 = 0.f;
#pragma unroll
    for (int et = 0; et < 4; ++et)
#pragma unroll
        for (int q = 0; q < 16; ++q) { const float v = acc[et][q] * hdiv; acc[et][q] = v; s1 += v; s2 += v * v; }
    s1 += __shfl_xor(s1, 32); s2 += __shfl_xor(s2, 32);
    if (hh == 0) { st[(w * 32 + r) * 2] = s1; st[(w * 32 + r) * 2 + 1] = s2; }
    __syncthreads();
    { const int pw = w ^ 4; s1 += st[(pw * 32 + r) * 2]; s2 += st[(pw * 32 + r) * 2 + 1]; }
    const float mu = s1 * (1.f / 256.f); const float var = fmaxf(s2 * (1.f / 256.f) - mu * mu, 0.f); const float rstd = 1.f / sqrtf(var + LN_EPS);
    LAS bf16* OL = (LAS bf16*)ldsb;
#pragma unroll
    for (int et = 0; et < 4; ++et)
#pragma unroll
        for (int rq = 0; rq < 4; ++rq) { const int e = 128 * eh + 32 * et + 8 * rq + 4 * hh;
            *(LAS unsigned long long*)(OL + il * QL_P + e) = (unsigned long long)pk2((acc[et][4 * rq] - mu) * rstd, (acc[et][4 * rq + 1] - mu) * rstd) | ((unsigned long long)pk2((acc[et][4 * rq + 2] - mu) * rstd, (acc[et][4 * rq + 3] - mu) * rstd) << 32); }
    __syncthreads();
    const float* gn = (kind ? a.in[I_GMN] : a.in[I_GRN]) + h * 256;
#pragma unroll 4
    for (int idx = tid; idx < 128 * 32; idx += NTHR) { const int i = idx >> 5, p = idx & 31; const int row = row0 + i;
        const v4u ov = *(const LAS v4u*)(OL + i * QL_P + p * 8); const v4u gz = *(const v4u*)(Z + (size_t)row * NZ + (kind ? ZMO : ZG) + h * 256 + p * 8);
        const f32x4 g0 = *(const f32x4*)(gn + p * 8), g1 = *(const f32x4*)(gn + p * 8 + 4); const float gg[8] = {g0.x, g0.y, g0.z, g0.w, g1.x, g1.y, g1.z, g1.w};
        float of[8];
#pragma unroll
        for (int k = 0; k < 4; ++k) { const float x0 = bf2f(ov[k] & 0xffffu), x1 = bf2f(ov[k] >> 16), z0 = bf2f(gz[k] & 0xffffu), z1 = bf2f(gz[k] >> 16);
            const float a0 = kind ? sigmoidf_(z0) : siluf_(z0), a1 = kind ? sigmoidf_(z1) : siluf_(z1);
            of[2 * k] = x0 * gg[2 * k] * a0; of[2 * k + 1] = x1 * gg[2 * k + 1] * a1; }
        if (USE_MX) *(unsigned long long*)(ws + WS_MIX + (size_t)row * D + (kind ? RW : 0) + h * 256 + p * 8) = (unsigned long long)pack4_fp8(of[0], of[1], of[2], of[3]) | ((unsigned long long)pack4_fp8(of[4], of[5], of[6], of[7]) << 32);
        else { v4u out; out.x = pk2(of[0], of[1]); out.y = pk2(of[2], of[3]); out.z = pk2(of[4], of[5]); out.w = pk2(of[6], of[7]);
            *(v4u*)((bf16*)(ws + WS_MIX) + (size_t)row * D + (kind ? RW : 0) + h * 256 + p * 8) = out; } }
}
__device__ __forceinline__ void conv_state_outputs(const Args& a) {
    unsigned char* ws = a.ws; const int gt = blockIdx.x * NTHR + threadIdx.x, NGT = gridDim.x * NTHR; const bf16* Z = (const bf16*)(ws + WS_Z); const float* sconv = a.in[I_SCONV];
    float* convp = a.out + O_CONVP; float* convs = a.out + O_CONVS;
    for (int j = gt; j < NPB * 3 * 1024; j += NGT) { const int b = j / (3 * 1024), q = (j >> 10) % 3, c = (j & 1023) * 4; const unsigned long long z = *(const unsigned long long*)(Z + (size_t)(b * SEQ + SEQ - 3 + q) * NZ + ZMQK + c);
        *(f32x4*)(convp + (size_t)j * 4) = (f32x4){bf2f((unsigned)z & 0xffffu), bf2f(((unsigned)z) >> 16), bf2f((unsigned)(z >> 32) & 0xffffu), bf2f((unsigned)(z >> 48))}; }
    for (int j = gt; j < NS * 3 * 1024; j += NGT) { const int b = j / (3 * 1024), q = (j >> 10) % 3, c = (j & 1023) * 4; f32x4 o;
        if (q < 2) o = *(const f32x4*)(sconv + ((size_t)b * 3 + q + 1) * 4096 + c);
        else { const unsigned long long z = *(const unsigned long long*)(Z + (size_t)(NP + b) * NZ + ZMQK + c); o = (f32x4){bf2f((unsigned)z & 0xffffu), bf2f(((unsigned)z) >> 16), bf2f((unsigned)(z >> 32) & 0xffffu), bf2f((unsigned)(z >> 48))}; }
        *(f32x4*)(convs + (size_t)j * 4) = o; }
}
__device__ __forceinline__ void phase_m1_sample(const Args& a, LAS unsigned char* lds) {
    if (FUSE_CONV) conv_state_outputs(a);
    const int nb = gridDim.x, bx = blockIdx.x;
    for (int pass = 0; pass < 2; ++pass) {
        const bool do_m1 = (pass == 0);
        if (do_m1) { for (int u = bx; u < 1024; u += nb) { const int kind = u >> 9, bh = (u >> 4) & 31, c = u & 15; m1_unit(a, lds, kind, bh, c); } }
        else { for (int u = bx; u < 1024; u += nb) { sample_unit(a, lds, 0, u); } }
        __syncthreads();
    }
}
__device__ __forceinline__ void phase_m3(const Args& a, LAS unsigned char* lds) {
    const int nb = gridDim.x, bx = blockIdx.x;
    for (int pass = 0; pass < 2; ++pass) {
        const bool do_m3 = (pass == 0);
        if (do_m3) { for (int u = bx; u < 1024; u += nb) { const int kind = u >> 9, bh = (u >> 4) & 31, c = u & 15; m3_unit(a, lds, kind, bh, c); } }
        else { for (int u = bx; u < 1024; u += nb) { sample_unit(a, lds, 1, u); } }
        __syncthreads();
    }
}

struct EpiY1 { float* Y1; const bf16* XN; __device__ __forceinline__ void operator()(int m, int n, float v) const { Y1[(size_t)m * D + n] = ALPHA * bf2f(XN[(size_t)m * D + n]) + v; } };
struct EpiF32 { float* C; int ldc; __device__ __forceinline__ void operator()(int m, int n, float v) const { C[(size_t)m * ldc + n] = v; } };
__device__ __forceinline__ void phase_gemm2(const Args& a, LAS unsigned char* lds) {
    unsigned char* ws = a.ws;
#if USE_MFMA
#if USE_MX
    { pg8::Gemm g{(const bf16*)(ws + WS_MIX), (const bf16*)(ws + WS_WOUT), MP, D, D / 2, WO8_E8M0}; pg8::TailOrder S; S.init(NP, D, (int)gridDim.x, (int)blockIdx.x);
      pg8::EpiY1m E{(bf16*)(ws + WS_Y1), (const bf16*)(ws + WS_XN)};
      pg8::gemm_phase<pg8::EpiY1m, pg8::TailOrder, true, true, true>(lds, g, S, E); }
#else
    { pg8::Gemm g{(const bf16*)(ws + WS_MIX), (const bf16*)(ws + WS_WOUT), MP, D, D}; pg8::TailOrder S; S.init(NP, D, (int)gridDim.x, (int)blockIdx.x);
      pg8::EpiY1m E{(bf16*)(ws + WS_Y1), (const bf16*)(ws + WS_XN)};
      pg8::gemm_phase<pg8::EpiY1m, pg8::TailOrder, true, true>(lds, g, S, E); }
#endif
    { int rank, cnt; idle_rank((MP / 256) * (D / 256), rank, cnt);
      if (rank >= 0) { bg_transposes(a, lds, BG_TS, BG_T2, rank * NWAVES + (int)(threadIdx.x >> 6), cnt * NWAVES); __syncthreads();
          pg8::Gemm g{(const bf16*)(ws + WS_P16), (const bf16*)(ws + WS_WP), MP, D, PLE_D}; pg8::StaticOrder S; S.init(MP, D, cnt, rank);
          pg8::EpiB16n E{(bf16*)(ws + WS_PLE), D};
          pg8::gemm_phase<pg8::EpiB16n, pg8::StaticOrder, true, true>(lds, g, S, E);
          if (!USE_MX) bg_tables(a, 0, NEXP / 2, rank * NWAVES + (int)(threadIdx.x >> 6), cnt * NWAVES); } }
#else
    EpiY1 e{(float*)(ws + WS_Y1), (const bf16*)(ws + WS_XN)};
    slow_gemm(lds, (const bf16*)(ws + WS_MIX), (const bf16*)(ws + WS_WOUT), MP, D, D, e);
    EpiF32 e2{(float*)(ws + WS_PLE), D};
    slow_gemm(lds, (const bf16*)(ws + WS_P16), (const bf16*)(ws + WS_WP), MP, D, PLE_D, e2);
#endif
}
__device__ __forceinline__ void phase_ln1(const Args& a) {
    unsigned char* ws = a.ws; const int lane = threadIdx.x & 63, wave = threadIdx.x >> 6, gw = blockIdx.x * NWAVES + wave, NGW = gridDim.x * NWAVES;
#if USE_MFMA
    for (int m = gw; m < MP; m += NGW) ln_row_bf16<true>((const bf16*)(ws + WS_Y1) + (size_t)m * D, a.in[I_LN1G], a.in[I_LN1B], (bf16*)(ws + WS_X1) + (size_t)m * D, lane, (bf16*)(ws + WS_X1S), m, USE_MX ? ws + WS_X18 + (size_t)m * D : nullptr);
#else
    for (int m = gw; m < MP; m += NGW) ln_row_bf16<false>((const float*)(ws + WS_Y1) + (size_t)m * D, a.in[I_LN1G], a.in[I_LN1B], (bf16*)(ws + WS_X1) + (size_t)m * D, lane, (bf16*)(ws + WS_X1S), m);
#endif
}
struct EpiGate { float* PLE; __device__ __forceinline__ void operator()(int m, int n, float v) const { const size_t i = (size_t)m * D + n; PLE[i] = sigmoidf_(v) * PLE[i]; } };
__device__ __forceinline__ void phase_route_fast(const Args& a, int mode, int crank);
__device__ __forceinline__ void phase_gemm3(const Args& a, LAS unsigned char* lds) {
    unsigned char* ws = a.ws;
#if USE_MFMA
#if USE_MX
    { const int G = (int)gridDim.x, b = (int)blockIdx.x, nqt = NQ / 256, wv = (int)(threadIdx.x >> 6);
      int qs, qst, qn, gs, gst, gn, c_lo = 0, c_hi = 0, c_w = 0, c_nw = 1; bool conv_first = false;
      constexpr int R1 = 11264;
      if (G == 256) { const int x = b & 7, j = b >> 3;
          if (j < 4)       { qs = 0; qst = 1; qn = 0; gs = 0; gst = 1; gn = 0; c_lo = 0; c_hi = R1; c_w = (x * 4 + j) * NWAVES + wv; c_nw = 32 * NWAVES; conv_first = true; }
          else if (j < 8)  { qs = 8 * (j - 4) + x; qst = 32; qn = 2; gs = 8 * (j - 4) + x; gst = 96; gn = 1; }
          else if (j < 20) { qs = 8 * j + x; qst = 96; qn = 1; gs = 8 * (j - 4) + x; gst = 96; gn = 3; }
          else             { qs = 8 * j + x; qst = 80; qn = (j == 22) ? 2 : 1; gs = 8 * (20 + j) + x; gst = 96; gn = (j < 22) ? 3 : 2;
                             if (j >= 23) { c_lo = R1; c_hi = NEXP; c_w = (x * 9 + (j - 23)) * NWAVES + wv; c_nw = 72 * NWAVES; } } }
      else { const int cq = (b + nqt) % G, nqu = (NP / 256 + 1) * nqt, ngu = (NP / 256 + 1) * (D / 256);
          qs = cq; qst = G; qn = (cq < nqu) ? (nqu - cq + G - 1) / G : 0; gs = b; gst = G; gn = (b < ngu) ? (ngu - b + G - 1) / G : 0;
          c_lo = 0; c_hi = NEXP; c_w = b * NWAVES + wv; c_nw = G * NWAVES; }
      unsigned* qs_done = (unsigned*)(ws + WS_CTL) + CW_QS;
      if (conv_first) { bg_tables(a, c_lo, c_hi, c_w, c_nw);
#if USE_ROUTE_FAST
          if (wv == 0) { unsigned sp = 0; while (xb_ld(qs_done) < 8u) { __builtin_amdgcn_s_sleep(8); if (++sp > (1u << 22)) break; } __builtin_amdgcn_fence(__ATOMIC_ACQUIRE, "agent"); asm volatile("s_waitcnt vmcnt(0)" ::: "memory"); }
          phase_route_fast(a, 1, (b & 7) * 4 + (b >> 3));
#endif
      }
      { pg8::Gemm g{(const bf16*)(ws + WS_X1), (const bf16*)(ws + WS_W3), MP, NQ, D}; pg8::SpanOrder S; S.init(NP, NQ, qs, qst, qn);
        pg8::EpiQGate E{(float*)(ws + WS_QP), (float*)(ws + WS_PLE), (float*)(ws + WS_PLE2), nqt};
        pg8::gemm_phase<pg8::EpiQGate, pg8::SpanOrder, true, true>(lds, g, S, E); }
      if (G == 256 && (b >> 3) == 22) { asm volatile("s_waitcnt vmcnt(0)" ::: "memory"); __syncthreads();
          if (threadIdx.x == 0) { __builtin_amdgcn_fence(__ATOMIC_RELEASE, "agent"); asm volatile("s_waitcnt vmcnt(0)" ::: "memory"); (void)xb_add(qs_done, 1u); } }
      { pg8::Gemm g{(const bf16*)(ws + WS_X18), (const bf16*)(ws + WS_W3 + (size_t)NQ * D * 2), MP, D, D / 2, WG8_E8M0}; pg8::SpanOrder S; S.init(NP, D, gs, gst, gn);
        pg8::EpiQGate E{(float*)(ws + WS_QP), (float*)(ws + WS_PLE), (float*)(ws + WS_PLE2), 0};
        pg8::gemm_phase<pg8::EpiQGate, pg8::SpanOrder, true, true, true>(lds, g, S, E); }
      if (!conv_first && c_hi > c_lo) bg_tables(a, c_lo, c_hi, c_w, c_nw); }
    { int rank = -1, cnt = 1;
#else
    { pg8::Gemm g{(const bf16*)(ws + WS_X1), (const bf16*)(ws + WS_W3), MP, NQ + D, D}; pg8::TailOrder S; S.init(NP, NQ + D, (int)gridDim.x, (int)blockIdx.x);
      pg8::EpiQGate E{(float*)(ws + WS_QP), (float*)(ws + WS_PLE), (float*)(ws + WS_PLE2), NQ / 256};
      pg8::gemm_phase<pg8::EpiQGate, pg8::TailOrder, true, true>(lds, g, S, E); }
    { int rank, cnt; idle_rank((MP / 256) * ((NQ + D) / 256), rank, cnt);
#endif
      if (rank >= 0) bg_tables(a, NEXP / 2, NEXP, rank * NWAVES + (int)(threadIdx.x >> 6), cnt * NWAVES); }
#else
    EpiF32 e{(float*)(ws + WS_QP), NQ};
    slow_gemm(lds, (const bf16*)(ws + WS_X1), (const bf16*)(ws + WS_W3), MP, NQ, D, e);
    EpiGate e2{(float*)(ws + WS_PLE)};
    slow_gemm(lds, (const bf16*)(ws + WS_X1), (const bf16*)(ws + WS_W3) + (size_t)NQ * D, MP, D, D, e2);
#endif
}
__device__ __forceinline__ void wave_argmax(float& v, int& i) {
#pragma unroll
    for (int o = 1; o < 64; o <<= 1) { const float ov = __shfl_xor(v, o); const int oi = __shfl_xor(i, o); if (ov > v || (ov == v && oi < i)) { v = ov; i = oi; } }
}
__device__ __forceinline__ void phase_route(const Args& a) {
    unsigned char* ws = a.ws; const int lane = threadIdx.x & 63, wave = threadIdx.x >> 6, gw = blockIdx.x * NWAVES + wave, NGW = gridDim.x * NWAVES;
    const float* QP = (const float*)(ws + WS_QP); const float* SK = a.in[I_SUBK]; int* EIDX = (int*)(ws + WS_EIDX); float* GW = (float*)(ws + WS_GW);
    const float NEG = -3.0e38f;
    for (int u = gw; u < M * H; u += NGW) {
        const int t = u >> 3, h = u & 7;
        const float* q = QP + (size_t)t * NQ + h * 256;
        float svp[2]; int sip[2];
#pragma unroll
        for (int p = 0; p < 2; ++p) {
            const float* k0 = SK + ((size_t)(h * 2 + p) * 128 + lane) * 128; const float* k1 = k0 + 64 * 128; const float* qp = q + p * 128;
            float s0 = 0.f, s1 = 0.f;
            for (int d = 0; d < 128; d += 4) { const f32x4 qv = *(const f32x4*)(qp + d), a0 = *(const f32x4*)(k0 + d), a1 = *(const f32x4*)(k1 + d);
                s0 += qv.x * a0.x + qv.y * a0.y + qv.z * a0.z + qv.w * a0.w; s1 += qv.x * a1.x + qv.y * a1.y + qv.z * a1.z + qv.w * a1.w; }
            float myv = NEG; int myi = 0;
            for (int r = 0; r < TOPK; ++r) {
                float v = (s0 >= s1) ? s0 : s1; int i = (s0 >= s1) ? lane : lane + 64;
                wave_argmax(v, i);
                if (i == lane) s0 = NEG; if (i == lane + 64) s1 = NEG;
                if (lane == r) { myv = v; myi = i; }
            }
            svp[p] = myv; sip[p] = myi;
        }
        float cand[4];
#pragma unroll
        for (int c = 0; c < 4; ++c) { const int f = 4 * lane + c; cand[c] = __shfl(svp[0], f >> 4) + __shfl(svp[1], f & 15); }
        float tv = NEG; int tf = 0;
        for (int r = 0; r < TOPK; ++r) {
            float v = cand[0]; int i = 4 * lane;
#pragma unroll
            for (int c = 1; c < 4; ++c) if (cand[c] > v) { v = cand[c]; i = 4 * lane + c; }
            wave_argmax(v, i);
#pragma unroll
            for (int c = 0; c < 4; ++c) if (i == 4 * lane + c) cand[c] = NEG;
            if (lane == r) { tv = v; tf = i; }
        }
        const int e0 = __shfl(sip[0], tf >> 4), e1 = __shfl(sip[1], tf & 15);
        const float vmax = __shfl(tv, 0);
        float ex = (lane < TOPK) ? __expf(tv - vmax) : 0.f;
        const float den = wave_sum(ex);
        if (lane < TOPK) { EIDX[(size_t)t * NSLOT + h * TOPK + lane] = e0 * 128 + e1; GW[(size_t)t * NSLOT + h * TOPK + lane] = ex / den; }
    }
}
__device__ __forceinline__ int f2key(float x) { const int b = __float_as_int(x); return b ^ ((b >> 31) & 0x7fffffff); }
__device__ __forceinline__ float key2f(int k) { return __int_as_float(k ^ ((k >> 31) & 0x7fffffff)); }
constexpr int IMIN = -2147483647 - 1;

template <int N> __device__ __forceinline__ void bitonic_sort_desc(int* x) {
#pragma unroll
    for (int k = 2; k <= N; k <<= 1)
#pragma unroll
        for (int j = k >> 1; j > 0; j >>= 1)
#pragma unroll
            for (int i = 0; i < N; ++i) { const int l = i ^ j; if (l > i) { const bool desc = ((i & k) == 0); const int a = x[i], b = x[l]; const int hi = max(a, b), lo = min(a, b); x[i] = desc ? hi : lo; x[l] = desc ? lo : hi; } }
}
__device__ __forceinline__ void bitonic_clean_desc16(int* x) {
#pragma unroll
    for (int j = 8; j > 0; j >>= 1)
#pragma unroll
        for (int i = 0; i < 16; ++i) if ((i & j) == 0) { const int a = x[i], b = x[i + j]; x[i] = max(a, b); x[i + j] = min(a, b); }
}
__device__ __forceinline__ void merge_top16(int* a, const int* b) {
#pragma unroll
    for (int i = 0; i < 16; ++i) a[i] = max(a[i], b[15 - i]);
    bitonic_clean_desc16(a);
}
__device__ __forceinline__ void top16_of64(int* kk, int* out) {
    bitonic_sort_desc<16>(kk); bitonic_sort_desc<16>(kk + 16); bitonic_sort_desc<16>(kk + 32); bitonic_sort_desc<16>(kk + 48);
    merge_top16(kk, kk + 16); merge_top16(kk + 32, kk + 48); merge_top16(kk, kk + 32);
#pragma unroll
    for (int i = 0; i < 16; ++i) out[i] = kk[i];
}

template <int N> __device__ __forceinline__ int tree_max(const int (&v)[N]) {
    int t[N];
#pragma unroll
    for (int i = 0; i < N; ++i) t[i] = v[i];
    int n = N;
#pragma unroll
    for (int lvl = 0; lvl < 8; ++lvl) { if (n > 1) { int o = 0;
#pragma unroll
            for (int i = 0; i < N; i += 3) { if (i < n) { int m = t[i]; if (i + 1 < n) m = max(m, t[i + 1]); if (i + 2 < n) m = max(m, t[i + 2]); t[o] = m; ++o; } }
            n = o; } }
    return t[0];
}
__device__ __forceinline__ void phase_route_fast(const Args& a, int mode, int crank) {
    unsigned char* ws = a.ws; const int lane = threadIdx.x & 63, wave = threadIdx.x >> 6, gw = blockIdx.x * NWAVES + wave, NGW = gridDim.x * NWAVES, r = lane & 31, hh = lane >> 5;
    const bf16* QH = (const bf16*)(ws + WS_QP); const bf16* QL = QH + (size_t)MP * NQ; const bf16* KH = (const bf16*)(ws + WS_KH); const bf16* KL = KH + 16 * 128 * 128;
    int* EIDX = (int*)(ws + WS_EIDX); float* GW = (float*)(ws + WS_GW);
    const int nun = (M / 32) * H, nfull = (nun / NGW) * NGW, nrem = nun - nfull;
    const bool rem_elsewhere = ((int)gridDim.x == 256) && USE_MX;
    for (int k = 0; ; ++k) {
        int u;
        if (mode == 1) { if (k > 0 || wave != 0 || crank >= nrem) break; u = nfull + crank; }
        else if (k * NGW < nfull) u = k * NGW + gw;
        else { if (rem_elsewhere || k * NGW > nfull) break; if (nrem <= (int)gridDim.x) { if (wave != 0 || (int)blockIdx.x >= nrem) break; u = nfull + (int)blockIdx.x; } else { if (gw >= nrem) break; u = nfull + gw; } }
        const int tb = u >> 3, h = u & 7, t0 = tb * 32;
        int sk[2][16];
#pragma unroll
        for (int p = 0; p < 2; ++p) {
            f32x16 acc[4];
#pragma unroll
            for (int tl = 0; tl < 4; ++tl)
#pragma unroll
                for (int q = 0; q < 16; ++q) acc[tl][q] = 0.f;
            const bf16* qh = QH + (size_t)(t0 + r) * NQ + h * 256 + p * 128 + 8 * hh; const bf16* ql = QL + (size_t)(t0 + r) * NQ + h * 256 + p * 128 + 8 * hh;
            const bf16* kh = KH + ((size_t)(h * 2 + p) * 128 + r) * 128 + 8 * hh; const bf16* kl = KL + ((size_t)(h * 2 + p) * 128 + r) * 128 + 8 * hh;
#pragma unroll 2
            for (int ks = 0; ks < 8; ++ks) { const bf16x8 bh = *(const bf16x8*)(qh + ks * 16), bl = *(const bf16x8*)(ql + ks * 16);
#pragma unroll
                for (int tl = 0; tl < 4; ++tl) { const bf16x8 ah = *(const bf16x8*)(kh + (size_t)tl * 32 * 128 + ks * 16), al = *(const bf16x8*)(kl + (size_t)tl * 32 * 128 + ks * 16);
                    acc[tl] = MFMA32(ah, bh, acc[tl]); acc[tl] = MFMA32(ah, bl, acc[tl]); acc[tl] = MFMA32(al, bh, acc[tl]); } }
            int kk[64];
#pragma unroll
            for (int tl = 0; tl < 4; ++tl)
#pragma unroll
                for (int q = 0; q < 16; ++q) { const int kidx = 32 * tl + (q & 3) + 8 * (q >> 2) + 4 * hh; kk[tl * 16 + q] = (f2key(acc[tl][q]) & ~127) | (127 - kidx); }
            int x[16];
            top16_of64(kk, x);
            { int o[16];
#pragma unroll
              for (int i = 0; i < 16; ++i) o[i] = __shfl_xor(x[i], 32);
              merge_top16(x, o); }
#pragma unroll
            for (int i = 0; i < 16; ++i) sk[p][i] = x[i];
        }
        float v0[16], v1[16];
#pragma unroll
        for (int i = 0; i < 16; ++i) { v0[i] = key2f(sk[0][i]); v1[i] = key2f(sk[1][i]); }
        int ck[64]; int nc = 0;
#pragma unroll
        for (int i = 0; i < 16; ++i)
#pragma unroll
            for (int j = 0; j < 16; ++j) if ((i + 1) * (j + 1) <= 16) { ck[nc] = (f2key(v0[i] + v1[j]) & ~255) | (255 - (16 * i + j)); ++nc; }
#pragma unroll
        for (int i = 50; i < 64; ++i) ck[i] = IMIN;
        int win[16];
        top16_of64(ck, win);
        const float vmax = key2f(win[0]); float den = 0.f;
#pragma unroll
        for (int i = 0; i < 16; ++i) den += __expf(key2f(win[i]) - vmax);
        const float rden = 1.f / den;
        int eo[8]; float go[8];
#pragma unroll
        for (int k = 0; k < 8; ++k) { const int m = win[k] ^ ((win[k] ^ win[8 + k]) & (-hh)); const int f = 255 - (m & 255), ci = f >> 4, cj = f & 15; int e0 = 0, e1 = 0;
#pragma unroll
            for (int i = 0; i < 16; ++i) { e0 = (ci == i) ? (127 - (sk[0][i] & 127)) : e0; e1 = (cj == i) ? (127 - (sk[1][i] & 127)) : e1; }
            eo[k] = e0 * 128 + e1; go[k] = __expf(key2f(m) - vmax) * rden; }
        const size_t ob = (size_t)(t0 + r) * NSLOT + h * TOPK + 8 * hh;
        { v4u pe; pe.x = (unsigned)eo[0] | ((unsigned)eo[1] << 16); pe.y = (unsigned)eo[2] | ((unsigned)eo[3] << 16); pe.z = (unsigned)eo[4] | ((unsigned)eo[5] << 16); pe.w = (unsigned)eo[6] | ((unsigned)eo[7] << 16);
          *(v4u*)((unsigned short*)EIDX + ob) = pe; }
        *(f32x4*)(GW + ob) = (f32x4){go[0], go[1], go[2], go[3]}; *(f32x4*)(GW + ob + 4) = (f32x4){go[4], go[5], go[6], go[7]};
    }
}
__device__ __forceinline__ void phase_peer_slow(const Args& a, LAS unsigned char* ldsb) {
    unsigned char* ws = a.ws; const int tid = threadIdx.x, lane = tid & 63, wave = tid >> 6;
    LAS float* xs = (LAS float*)ldsb; LAS float* gk = xs + D; LAS int* ek = (LAS int*)(gk + NSLOT);
    const bf16* X1 = (const bf16*)(ws + WS_X1); const int* EIDX = (const int*)(ws + WS_EIDX); const float* GW = (const float*)(ws + WS_GW);
    const float* U = a.in[I_PU]; const float* V = a.in[I_PV]; float* CH = (float*)(ws + WS_CH);
    for (int t = blockIdx.x; t < M; t += gridDim.x) {
        __syncthreads();
        for (int j = tid; j < D; j += NTHR) xs[j] = bf2f(X1[(size_t)t * D + j]);
        if (tid < NSLOT) ek[tid] = EIDX[(size_t)t * NSLOT + tid];
        __syncthreads();
        for (int kk = 0; kk < 16; ++kk) { const int k = wave * 16 + kk; const float* ur = U + (size_t)ek[k] * D; float s = 0.f;
#pragma unroll 4
            for (int c = 0; c < 16; ++c) { const int idx = c * 256 + lane * 4; const f32x4 uv = *(const f32x4*)(ur + idx); const f32x4 xv = *(const LAS f32x4*)(xs + idx);
                s += uv.x * xv.x + uv.y * xv.y + uv.z * xv.z + uv.w * xv.w; }
            s = wave_sum(s);
            if (lane == 0) gk[k] = gelu_tanh(s) * GW[(size_t)t * NSLOT + k]; }
        __syncthreads();
        f32x4 acc0 = {0.f, 0.f, 0.f, 0.f}, acc1 = {0.f, 0.f, 0.f, 0.f};
        for (int k = 0; k < NSLOT; ++k) { const float g = gk[k]; const float* vr = V + (size_t)ek[k] * D + tid * 8; acc0 += g * *(const f32x4*)vr; acc1 += g * *(const f32x4*)(vr + 4); }
        *(f32x4*)(CH + (size_t)t * D + tid * 8) = acc0; *(f32x4*)(CH + (size_t)t * D + tid * 8 + 4) = acc1;
    }
}
typedef __bf16 bf2_t __attribute__((ext_vector_type(2)));
__device__ __forceinline__ float dot2bf(unsigned x, unsigned y, float c) { return __builtin_amdgcn_fdot2_f32_bf16(__builtin_bit_cast(bf2_t, x), __builtin_bit_cast(bf2_t, y), c, false); }
constexpr int PEER_TL = 260;
__device__ __forceinline__ void phase_peer_u(const Args& a, LAS unsigned char* ldsb) {
    unsigned char* ws = a.ws; const int tid = threadIdx.x, lane = tid & 63, wave = tid >> 6, g = lane >> 3, l8 = lane & 7;
    const int ngrp = (gridDim.x % 8 == 0) ? 8 : 1, xg = blockIdx.x % ngrp, r = blockIdx.x / ngrp, nr = gridDim.x / ngrp;
    LAS float* part = (LAS float*)ldsb;
    const unsigned char* Ub = ws + WS_UB; const bf16* X1s = (const bf16*)(ws + WS_X1S); const int* EIDX = (const int*)(ws + WS_EIDX); float* PA = (float*)(ws + WS_PA);
    const int ntl = (M - r + nr - 1) / nr;
    typedef float f32x2 __attribute__((ext_vector_type(2)));
    for (int n0 = 0; n0 < ntl; n0 += PEER_TL) {
        const int nn = (ntl - n0 < PEER_TL) ? (ntl - n0) : PEER_TL;
        __syncthreads();
        for (int i = tid; i < nn * NSLOT; i += NTHR) part[i] = 0.f;
        __syncthreads();
        for (int s = xg; s < 32; s += ngrp) {
            const int sp = (s - xg) / ngrp, npb = (ngrp == 8) ? 4 : 8, per = (NEXP + npb - 1) / npb; const bool cv = (n0 == 0) && (sp < npb);
            const int cv_lo = NEXP + sp * per, cv_hi = (NEXP + (sp + 1) * per < 2 * NEXP) ? NEXP + (sp + 1) * per : 2 * NEXP;
            const int iters = (nn > wave) ? (nn - wave + NWAVES - 1) / NWAVES : 0, n_cv = wave + NWAVES * ((4 * wave < iters) ? 4 * wave : 0);
            if (cv && iters == 0) bg_tables(a, cv_lo, cv_hi, (int)blockIdx.x * NWAVES + wave, (int)gridDim.x * NWAVES);
            const unsigned char* Us = Ub + (size_t)s * NEXP * 128 + l8 * 16; const bf16* Xs = X1s + (size_t)s * MP * 128 + l8 * 16;
            for (int n = wave; n < nn; n += NWAVES) { const int t = r + nr * (n0 + n);
                if (cv && n == n_cv) bg_tables(a, cv_lo, cv_hi, (int)blockIdx.x * NWAVES + wave, (int)gridDim.x * NWAVES);
                const v4u* ip = (const v4u*)((const unsigned short*)EIDX + (size_t)t * NSLOT + g * 16);
                const v4u ia = ip[0], ib = ip[1];
                const int ej[16] = {(int)(ia.x & 0xffffu), (int)(ia.x >> 16), (int)(ia.y & 0xffffu), (int)(ia.y >> 16), (int)(ia.z & 0xffffu), (int)(ia.z >> 16), (int)(ia.w & 0xffffu), (int)(ia.w >> 16),
                                    (int)(ib.x & 0xffffu), (int)(ib.x >> 16), (int)(ib.y & 0xffffu), (int)(ib.y >> 16), (int)(ib.z & 0xffffu), (int)(ib.z >> 16), (int)(ib.w & 0xffffu), (int)(ib.w >> 16)};
                const v4u xa = *(const v4u*)(Xs + (size_t)t * 128), xb = *(const v4u*)(Xs + (size_t)t * 128 + 8);
                v4u ug[16];
#pragma unroll
                for (int j = 0; j < 16; ++j) ug[j] = *(const v4u*)(Us + (size_t)ej[j] * 128);
                f32x2 x2[8];
#pragma unroll
                for (int i = 0; i < 4; ++i) { x2[i] = (f32x2){__uint_as_float(xa[i] << 16), __uint_as_float(xa[i] & 0xffff0000u)}; x2[4 + i] = (f32x2){__uint_as_float(xb[i] << 16), __uint_as_float(xb[i] & 0xffff0000u)}; }
                float acc[16];
#pragma unroll
                for (int j = 0; j < 16; ++j) { const v4u uv = ug[j]; f32x2 s2 = {0.f, 0.f};
#pragma unroll
                    for (int i = 0; i < 4; ++i) { const f32x2 lo = __builtin_amdgcn_cvt_pk_f32_fp8((int)uv[i], false), hi = __builtin_amdgcn_cvt_pk_f32_fp8((int)uv[i], true);
                        s2 = __builtin_elementwise_fma(lo, x2[2 * i], s2); s2 = __builtin_elementwise_fma(hi, x2[2 * i + 1], s2); }
                    acc[j] = s2.x + s2.y; }
                float b8[8], c4[4], d2[2];
#pragma unroll
                for (int i = 0; i < 8; ++i) { const float snd = (l8 & 4) ? acc[i] : acc[i + 8], kp = (l8 & 4) ? acc[i + 8] : acc[i]; b8[i] = kp + __shfl_xor(snd, 4); }
#pragma unroll
                for (int i = 0; i < 4; ++i) { const float snd = (l8 & 2) ? b8[i] : b8[i + 4], kp = (l8 & 2) ? b8[i + 4] : b8[i]; c4[i] = kp + __shfl_xor(snd, 2); }
#pragma unroll
                for (int i = 0; i < 2; ++i) { const float snd = (l8 & 1) ? c4[i] : c4[i + 2], kp = (l8 & 1) ? c4[i + 2] : c4[i]; d2[i] = kp + __shfl_xor(snd, 1); }
                LAS float* pp = part + n * NSLOT + 2 * lane;
                pp[0] += d2[0]; pp[1] += d2[1];
            }
        }
        __syncthreads();
        for (int i = tid; i < nn * NSLOT; i += NTHR) { const int n = i >> 7, q = i & 127; PA[((size_t)xg * M + (r + nr * (n0 + n))) * NSLOT + q] = part[i] * (1.f / U8_SCALE); }
    }
    if (ngrp == 1) {
        for (size_t i = (size_t)blockIdx.x * NTHR + tid; i < (size_t)7 * M * NSLOT; i += (size_t)gridDim.x * NTHR) PA[(size_t)M * NSLOT + i] = 0.f; }
}
__device__ __forceinline__ void phase_peer_v(const Args& a, LAS unsigned char* ldsb) {
    unsigned char* ws = a.ws; const int tid = threadIdx.x, lane = tid & 63, wave = tid >> 6, g = lane >> 3, l8 = lane & 7;
    const int ngrp = (gridDim.x % 8 == 0) ? 8 : 1, xg = blockIdx.x % ngrp, r = blockIdx.x / ngrp, nr = gridDim.x / ngrp;
    LAS float* gk = (LAS float*)ldsb;
    const unsigned char* Vb = ws + WS_VB; const int* EIDX = (const int*)(ws + WS_EIDX); const float* PA = (const float*)(ws + WS_PA); const float* GW = (const float*)(ws + WS_GW);
    bf16* CH = (bf16*)(ws + WS_CH);
    const int ntl = (M - r + nr - 1) / nr;
    for (int n0 = 0; n0 < ntl; n0 += PEER_TL) {
        const int nn = (ntl - n0 < PEER_TL) ? (ntl - n0) : PEER_TL;
        __syncthreads();
        { const int nit = nn * NSLOT;
          for (int i0 = tid; i0 < nit; i0 += NTHR * 8) {
              float pa[8][8], gw[8];
#pragma unroll
              for (int bb = 0; bb < 8; ++bb) { const int i = i0 + bb * NTHR, ii = (i < nit) ? i : 0; const int n = ii >> 7, q = ii & 127; const size_t t = (size_t)(r + nr * (n0 + n));
#pragma unroll
                  for (int x = 0; x < 8; ++x) pa[bb][x] = PA[((size_t)x * M + t) * NSLOT + q];
                  gw[bb] = GW[t * NSLOT + q]; }
#pragma unroll
              for (int bb = 0; bb < 8; ++bb) { const int i = i0 + bb * NTHR; float sm = 0.f;
#pragma unroll
                  for (int x = 0; x < 8; ++x) sm += pa[bb][x];
                  const float u2 = 1.5957691216057308f * (sm + 0.044715f * sm * sm * sm);
                  if (i < nit) gk[i] = sm * __builtin_amdgcn_rcpf(1.f + __expf(-u2)) * gw[bb] * (1.f / V8_SCALE); } } }
        __syncthreads();
        for (int s = xg; s < 32; s += ngrp) {
            const unsigned char* Vs = Vb + (size_t)s * NEXP * 128 + l8 * 16;
            for (int n = wave; n < nn; n += NWAVES) { const int t = r + nr * (n0 + n);
                const v4u* ip = (const v4u*)((const unsigned short*)EIDX + (size_t)t * NSLOT + g * 16);
                const v4u ia = ip[0], ib = ip[1];
                const int ej[16] = {(int)(ia.x & 0xffffu), (int)(ia.x >> 16), (int)(ia.y & 0xffffu), (int)(ia.y >> 16), (int)(ia.z & 0xffffu), (int)(ia.z >> 16), (int)(ia.w & 0xffffu), (int)(ia.w >> 16),
                                    (int)(ib.x & 0xffffu), (int)(ib.x >> 16), (int)(ib.y & 0xffffu), (int)(ib.y >> 16), (int)(ib.z & 0xffffu), (int)(ib.z >> 16), (int)(ib.w & 0xffffu), (int)(ib.w >> 16)};
                v4u vg[16];
#pragma unroll
                for (int j = 0; j < 16; ++j) vg[j] = *(const v4u*)(Vs + (size_t)ej[j] * 128);
                const LAS f32x4* gp = (const LAS f32x4*)(gk + n * NSLOT + g * 16);
                const f32x4 g0 = gp[0], g1 = gp[1], g2 = gp[2], g3 = gp[3];
                const float gj[16] = {g0.x, g0.y, g0.z, g0.w, g1.x, g1.y, g1.z, g1.w, g2.x, g2.y, g2.z, g2.w, g3.x, g3.y, g3.z, g3.w};
                typedef float f32x2 __attribute__((ext_vector_type(2)));
                f32x2 ac2[8];
#pragma unroll
                for (int i = 0; i < 8; ++i) ac2[i] = (f32x2){0.f, 0.f};
#pragma unroll
                for (int j = 0; j < 16; ++j) { const v4u vv = vg[j]; const f32x2 gg = {gj[j], gj[j]};
#pragma unroll
                    for (int i = 0; i < 4; ++i) { const f32x2 lo = __builtin_amdgcn_cvt_pk_f32_fp8((int)vv[i], false), hi = __builtin_amdgcn_cvt_pk_f32_fp8((int)vv[i], true);
                        ac2[2 * i] = __builtin_elementwise_fma(gg, lo, ac2[2 * i]); ac2[2 * i + 1] = __builtin_elementwise_fma(gg, hi, ac2[2 * i + 1]); } }
                float acc[16];
#pragma unroll
                for (int i = 0; i < 8; ++i) { acc[2 * i] = ac2[i].x; acc[2 * i + 1] = ac2[i].y; }
                float b8[8], c4[4], d2[2];
#pragma unroll
                for (int i = 0; i < 8; ++i) { const float snd = (g & 4) ? acc[i] : acc[i + 8], kp = (g & 4) ? acc[i + 8] : acc[i]; b8[i] = kp + __shfl_xor(snd, 32); }
#pragma unroll
                for (int i = 0; i < 4; ++i) { const float snd = (g & 2) ? b8[i] : b8[i + 4], kp = (g & 2) ? b8[i + 4] : b8[i]; c4[i] = kp + __shfl_xor(snd, 16); }
#pragma unroll
                for (int i = 0; i < 2; ++i) { const float snd = (g & 1) ? c4[i] : c4[i + 2], kp = (g & 1) ? c4[i + 2] : c4[i]; d2[i] = kp + __shfl_xor(snd, 8); }
                *(unsigned*)(CH + (size_t)t * D + s * 128 + l8 * 16 + 2 * g) = pk2(d2[0], d2[1]);
            }
        }
    }
}

__device__ __forceinline__ void phase_final(const Args& a) {
    unsigned char* ws = a.ws; const int lane = threadIdx.x & 63, wave = threadIdx.x >> 6, gw = blockIdx.x * NWAVES + wave, NGW = gridDim.x * NWAVES;
    const bf16* X1 = (const bf16*)(ws + WS_X1); const float* CH = (const float*)(ws + WS_CH); const float* PLE = (const float*)(ws + (USE_MFMA ? WS_PLE2 : WS_PLE));
    const float* g = a.in[I_LN2G]; const float* b = a.in[I_LN2B];
    for (int m = gw; m < M; m += NGW) {
        float* orow = (m < NP) ? a.out + O_YP + (size_t)m * D : a.out + O_YS + (size_t)(m - NP) * D;
        f32x4 v[16]; float s = 0.f;
#pragma unroll
        for (int j = 0; j < 16; ++j) { const int c = (lane + 64 * j) * 4; const unsigned long long xb = *(const unsigned long long*)(X1 + (size_t)m * D + c);
            const f32x4 x = {bf2f((unsigned)xb & 0xffffu), bf2f(((unsigned)xb) >> 16), bf2f((unsigned)(xb >> 32) & 0xffffu), bf2f((unsigned)(xb >> 48))};
            f32x4 pl;
            if (USE_MFMA) { const unsigned long long pb = *(const unsigned long long*)((const bf16*)PLE + (size_t)m * D + c); pl = (f32x4){bf2f((unsigned)pb & 0xffffu), bf2f(((unsigned)pb) >> 16), bf2f((unsigned)(pb >> 32) & 0xffffu), bf2f((unsigned)(pb >> 48))}; }
            else pl = *(const f32x4*)(PLE + (size_t)m * D + c);
            f32x4 chv;
            if (USE_PEER_FAST) { const unsigned long long cb = *(const unsigned long long*)((const bf16*)CH + (size_t)m * D + c); chv = (f32x4){bf2f((unsigned)cb & 0xffffu), bf2f(((unsigned)cb) >> 16), bf2f((unsigned)(cb >> 32) & 0xffffu), bf2f((unsigned)(cb >> 48))}; }
            else chv = *(const f32x4*)(CH + (size_t)m * D + c);
            v[j] = ALPHA * x + chv + pl; s += (v[j].x + v[j].y) + (v[j].z + v[j].w); }
        const float mean = wave_sum(s) * (1.f / D); float s2 = 0.f;
#pragma unroll
        for (int j = 0; j < 16; ++j) { v[j] = v[j] - mean; s2 += (v[j].x * v[j].x + v[j].y * v[j].y) + (v[j].z * v[j].z + v[j].w * v[j].w); }
        const float rstd = 1.f / sqrtf(wave_sum(s2) * (1.f / D) + LN_EPS);
#pragma unroll
        for (int j = 0; j < 16; ++j) { const int c = (lane + 64 * j) * 4; *(f32x4*)(orow + c) = v[j] * rstd * *(const f32x4*)(g + c) + *(const f32x4*)(b + c); }
    }
}

constexpr int N_PHASES = 8 - (FUSE_CONV ? 1 : 0) + (USE_MIX_FAST ? 3 : 1) + (USE_PEER_FAST ? 2 : 1);
__global__ void __launch_bounds__(NTHR, 2) fwd(Args args) {
    extern __shared__ __attribute__((aligned(16))) unsigned char lds_raw[];
    LAS unsigned char* lds = (LAS unsigned char*)lds_raw;
    volatile LAS unsigned* MISC = (volatile LAS unsigned*)(lds + MISC_OFF);
    for (int u = threadIdx.x; u < (LDS_BYTES - LDSCTL_OFF) / 4; u += NTHR) ((LAS unsigned*)(lds + LDSCTL_OFF))[u] = 0u;
    __syncthreads();
    const int lo = args.ph_lo, hi = args.ph_hi;
    XcdBarrier bar; bar.bar = (unsigned*)(args.ws + WS_CTL) + CW_BAR; bar.x = 0; bar.st = nullptr;
    if (hi - lo > 1) bar = xcd_barrier_post((unsigned*)(args.ws + WS_CTL) + CW_BAR, MISC + 8);
    int pk = 0;
#define PHASE(body) do { if (lo <= pk && pk < hi) { body; if (pk + 1 < hi) xcd_barrier(bar); } ++pk; } while (0)
    PHASE(phase_prologue(args, lds));
    PHASE(phase_gemm1(args, lds));
#if !FUSE_CONV
    PHASE(phase_rope_conv(args));
#endif
#if USE_MIX_FAST
    PHASE(phase_m1_sample(args, lds));
    PHASE(phase_scan(args, lds));
    PHASE(phase_m3(args, lds));
#else
    PHASE(phase_seq_mixers(args, lds));
#endif
    PHASE(phase_gemm2(args, lds));
    PHASE(phase_ln1(args));
    PHASE(phase_gemm3(args, lds));
#if USE_ROUTE_FAST
    PHASE(phase_route_fast(args, 0, 0));
#else
    PHASE(phase_route(args));
#endif
#if USE_PEER_FAST
    PHASE(phase_peer_u(args, lds));
    PHASE(phase_peer_v(args, lds));
#else
    PHASE(phase_peer_slow(args, lds));
#endif
    PHASE(phase_final(args));
#undef PHASE
}

extern "C" void kernel_launch(void* const* d_in, const int* in_sizes, int n_in, void* d_out, int out_size, void* d_ws, size_t ws_size, hipStream_t stream) {
    static int grid = 0;
    if (grid == 0) {
        if (n_in != 28 || (size_t)out_size != O_END || ws_size < WS_END) { fprintf(stderr, "kernel_launch: unexpected shapes: n_in %d out %d ws %zu\n", n_in, out_size, ws_size); grid = -1; return; }
        int dev = 0, cus = 0, per_cu = 0;
        if (hipGetDevice(&dev) != hipSuccess || hipDeviceGetAttribute(&cus, hipDeviceAttributeMultiprocessorCount, dev) != hipSuccess) { grid = -1; return; }
        if (hipFuncSetAttribute((const void*)fwd, hipFuncAttributeMaxDynamicSharedMemorySize, LDS_BYTES) != hipSuccess) { fprintf(stderr, "kernel_launch: hipFuncSetAttribute failed\n"); grid = -1; return; }
        if (hipOccupancyMaxActiveBlocksPerMultiprocessor(&per_cu, (const void*)fwd, NTHR, LDS_BYTES) != hipSuccess || per_cu < 1) { fprintf(stderr, "kernel_launch: occupancy query says %d\n", per_cu); }
        (void)hipGetLastError();
        grid = cus;
    }
    if (grid < 0) return;
    (void)hipMemsetAsync((char*)d_ws + WS_CTL, 0, CTL_ZERO_BYTES, stream);
    Args a; memset(&a, 0, sizeof(a));
    for (int i = 0; i < 28; ++i) a.in[i] = (const float*)d_in[i];
    a.out = (float*)d_out; a.ws = (unsigned char*)d_ws;
    for (int i = 0; i < 128; ++i) a.inv[i] = std::pow(10000.0, -(double)i / 128.0);
#if MK_PER_PHASE
    for (int p = 0; p < N_PHASES; ++p) { a.ph_lo = p; a.ph_hi = p + 1; hipLaunchKernelGGL(fwd, dim3(grid), dim3(NTHR), LDS_BYTES, stream, a); }
#else
    a.ph_lo = 0; a.ph_hi = N_PHASES; hipLaunchKernelGGL(fwd, dim3(grid), dim3(NTHR), LDS_BYTES, stream, a);
#endif
}
```
